# Optimizing an MI355X kernel written in HIP

```python
import math
import jax
import jax.numpy as jnp
from jax import lax
import numpy as np

D_MODEL = 1024
BATCH = 8
SEQ = 4096
DEPTH = 2

GRID_W = 64
CTX_LEN = 256
RMS_EPS = 1e-6
ROPE_THETA = 10000.0
Q_BLOCK = 128

POOL_WINDOWS = (2, 4, 8, 16)
POOL_GROUPS = 4
POOL_WIDTH = 512
POOL_GROUP_DIM = POOL_WIDTH // POOL_GROUPS

DIFF_HEADS = 4
DIFF_QK_DIM = 64
DIFF_V_DIM = 2 * DIFF_QK_DIM
DIFF_QK_WIDTH = 2 * DIFF_HEADS * DIFF_QK_DIM
DIFF_WIDTH = DIFF_HEADS * DIFF_V_DIM

MLA_HEADS = 4
MLA_Q_RANK = 512
MLA_KV_RANK = 256
MLA_NOPE_DIM = 128
MLA_ROPE_DIM = 64
MLA_V_DIM = 128
MLA_WIDTH = MLA_HEADS * MLA_V_DIM

HG_HEADS = 4
HG_K_DIM = 128
HG_V_DIM = 128
HG_QK_WIDTH = HG_HEADS * HG_K_DIM
HG_WIDTH = HG_HEADS * HG_V_DIM
HG_CHUNK = 64

D_FF = 2816
CONV_WIDTH = 3

MIX_WIDTH = POOL_WIDTH + DIFF_WIDTH
EVEN_IN = POOL_WIDTH + 2 * DIFF_QK_WIDTH + DIFF_WIDTH
ODD_IN = MLA_Q_RANK + MLA_KV_RANK + MLA_ROPE_DIM + 3 * HG_QK_WIDTH + 2 * HG_WIDTH
N_EVEN = (DEPTH + 1) // 2
N_ODD = DEPTH // 2

kernel_name = "hybrid_pool_diff_mla_hgrn2_dit_block"


def _rmsnorm(x, g):
    xf = x.astype(jnp.float32)
    y = xf * lax.rsqrt(jnp.mean(xf * xf, axis=-1, keepdims=True) + RMS_EPS)
    return (y * g.astype(jnp.float32)).astype(x.dtype)


def _modulation(cond, w, b):
    m = jax.nn.silu(cond) @ w + b
    m = m.reshape(m.shape[:-1] + (6, 1, D_MODEL))
    return jnp.moveaxis(m, -3, 0)


def _modulate(h, shift, scale):
    return h * (1 + scale) + shift


def _axial_rope_tables(n_tokens, rot_dim, dtype):
    rows = n_tokens // GRID_W
    pos_row = jnp.repeat(jnp.arange(rows), GRID_W)
    pos_col = jnp.tile(jnp.arange(GRID_W), rows)
    axis_dim = rot_dim // 2
    inv_freq = ROPE_THETA ** (-jnp.arange(0, axis_dim, 2, dtype=jnp.float32) / axis_dim)
    ang = jnp.stack([pos_row, pos_col], axis=-1).astype(jnp.float32)[..., None] * inv_freq
    return jnp.cos(ang).astype(dtype), jnp.sin(ang).astype(dtype)


def _apply_axial_rope(x, cos, sin):
    r = x.shape[-1]
    xr = x.reshape(x.shape[:-1] + (2, 2, r // 4))
    bshape = (1, cos.shape[0]) + (1,) * (x.ndim - 3) + (2, r // 4)
    cs = cos.reshape(bshape)
    sn = sin.reshape(bshape)
    x1 = xr[..., 0, :]
    x2 = xr[..., 1, :]
    out = jnp.stack([x1 * cs - x2 * sn, x2 * cs + x1 * sn], axis=-2)
    return out.reshape(x.shape)


def _query_blocks(a):
    b, n = a.shape[:2]
    return jnp.moveaxis(a.reshape((b, n // Q_BLOCK, Q_BLOCK) + a.shape[2:]), 1, 0)


def _merge_blocks(o):
    o = jnp.moveaxis(o, 0, 1)
    return o.reshape((o.shape[0], o.shape[1] * o.shape[2]) + o.shape[3:])


def _multiscale_pool(u):
    b, n, _ = u.shape
    ug = u.reshape(b, n, POOL_GROUPS, POOL_GROUP_DIM).astype(jnp.float32)
    csum = jnp.concatenate([jnp.zeros((b, 1, POOL_GROUPS, POOL_GROUP_DIM), jnp.float32),
                            jnp.cumsum(ug, axis=1)], axis=1)
    half = jnp.array(POOL_WINDOWS, jnp.int32) // 2
    t = jnp.arange(n, dtype=jnp.int32)[:, None]
    lo = jnp.clip(t - half, 0, n)
    hi = jnp.clip(t + half, 0, n)
    grp = jnp.arange(POOL_GROUPS, dtype=jnp.int32)[None, :]
    win_sum = csum[:, hi, grp] - csum[:, lo, grp]
    mean = win_sum / (hi - lo).astype(jnp.float32)[None, :, :, None]
    return (mean - ug).astype(u.dtype)


def _diff_attention(q, k, v, lam):
    scale = DIFF_QK_DIM ** -0.5

    def one(qblk):
        bsz = qblk.shape[0]
        s = jnp.einsum('bqhd,bkhd->bhqk', qblk, k).astype(jnp.float32) * scale
        p = jax.nn.softmax(s, axis=-1).reshape(bsz, DIFF_HEADS, 2, Q_BLOCK, -1)
        a = p[:, :, 0] - lam * p[:, :, 1]
        return jnp.einsum('bhqk,bkhe->bqhe', a.astype(v.dtype), v)

    return _merge_blocks(lax.map(one, _query_blocks(q)))


def _mla_attention(q_nope, q_rope, k_nope, k_rope, v):
    scale = (MLA_NOPE_DIM + MLA_ROPE_DIM) ** -0.5

    def one(blk):
        qn, qr = blk
        s = jnp.einsum('bqhd,bkhd->bhqk', qn, k_nope) + jnp.einsum('bqhr,bkr->bhqk', qr, k_rope)
        p = jax.nn.softmax(s.astype(jnp.float32) * scale, axis=-1)
        return jnp.einsum('bhqk,bkhv->bqhv', p.astype(v.dtype), v)

    return _merge_blocks(lax.map(one, (_query_blocks(q_nope), _query_blocks(q_rope))))


def _hgrn_scan(q, k, v, log_f, s0):
    b, n = q.shape[:2]
    n_chunks = n // HG_CHUNK

    def chunks(a):
        return jnp.moveaxis(a.reshape((b, n_chunks, HG_CHUNK) + a.shape[2:]), 1, 0)

    tri = jnp.tril(jnp.ones((HG_CHUNK, HG_CHUNK), bool))[None, :, :, None, None]

    def step(s, inp):
        qc, kc, vc, gc = inp
        cum = jnp.cumsum(gc, axis=1)
        o_inter = jnp.einsum('bthk,bhkv->bthv', qc * jnp.exp(cum), s)
        rel = jnp.where(tri, cum[:, :, None] - cum[:, None, :], -jnp.inf)
        scores = jnp.einsum('bthk,bshk,btshk->bhts', qc, kc, jnp.exp(rel))
        o_intra = jnp.einsum('bhts,bshv->bthv', scores, vc)
        last = cum[:, -1]
        s_new = jnp.exp(last)[..., None] * s + jnp.einsum(
            'bshk,bshv->bhkv', kc * jnp.exp(last[:, None] - cum), vc)
        return s_new, o_inter + o_intra

    s_fin, o = lax.scan(step, s0, (chunks(q), chunks(k), chunks(v), chunks(log_f)))
    return _merge_blocks(o), s_fin


def _hgrn_direction(q_c, q_l, i_c, i_l, fr_c, fr_l, lb, reverse):
    def gates(fr):
        f = lb + (1.0 - lb) * jax.nn.sigmoid(fr)
        return 1.0 - f, jnp.log(f)

    def orient(a):
        return jnp.flip(a, axis=1) if reverse else a

    k_c, lf_c = gates(fr_c)
    k_l, lf_l = gates(fr_l)
    s0 = jnp.zeros((q_l.shape[0], HG_HEADS, HG_K_DIM, HG_V_DIM), jnp.float32)
    o_c, s_c = _hgrn_scan(orient(q_c), orient(k_c), orient(i_c), orient(lf_c), s0)
    o_l, _ = _hgrn_scan(orient(q_l), orient(k_l), orient(i_l), orient(lf_l), s_c)
    return orient(o_c), orient(o_l)


def _even_mixer(h_c, h_l, w_in, pool_w, pool_scale, lam_vec, subln, w_out, lam_init, cos, sin, need_ctx):
    lam_vec = lam_vec.astype(jnp.float32)
    lam = (jnp.exp(jnp.sum(lam_vec[0] * lam_vec[1])) - jnp.exp(jnp.sum(lam_vec[2] * lam_vec[3]))
           + lam_init)
    split_at = [POOL_WIDTH, POOL_WIDTH + DIFF_QK_WIDTH, POOL_WIDTH + 2 * DIFF_QK_WIDTH]

    def project(h):
        b, n = h.shape[:2]
        u, q, k, v = jnp.split(h @ w_in, split_at, axis=-1)
        return (u, q.reshape(b, n, 2 * DIFF_HEADS, DIFF_QK_DIM), k.reshape(b, n, 2 * DIFF_HEADS, DIFF_QK_DIM),
                v.reshape(b, n, DIFF_HEADS, DIFF_V_DIM))

    def pool_branch(u):
        b, n = u.shape[:2]
        d = _multiscale_pool(u).reshape(b, n, POOL_GROUPS, POOL_GROUP_DIM)
        y = jnp.einsum('blgc,gcd->blgd', d, pool_w).reshape(b, n, POOL_WIDTH)
        return y * pool_scale

    def diff_branch(q, k, v):
        b, n = q.shape[:2]
        o = _diff_attention(q, k, v, lam)
        return (_rmsnorm(o, subln) * (1.0 - lam_init)).reshape(b, n, DIFF_WIDTH)

    u_c, q_c, k_c, v_c = project(h_c)
    u_l, q_l, k_l, v_l = project(h_l)
    q_l = _apply_axial_rope(q_l, cos, sin)
    k_l = _apply_axial_rope(k_l, cos, sin)
    k_all = jnp.concatenate([k_c, k_l], axis=1)
    v_all = jnp.concatenate([v_c, v_l], axis=1)
    y_l = jnp.concatenate([pool_branch(u_l), diff_branch(q_l, k_all, v_all)], axis=-1) @ w_out
    y_c = None
    if need_ctx:
        y_c = jnp.concatenate([pool_branch(u_c), diff_branch(q_c, k_c, v_c)], axis=-1) @ w_out
    return y_c, y_l


def _odd_mixer(h_c, h_l, w_in, q_norm, w_uq, kv_norm, w_ukv, hg_norm, lbs, w_out, cos, sin, need_ctx):
    split_at = np.cumsum([MLA_Q_RANK, MLA_KV_RANK, MLA_ROPE_DIM, HG_QK_WIDTH, HG_QK_WIDTH,
                          HG_QK_WIDTH, HG_WIDTH]).tolist()

    def project(h):
        b, n = h.shape[:2]
        cq, ckv, kr, hq, hf_fwd, hf_bwd, hi, hg = jnp.split(h @ w_in, split_at, axis=-1)
        q = (_rmsnorm(cq, q_norm) @ w_uq).reshape(b, n, MLA_HEADS, MLA_NOPE_DIM + MLA_ROPE_DIM)
        kv = (_rmsnorm(ckv, kv_norm) @ w_ukv).reshape(b, n, MLA_HEADS, MLA_NOPE_DIM + MLA_V_DIM)
        ks = (b, n, HG_HEADS, HG_K_DIM)
        vs = (b, n, HG_HEADS, HG_V_DIM)
        hgrn = (jax.nn.silu(hq).reshape(ks).astype(jnp.float32), hf_fwd.reshape(ks).astype(jnp.float32),
                hf_bwd.reshape(ks).astype(jnp.float32), hi.reshape(vs).astype(jnp.float32), hg.reshape(vs))
        return (q[..., :MLA_NOPE_DIM], q[..., MLA_NOPE_DIM:], kv[..., :MLA_NOPE_DIM],
                kv[..., MLA_NOPE_DIM:], kr, hgrn)

    qn_c, qr_c, kn_c, v_c, kr_c, hg_c = project(h_c)
    qn_l, qr_l, kn_l, v_l, kr_l, hg_l = project(h_l)
    qr_l = _apply_axial_rope(qr_l, cos, sin)
    kr_l = _apply_axial_rope(kr_l, cos, sin)
    mla_l = _mla_attention(qn_l, qr_l, jnp.concatenate([kn_c, kn_l], axis=1),
                           jnp.concatenate([kr_c, kr_l], axis=1), jnp.concatenate([v_c, v_l], axis=1))

    oc_f, ol_f = _hgrn_direction(hg_c[0], hg_l[0], hg_c[3], hg_l[3], hg_c[1], hg_l[1],
                                 lbs[0].reshape(HG_HEADS, HG_K_DIM), False)
    oc_b, ol_b = _hgrn_direction(hg_c[0], hg_l[0], hg_c[3], hg_l[3], hg_c[2], hg_l[2],
                                 lbs[1].reshape(HG_HEADS, HG_K_DIM), True)

    def hgrn_readout(o, gate):
        b, n = gate.shape[:2]
        return (_rmsnorm(o.astype(gate.dtype), hg_norm) * jax.nn.silu(gate)).reshape(b, n, HG_WIDTH)

    def merge(mla, hg_out):
        b, n = mla.shape[:2]
        return jnp.concatenate([mla.reshape(b, n, MLA_WIDTH), hg_out], axis=-1) @ w_out

    y_l = merge(mla_l, hgrn_readout(ol_f + ol_b, hg_l[4]))
    y_c = None
    if need_ctx:
        mla_c = _mla_attention(qn_c, qr_c, kn_c, kr_c, v_c)
        y_c = merge(mla_c, hgrn_readout(oc_f + oc_b, hg_c[4]))
    return y_c, y_l


def _conv_ffn(h, w_gate, w_up, conv_w, conv_b, w_down):
    a = h @ w_gate
    ap = jnp.pad(a, ((0, 0), (1, 1), (0, 0)))
    a = ap[:, :-2] * conv_w[0] + ap[:, 1:-1] * conv_w[1] + ap[:, 2:] * conv_w[2] + conv_b
    return (jax.nn.silu(a) * (h @ w_up)) @ w_down


def setup_inputs(seed: int = 0) -> dict:
    key = jax.random.key(seed)
    ks = jax.random.split(key, 25)

    def nrm(k, shape, scale):
        return jax.random.normal(k, shape, jnp.float32) * scale

    def gain(k, shape):
        return 1.0 + 0.05 * jax.random.normal(k, shape, jnp.float32)

    return {
        "x": nrm(ks[0], (BATCH, SEQ, D_MODEL), 1.0),
        "c": nrm(ks[1], (BATCH, D_MODEL), 1.0),
        "ctx": nrm(ks[2], (BATCH, CTX_LEN, D_MODEL), 1.0),
        "c_ctx": nrm(ks[3], (D_MODEL,), 1.0),
        "ada_w": nrm(ks[4], (DEPTH, D_MODEL, 6 * D_MODEL), 0.5 * D_MODEL ** -0.5),
        "ada_b": nrm(ks[5], (DEPTH, 6 * D_MODEL), 0.02),
        "norm_g": gain(ks[6], (DEPTH, 4, D_MODEL)),
        "mix_w_out": nrm(ks[7], (DEPTH, MIX_WIDTH, D_MODEL), MIX_WIDTH ** -0.5),
        "ffn_w_gate": nrm(ks[8], (DEPTH, D_MODEL, D_FF), D_MODEL ** -0.5),
        "ffn_w_up": nrm(ks[9], (DEPTH, D_MODEL, D_FF), D_MODEL ** -0.5),
        "ffn_conv_w": nrm(ks[10], (DEPTH, CONV_WIDTH, D_FF), CONV_WIDTH ** -0.5),
        "ffn_conv_b": nrm(ks[11], (DEPTH, D_FF), 0.02),
        "ffn_w_down": nrm(ks[12], (DEPTH, D_FF, D_MODEL), D_FF ** -0.5),
        "ev_w_in": nrm(ks[13], (N_EVEN, D_MODEL, EVEN_IN), D_MODEL ** -0.5),
        "pool_w": nrm(ks[14], (N_EVEN, POOL_GROUPS, POOL_GROUP_DIM, POOL_GROUP_DIM), POOL_GROUP_DIM ** -0.5),
        "pool_scale": 1.0 + 0.1 * jax.random.normal(ks[15], (N_EVEN, POOL_WIDTH), jnp.float32),
        "diff_lambda": nrm(ks[16], (N_EVEN, 4, DIFF_QK_DIM), 0.1),
        "diff_subln": gain(ks[17], (N_EVEN, DIFF_V_DIM)),
        "od_w_in": nrm(ks[18], (N_ODD, D_MODEL, ODD_IN), D_MODEL ** -0.5),
        "mla_q_norm": gain(ks[19], (N_ODD, MLA_Q_RANK)),
        "mla_w_uq": nrm(ks[20], (N_ODD, MLA_Q_RANK, MLA_HEADS * (MLA_NOPE_DIM + MLA_ROPE_DIM)), MLA_Q_RANK ** -0.5),
        "mla_kv_norm": gain(ks[21], (N_ODD, MLA_KV_RANK)),
        "mla_w_ukv": nrm(ks[22], (N_ODD, MLA_KV_RANK, MLA_HEADS * (MLA_NOPE_DIM + MLA_V_DIM)), MLA_KV_RANK ** -0.5),
        "hgrn_norm": gain(ks[23], (N_ODD, HG_V_DIM)),
        "hgrn_lb": nrm(ks[24], (2, DEPTH, HG_QK_WIDTH), 0.5),
    }


def reference(x, c, ctx, c_ctx, ada_w, ada_b, norm_g, mix_w_out, ffn_w_gate, ffn_w_up, ffn_conv_w,
              ffn_conv_b, ffn_w_down, ev_w_in, pool_w, pool_scale, diff_lambda, diff_subln, od_w_in,
              mla_q_norm, mla_w_uq, mla_kv_norm, mla_w_ukv, hgrn_norm, hgrn_lb):
    n_lat = x.shape[1]
    cos, sin = _axial_rope_tables(n_lat, DIFF_QK_DIM, x.dtype)
    probs = jax.nn.softmax(hgrn_lb.astype(jnp.float32), axis=1)
    lower_bounds = jnp.cumsum(probs, axis=1) - probs[:, :1]
    xc = ctx
    for layer in range(DEPTH):
        last = layer == DEPTH - 1
        j = layer // 2
        sh1, sc1, g1, sh2, sc2, g2 = _modulation(c, ada_w[layer], ada_b[layer])
        csh1, csc1, cg1, csh2, csc2, cg2 = _modulation(c_ctx, ada_w[layer], ada_b[layer])
        h_l = _modulate(_rmsnorm(x, norm_g[layer, 0]), sh1, sc1)
        h_c = _modulate(_rmsnorm(xc, norm_g[layer, 0]), csh1, csc1)
        if layer % 2 == 0:
            lam_init = 0.8 - 0.6 * math.exp(-0.3 * layer)
            y_c, y_l = _even_mixer(h_c, h_l, ev_w_in[j], pool_w[j], pool_scale[j], diff_lambda[j],
                                   diff_subln[j], mix_w_out[layer], lam_init, cos, sin, not last)
        else:
            y_c, y_l = _odd_mixer(h_c, h_l, od_w_in[j], mla_q_norm[j], mla_w_uq[j], mla_kv_norm[j],
                                  mla_w_ukv[j], hgrn_norm[j], lower_bounds[:, layer], mix_w_out[layer],
                                  cos, sin, not last)
        x = x + g1 * _rmsnorm(y_l, norm_g[layer, 1])
        f_l = _conv_ffn(_modulate(_rmsnorm(x, norm_g[layer, 2]), sh2, sc2), ffn_w_gate[layer],
                        ffn_w_up[layer], ffn_conv_w[layer], ffn_conv_b[layer], ffn_w_down[layer])
        x = x + g2 * _rmsnorm(f_l, norm_g[layer, 3])
        if not last:
            xc = xc + cg1 * _rmsnorm(y_c, norm_g[layer, 1])
            f_c = _conv_ffn(_modulate(_rmsnorm(xc, norm_g[layer, 2]), csh2, csc2), ffn_w_gate[layer],
                            ffn_w_up[layer], ffn_conv_w[layer], ffn_conv_b[layer], ffn_w_down[layer])
            xc = xc + cg2 * _rmsnorm(f_c, norm_g[layer, 3])
    return x
```

```cpp
#include <hip/hip_runtime.h>
#include <hip/hip_fp16.h>
#include <hip/hip_cooperative_groups.h>
#include <cstdio>
#include <cstdint>
namespace cg = cooperative_groups;

#define DI __device__ __forceinline__
typedef unsigned short u16;
typedef __attribute__((ext_vector_type(8))) short bf16x8;
typedef __attribute__((ext_vector_type(16))) float f32x16;
typedef __attribute__((ext_vector_type(4))) unsigned u32x4;
typedef __attribute__((ext_vector_type(2))) unsigned u32x2;

constexpr int D = 1024, NB = 8, SEQ = 4096, CTX = 256, LT = 4352, M = NB * LT, DFF = 2816;
constexpr float EPS = 1e-6f;
constexpr float LOG2E = 1.4426950408889634f;
constexpr float QS_DIFF = 0.125f * LOG2E;
constexpr float QS_MLA = 0.07216878364870323f * LOG2E;
constexpr int NTHR = 256;

constexpr size_t SZ_WT_OUT = 2ull * 1024 * 1024 * 2;
constexpr size_t SZ_WT_F1 = 5632ull * 1024 * 2;
constexpr size_t SZ_WT_F2 = 1024ull * 2816 * 2;
constexpr size_t SZ_WT_EV = 2048ull * 1024 * 2;
constexpr size_t SZ_WT_OD = 3456ull * 1024 * 2;
constexpr size_t SZ_WT_UQ = 768ull * 512 * 2;
constexpr size_t SZ_WT_UKV = 1024ull * 256 * 2;
constexpr size_t SZ_WT_POOL = 4ull * 128 * 128 * 2;
constexpr size_t SZ_MOD = 2ull * 9 * 6144 * 4;
constexpr size_t SZ_ROPE = 2ull * 1024 * 4;
constexpr size_t SZ_LB = 1024 * 4;
constexpr size_t SZ_LAM = 256;
constexpr size_t SZ_XC = 2048ull * 1024 * 4;
constexpr size_t SZ_H = (size_t)M * 1024 * 2;
constexpr size_t SZ_M512 = (size_t)M * 512 * 2;

constexpr size_t OFF_WT_OUT = 0;
constexpr size_t OFF_WT_F1 = OFF_WT_OUT + SZ_WT_OUT;
constexpr size_t OFF_WT_F2 = OFF_WT_F1 + SZ_WT_F1;
constexpr size_t OFF_WT_EV = OFF_WT_F2 + SZ_WT_F2;
constexpr size_t OFF_WT_OD = OFF_WT_EV + SZ_WT_EV;
constexpr size_t OFF_WT_UQ = OFF_WT_OD + SZ_WT_OD;
constexpr size_t OFF_WT_UKV = OFF_WT_UQ + SZ_WT_UQ;
constexpr size_t OFF_WT_POOL = OFF_WT_UKV + SZ_WT_UKV;
constexpr size_t OFF_MOD = OFF_WT_POOL + SZ_WT_POOL;
constexpr size_t OFF_ROPE = OFF_MOD + SZ_MOD;
constexpr size_t OFF_LB = OFF_ROPE + SZ_ROPE;
constexpr size_t OFF_LAM = OFF_LB + SZ_LB;
constexpr size_t OFF_XC = OFF_LAM + SZ_LAM;
constexpr size_t OFF_H = OFF_XC + SZ_XC;
constexpr size_t OFF_R = OFF_H + SZ_H;
constexpr size_t R_U = 0;
constexpr size_t R_Q0 = R_U + SZ_M512;
constexpr size_t R_K0 = R_Q0 + SZ_M512;
constexpr size_t R_VT0 = R_K0 + SZ_M512;
constexpr size_t R_MIX0 = R_VT0 + SZ_M512;
constexpr size_t R_Y0 = R_MIX0 + SZ_H;
constexpr size_t R_G0 = 0;
constexpr size_t R_MIX1 = 0;
constexpr size_t R_CQ = 0;
constexpr size_t R_CKV = SZ_M512;
constexpr size_t R_KF = SZ_H;
constexpr size_t SZ_KF = 8ull * 4 * LT * 192 * 2;
constexpr size_t R_VT1 = R_KF + SZ_KF;
constexpr size_t R_HQ = R_VT1 + SZ_M512;
constexpr size_t R_LF = R_HQ + SZ_M512;
constexpr size_t R_HI = R_LF + 2 * SZ_M512;
constexpr size_t R_HG = R_HI + SZ_M512;
constexpr size_t R_OH = R_HG + SZ_M512;
constexpr size_t R_END1 = R_OH + 2 * SZ_M512;
constexpr size_t R_Y1 = R_KF;
constexpr size_t SZ_Y = (size_t)M * 1024 * 4;
constexpr size_t R_G1 = R_Y1 + SZ_Y;
constexpr size_t SZ_G = (size_t)M * DFF * 2;
constexpr size_t R_SIZE = (R_G1 + SZ_G > R_END1) ? (R_G1 + SZ_G) : R_END1;
constexpr size_t WS_NEEDED = OFF_R + R_SIZE;
static_assert(R_Y0 + SZ_Y <= R_SIZE, "layer0 region");
static_assert(R_G0 + SZ_G <= R_Y0, "G0 overlap");
static_assert(WS_NEEDED <= 536870912ull, "ws too big");

struct Params {
  const float* in[25];
  float* out;
  char* ws;
  int ph_lo, ph_hi;
};

constexpr int SMEM_BYTES = 73728;
constexpr int LDT = 72;
constexpr int CLD = 132;

DI u16 f2bf(float x) { return __builtin_bit_cast(u16, (__bf16)x); }
DI unsigned pk2(float a, float b) { return (unsigned)f2bf(a) | ((unsigned)f2bf(b) << 16); }
DI float bflo(unsigned u) { return __uint_as_float(u << 16); }
DI float bfhi(unsigned u) { return __uint_as_float(u & 0xffff0000u); }
DI float bf2f(u16 v) { return __uint_as_float(((unsigned)v) << 16); }
DI float h2f(u16 v) { return __half2float(__ushort_as_half(v)); }
DI u16 f2h(float x) { return __half_as_ushort(__float2half(x)); }
DI float siluf(float x) { return x / (1.f + __expf(-x)); }
DI float wave_sum(float v) {
#pragma unroll
  for (int o = 32; o > 0; o >>= 1) v += __shfl_xor(v, o);
  return v;
}
DI u32x4 pack8(const float* v) {
  u32x4 o;
  o[0] = pk2(v[0], v[1]); o[1] = pk2(v[2], v[3]); o[2] = pk2(v[4], v[5]); o[3] = pk2(v[6], v[7]);
  return o;
}
DI int crow(int reg, int h) { return (reg & 3) + 8 * (reg >> 2) + 4 * h; }
#define MFMA32(a, b, c) __builtin_amdgcn_mfma_f32_32x32x16_bf16((a), (b), (c), 0, 0, 0)

struct Bufs {
  char* ws;
#define BUFP(T, name, off) DI T* name##_() const { return (T*)(ws + (off)); }
  BUFP(u16, wt_out, OFF_WT_OUT) BUFP(u16, wt_f1, OFF_WT_F1) BUFP(u16, wt_f2, OFF_WT_F2) BUFP(u16, wt_ev, OFF_WT_EV)
  BUFP(u16, wt_od, OFF_WT_OD) BUFP(u16, wt_uq, OFF_WT_UQ) BUFP(u16, wt_ukv, OFF_WT_UKV) BUFP(u16, wt_pool, OFF_WT_POOL)
  BUFP(float, mod, OFF_MOD) BUFP(float, ropec, OFF_ROPE) BUFP(float, ropes, OFF_ROPE + 4096) BUFP(float, lb, OFF_LB)
  BUFP(float, lam, OFF_LAM) BUFP(float, xc, OFF_XC) BUFP(u16, H, OFF_H)
  BUFP(u16, U, OFF_R + R_U) BUFP(u16, Q0, OFF_R + R_Q0) BUFP(u16, K0, OFF_R + R_K0) BUFP(u16, VT0, OFF_R + R_VT0)
  BUFP(u16, MIX0, OFF_R + R_MIX0) BUFP(float, Y0, OFF_R + R_Y0) BUFP(u16, G0, OFF_R + R_G0)
  BUFP(u16, CQ, OFF_R + R_CQ) BUFP(u16, CKV, OFF_R + R_CKV) BUFP(u16, MIX1, OFF_R + R_MIX1) BUFP(u16, KF, OFF_R + R_KF)
  BUFP(u16, VT1, OFF_R + R_VT1) BUFP(u16, HQ, OFF_R + R_HQ) BUFP(u16, LF, OFF_R + R_LF) BUFP(u16, HI, OFF_R + R_HI)
  BUFP(u16, HG, OFF_R + R_HG) BUFP(u16, OH, OFF_R + R_OH) BUFP(u16, QF, OFF_H) BUFP(float, Y1, OFF_R + R_Y1)
  BUFP(u16, G1, OFF_R + R_G1)
};
DI Bufs make_bufs(char* ws) { Bufs b; b.ws = ws; return b; }

DI void wt_tile(char* smem, const float* __restrict__ src, int ld, int kt, int ncol0, u16* __restrict__ dst, int K,
                int dst_row0, const float* __restrict__ scale) {
  float* t = (float*)smem;
  const int tid = threadIdx.x, col = tid & 63, r0 = tid >> 6;
#pragma unroll 4
  for (int i = 0; i < 16; ++i) {
    int row = i * 4 + r0;
    float v = src[(size_t)(kt * 64 + row) * ld + ncol0 + col];
    if (scale) v *= scale[kt * 64 + row];
    t[row * 65 + col] = v;
  }
  __syncthreads();
#pragma unroll
  for (int it = 0; it < 2; ++it) {
    int c = it * 256 + tid, j = c >> 3, kc = c & 7;
    u32x4 o;
#pragma unroll
    for (int q = 0; q < 4; ++q) o[q] = pk2(t[(kc * 8 + 2 * q) * 65 + j], t[(kc * 8 + 2 * q + 1) * 65 + j]);
    *(u32x4*)(dst + (size_t)(dst_row0 + j) * K + kt * 64 + kc * 8) = o;
  }
  __syncthreads();
}

#define WJOB(SRC, LDD, KK, NN, DST, TS, ROFF, SC)                                        \
  {                                                                                       \
    const int ntn = (NN) / 64, cnt = ((KK) / 64) * ntn;                                   \
    if (idx < cnt) {                                                                      \
      int kt = idx / ntn, nt = idx % ntn;                                                 \
      wt_tile(smem, (SRC), (LDD), kt, nt * 64, (DST), (KK), nt * (TS) + (ROFF), (SC));    \
      return;                                                                             \
    }                                                                                     \
    idx -= cnt;                                                                           \
  }

constexpr int NW_FFN = 704 * 3;
constexpr int NW_P0 = 256 + 256 + NW_FFN + 512 + 848 + 96 + 64 + 16;

DI void ffn_weight_item(char* smem, const Params& p, const Bufs& B, int layer, int idx) {
  WJOB(p.in[8] + (size_t)layer * 1024 * DFF, DFF, 1024, DFF, B.wt_f1_(), 128, 0, nullptr)
  WJOB(p.in[9] + (size_t)layer * 1024 * DFF, DFF, 1024, DFF, B.wt_f1_(), 128, 64, nullptr)
  WJOB(p.in[12] + (size_t)layer * DFF * 1024, 1024, DFF, 1024, B.wt_f2_(), 64, 0, nullptr)
}

DI void prep_weight_item(char* smem, const Params& p, const Bufs& B, int idx) {
  WJOB(p.in[7], 1024, 1024, 1024, B.wt_out_(), 64, 0, nullptr)
  WJOB(p.in[7] + 1024 * 1024, 1024, 1024, 1024, B.wt_out_() + 1024 * 1024, 64, 0, nullptr)
  if (idx < NW_FFN) { ffn_weight_item(smem, p, B, 0, idx); return; }
  idx -= NW_FFN;
  WJOB(p.in[13], 2048, 1024, 2048, B.wt_ev_(), 64, 0, nullptr)
  WJOB(p.in[18], 3392, 1024, 3392, B.wt_od_(), 64, 0, nullptr)
  WJOB(p.in[20], 768, 512, 768, B.wt_uq_(), 64, 0, p.in[19])
  WJOB(p.in[22], 1024, 256, 1024, B.wt_ukv_(), 64, 0, p.in[21])
  {
    int g = idx >> 2, t = idx & 3;
    wt_tile(smem, p.in[14] + g * 128 * 128, 128, t >> 1, (t & 1) * 64, B.wt_pool_() + g * 128 * 128, 128, (t & 1) * 64,
            nullptr);
  }
}

DI void mod_gemv_item(char* smem, const Params& p, const Bufs& B, int idx) {
  const int layer = idx / 96, c0 = (idx % 96) * 64, tid = threadIdx.x;
  float* sc = (float*)smem;
  float* red = sc + 9 * 1024;
  for (int i = tid; i < 9 * 1024; i += NTHR) {
    int rr = i >> 10, k = i & 1023;
    float v = (rr < 8) ? p.in[1][rr * 1024 + k] : p.in[3][k];
    sc[i] = siluf(v);
  }
  __syncthreads();
  const int cq = tid & 15, kg = tid >> 4;
  float acc[9][4];
#pragma unroll
  for (int a = 0; a < 9; ++a)
#pragma unroll
    for (int e = 0; e < 4; ++e) acc[a][e] = 0.f;
  const float* W = p.in[4] + (size_t)layer * 1024 * 6144 + c0 + cq * 4;
#pragma unroll 4
  for (int kk = 0; kk < 64; ++kk) {
    int k = kg * 64 + kk;
    float4 w = *(const float4*)(W + (size_t)k * 6144);
#pragma unroll
    for (int a = 0; a < 9; ++a) {
      float s = sc[a * 1024 + k];
      acc[a][0] += s * w.x; acc[a][1] += s * w.y; acc[a][2] += s * w.z; acc[a][3] += s * w.w;
    }
  }
#pragma unroll
  for (int a = 0; a < 9; ++a)
#pragma unroll
    for (int e = 0; e < 4; ++e) red[(kg * 9 + a) * 64 + cq * 4 + e] = acc[a][e];
  __syncthreads();
  for (int i = tid; i < 9 * 64; i += NTHR) {
    int a = i >> 6, c = i & 63;
    float s = 0.f;
    for (int g = 0; g < 16; ++g) s += red[(g * 9 + a) * 64 + c];
    B.mod_()[(size_t)(layer * 9 + a) * 6144 + c0 + c] = s + p.in[5][layer * 6144 + c0 + c];
  }
  __syncthreads();
}

DI void tables_item(const Params& p, const Bufs& B) {
  const int tid = threadIdx.x;
  for (int i = tid; i < 1024; i += NTHR) {
    int pos = i >> 4, f = i & 15;
    float inv = powf(10000.f, -(float)f / 16.f);
    float ang = (float)pos * inv;
    B.ropec_()[i] = cosf(ang);
    B.ropes_()[i] = sinf(ang);
    int dir = i >> 9, ch = i & 511;
    float a0 = p.in[24][(dir * 2 + 0) * 512 + ch], a1 = p.in[24][(dir * 2 + 1) * 512 + ch];
    B.lb_()[i] = 1.f / (1.f + expf(a0 - a1));
  }
  if (tid < 64) {
    const float* L = p.in[16];
    float s1 = wave_sum(L[tid] * L[64 + tid]);
    float s2 = wave_sum(L[128 + tid] * L[192 + tid]);
    if (tid == 0) B.lam_()[0] = expf(s1) - expf(s2) + 0.2f;
  }
  for (int i = tid; i < 64 * 1024 / 8; i += NTHR) {
    u32x4 z = {0u, 0u, 0u, 0u};
    *(u32x4*)(B.wt_od_() + (size_t)3392 * 1024 + i * 8) = z;
  }
}

struct RowInfo { int b, pos, mi; bool lat; };
DI RowInfo row_info(int r) {
  RowInfo ri;
  ri.b = r / LT; ri.pos = r - ri.b * LT; ri.lat = ri.pos >= CTX; ri.mi = ri.lat ? ri.b : 8;
  return ri;
}
DI size_t resid_off(const RowInfo& ri) {
  return ri.lat ? ((size_t)ri.b * SEQ + (ri.pos - CTX)) * 1024 : ((size_t)ri.b * CTX + ri.pos) * 1024;
}

DI void norm_mod_row(const float* __restrict__ x, const float* __restrict__ g, const float* __restrict__ sh,
                     const float* __restrict__ sc, u16* __restrict__ hrow, int lane) {
  float4 v[4];
  float ss = 0.f;
#pragma unroll
  for (int i = 0; i < 4; ++i) {
    v[i] = *(const float4*)(x + i * 256 + lane * 4);
    ss += v[i].x * v[i].x + v[i].y * v[i].y + v[i].z * v[i].z + v[i].w * v[i].w;
  }
  ss = wave_sum(ss);
  const float rstd = rsqrtf(ss * (1.f / 1024.f) + EPS);
#pragma unroll
  for (int i = 0; i < 4; ++i) {
    int c = i * 256 + lane * 4;
    float4 gg = *(const float4*)(g + c), s1 = *(const float4*)(sh + c), s2 = *(const float4*)(sc + c);
    u32x2 o;
    o[0] = pk2(v[i].x * rstd * gg.x * (1.f + s2.x) + s1.x, v[i].y * rstd * gg.y * (1.f + s2.y) + s1.y);
    o[1] = pk2(v[i].z * rstd * gg.z * (1.f + s2.z) + s1.z, v[i].w * rstd * gg.w * (1.f + s2.w) + s1.w);
    *(u32x2*)(hrow + c) = o;
  }
}

template <bool NEXT>
DI void resid_row(const float* __restrict__ y, const float* xs, float* xd, const float* __restrict__ gate,
                  const float* __restrict__ ny, const float* __restrict__ nx, const float* __restrict__ sh,
                  const float* __restrict__ sc, u16* __restrict__ hrow, int lane) {
  float4 v[4];
  float ss = 0.f;
#pragma unroll
  for (int i = 0; i < 4; ++i) {
    v[i] = *(const float4*)(y + i * 256 + lane * 4);
    ss += v[i].x * v[i].x + v[i].y * v[i].y + v[i].z * v[i].z + v[i].w * v[i].w;
  }
  ss = wave_sum(ss);
  const float rstd = rsqrtf(ss * (1.f / 1024.f) + EPS);
  float ss2 = 0.f;
#pragma unroll
  for (int i = 0; i < 4; ++i) {
    int c = i * 256 + lane * 4;
    float4 xv = *(const float4*)(xs + c), gt = *(const float4*)(gate + c), nn = *(const float4*)(ny + c);
    float4 o;
    o.x = xv.x + gt.x * (v[i].x * rstd * nn.x); o.y = xv.y + gt.y * (v[i].y * rstd * nn.y);
    o.z = xv.z + gt.z * (v[i].z * rstd * nn.z); o.w = xv.w + gt.w * (v[i].w * rstd * nn.w);
    *(float4*)(xd + c) = o;
    v[i] = o;
    ss2 += o.x * o.x + o.y * o.y + o.z * o.z + o.w * o.w;
  }
  if (NEXT) {
    ss2 = wave_sum(ss2);
    const float rstd2 = rsqrtf(ss2 * (1.f / 1024.f) + EPS);
#pragma unroll
    for (int i = 0; i < 4; ++i) {
      int c = i * 256 + lane * 4;
      float4 gg = *(const float4*)(nx + c), s1 = *(const float4*)(sh + c), s2 = *(const float4*)(sc + c);
      u32x2 o;
      o[0] = pk2(v[i].x * rstd2 * gg.x * (1.f + s2.x) + s1.x, v[i].y * rstd2 * gg.y * (1.f + s2.y) + s1.y);
      o[1] = pk2(v[i].z * rstd2 * gg.z * (1.f + s2.z) + s1.z, v[i].w * rstd2 * gg.w * (1.f + s2.w) + s1.w);
      *(u32x2*)(hrow + c) = o;
    }
  }
}

enum { EPI_F32 = 0, EPI_IN0, EPI_IN1, EPI_FFN1, EPI_UQ, EPI_UKV, EPI_POOL };

struct EpiArgs {
  float* outf;
  int layer;
  int seg_lo, seg_hi;
  int aux;
};

DI void mma_ktile(const u16* As, const u16* Bs, f32x16 (&acc)[2][2], int wm, int wn, int r, int h) {
#pragma unroll
  for (int ks = 0; ks < 4; ++ks) {
    bf16x8 a[2], b[2];
#pragma unroll
    for (int i = 0; i < 2; ++i) a[i] = *(const bf16x8*)(As + (wm * 64 + i * 32 + r) * LDT + ks * 16 + h * 8);
#pragma unroll
    for (int j = 0; j < 2; ++j) b[j] = *(const bf16x8*)(Bs + (wn * 64 + j * 32 + r) * LDT + ks * 16 + h * 8);
#pragma unroll
    for (int i = 0; i < 2; ++i)
#pragma unroll
      for (int j = 0; j < 2; ++j) acc[i][j] = MFMA32(a[i], b[j], acc[i][j]);
  }
}

DI void acc_to_lds(float* Ct, f32x16 (&acc)[2][2], int wm, int wn, int r, int h) {
#pragma unroll
  for (int i = 0; i < 2; ++i)
#pragma unroll
    for (int j = 0; j < 2; ++j)
#pragma unroll
      for (int g = 0; g < 16; ++g)
        Ct[(wm * 64 + i * 32 + crow(g, h)) * CLD + wn * 64 + j * 32 + r] = acc[i][j][g];
}

DI void rope8(float* v, const float* Ct_row, int cc8, int d, int n, const Bufs& B) {
  const int axis = d >> 5, pa = axis ? (n & 63) : (n >> 6), f0 = d & 15;
  const bool first = (d & 16) == 0;
  const int pc = first ? cc8 + 16 : cc8 - 16;
#pragma unroll
  for (int e = 0; e < 8; ++e) {
    float cs = B.ropec_()[pa * 16 + f0 + e], sn = B.ropes_()[pa * 16 + f0 + e], xp = Ct_row[pc + e];
    v[e] = first ? v[e] * cs - xp * sn : v[e] * cs + xp * sn;
  }
}

template <int EPI>
DI void epilogue(const Params& p, const Bufs& B, const float* Ct, const float* rowss, int rowbase, int n0,
                 const EpiArgs& ea) {
  const int tid = threadIdx.x;
  if (EPI == EPI_F32) {
#pragma unroll 1
    for (int it = 0; it < 8; ++it) {
      int id = it * 256 + tid, i = id >> 4, cc = id & 15;
      float4 v0 = *(const float4*)(Ct + i * CLD + cc * 8), v1 = *(const float4*)(Ct + i * CLD + cc * 8 + 4);
      float* o = ea.outf + (size_t)(rowbase + i) * 1024 + n0 + cc * 8;
      *(float4*)o = v0; *(float4*)(o + 4) = v1;
    }
  } else if (EPI == EPI_POOL) {
#pragma unroll 1
    for (int it = 0; it < 8; ++it) {
      int id = it * 256 + tid, i = id >> 4, cc = id & 15;
      float v[8];
#pragma unroll
      for (int e = 0; e < 8; ++e) v[e] = Ct[i * CLD + cc * 8 + e] * p.in[15][ea.aux * 128 + cc * 8 + e];
      *(u32x4*)(B.MIX0_() + (size_t)(rowbase + i) * 1024 + ea.aux * 128 + cc * 8) = pack8(v);
    }
  } else if (EPI == EPI_IN0) {
    const int seg = n0 >> 9, b = rowbase / LT, pos0 = rowbase - b * LT;
    if (seg == 3) {
#pragma unroll 1
      for (int it = 0; it < 8; ++it) {
        int id = it * 256 + tid, c = id & 127, rc = id >> 7;
        float v[8];
#pragma unroll
        for (int e = 0; e < 8; ++e) v[e] = Ct[(rc * 8 + e) * CLD + c];
        int hc = n0 - 1536 + c, vh = hc >> 7, dv = hc & 127;
        *(u32x4*)(B.VT0_() + ((size_t)(b * 4 + vh) * 128 + dv) * LT + pos0 + rc * 8) = pack8(v);
      }
    } else {
#pragma unroll 1
      for (int it = 0; it < 8; ++it) {
        int id = it * 256 + tid, i = id >> 4, cc = id & 15;
        float v[8];
#pragma unroll
        for (int e = 0; e < 8; ++e) v[e] = Ct[i * CLD + cc * 8 + e];
        if (seg == 0) {
          *(u32x4*)(B.U_() + (size_t)(rowbase + i) * 512 + n0 + cc * 8) = pack8(v);
        } else {
          int hc = n0 - 512 * seg + cc * 8, head = hc >> 6, d = hc & 63, pos = pos0 + i;
          if (pos >= CTX) rope8(v, Ct + i * CLD, cc * 8, d, pos - CTX, B);
          if (seg == 1) {
#pragma unroll
            for (int e = 0; e < 8; ++e) v[e] *= QS_DIFF;
          }
          u16* dst = (seg == 1 ? B.Q0_() : B.K0_()) + ((size_t)(b * 8 + head) * LT + pos) * 64 + d;
          *(u32x4*)dst = pack8(v);
        }
      }
    }
  } else if (EPI == EPI_IN1) {
    const int b = rowbase / LT, pos0 = rowbase - b * LT;
#pragma unroll 1
    for (int it = 0; it < 8; ++it) {
      int id = it * 256 + tid, i = id >> 4, cc = id & 15;
      int gc = n0 + cc * 8, pos = pos0 + i;
      size_t grow = (size_t)(rowbase + i);
      float v[8];
#pragma unroll
      for (int e = 0; e < 8; ++e) v[e] = Ct[i * CLD + cc * 8 + e];
      if (gc < 512) {
        *(u32x4*)(B.CQ_() + grow * 512 + gc) = pack8(v);
      } else if (gc < 768) {
        *(u32x4*)(B.CKV_() + grow * 256 + (gc - 512)) = pack8(v);
      } else if (gc < 832) {
        int d = gc - 768;
        if (pos >= CTX) rope8(v, Ct + i * CLD, cc * 8, d, pos - CTX, B);
        u32x4 o = pack8(v);
#pragma unroll
        for (int hh = 0; hh < 4; ++hh) *(u32x4*)(B.KF_() + ((size_t)(b * 4 + hh) * LT + pos) * 192 + 128 + d) = o;
      } else if (gc < 1344) {
#pragma unroll
        for (int e = 0; e < 8; ++e) v[e] = siluf(v[e]);
        *(u32x4*)(B.HQ_() + grow * 512 + (gc - 832)) = pack8(v);
      } else if (gc < 2368) {
        int dir = gc >= 1856, ch = gc - (dir ? 1856 : 1344);
        u32x4 o;
        float lf[8];
#pragma unroll
        for (int e = 0; e < 8; ++e) {
          float lbv = B.lb_()[dir * 512 + ch + e];
          float f = lbv + (1.f - lbv) / (1.f + __expf(-v[e]));
          lf[e] = logf(f);
        }
#pragma unroll
        for (int q = 0; q < 4; ++q) o[q] = (unsigned)f2h(lf[2 * q]) | ((unsigned)f2h(lf[2 * q + 1]) << 16);
        *(u32x4*)(B.LF_() + (size_t)dir * M * 512 + grow * 512 + ch) = o;
      } else if (gc < 2880) {
        *(u32x4*)(B.HI_() + grow * 512 + (gc - 2368)) = pack8(v);
      } else if (gc < 3392) {
        *(u32x4*)(B.HG_() + grow * 512 + (gc - 2880)) = pack8(v);
      }
    }
  } else if (EPI == EPI_UQ) {
    const int b = rowbase / LT, nl0 = rowbase - b * LT - CTX;
#pragma unroll 1
    for (int it = 0; it < 8; ++it) {
      int id = it * 256 + tid, i = id >> 4, cc = id & 15;
      int gc = n0 + cc * 8, head = gc / 192, dd = gc - head * 192, n = nl0 + i;
      float v[8];
#pragma unroll
      for (int e = 0; e < 8; ++e) v[e] = Ct[i * CLD + cc * 8 + e];
      if (dd >= 128) rope8(v, Ct + i * CLD, cc * 8, dd - 128, n, B);
      const float s = rsqrtf(rowss[i] * (1.f / 512.f) + EPS) * QS_MLA;
#pragma unroll
      for (int e = 0; e < 8; ++e) v[e] *= s;
      *(u32x4*)(B.QF_() + ((size_t)(b * 4 + head) * SEQ + n) * 192 + dd) = pack8(v);
    }
  } else if (EPI == EPI_UKV) {
    const int b = rowbase / LT, pos0 = rowbase - b * LT, head = n0 >> 8;
    if ((n0 & 128) == 0) {
#pragma unroll 1
      for (int it = 0; it < 8; ++it) {
        int id = it * 256 + tid, i = id >> 4, cc = id & 15;
        const float s = rsqrtf(rowss[i] * (1.f / 256.f) + EPS);
        float v[8];
#pragma unroll
        for (int e = 0; e < 8; ++e) v[e] = Ct[i * CLD + cc * 8 + e] * s;
        *(u32x4*)(B.KF_() + ((size_t)(b * 4 + head) * LT + pos0 + i) * 192 + cc * 8) = pack8(v);
      }
    } else {
#pragma unroll 1
      for (int it = 0; it < 8; ++it) {
        int id = it * 256 + tid, c = id & 127, rc = id >> 7;
        float v[8];
#pragma unroll
        for (int e = 0; e < 8; ++e)
          v[e] = Ct[(rc * 8 + e) * CLD + c] * rsqrtf(rowss[rc * 8 + e] * (1.f / 256.f) + EPS);
        *(u32x4*)(B.VT1_() + ((size_t)(b * 4 + head) * 128 + c) * LT + pos0 + rc * 8) = pack8(v);
      }
    }
  } else if (EPI == EPI_FFN1) {
    const int nt = n0 >> 7;
    const float* cw = p.in[10] + (size_t)ea.layer * 3 * DFF;
    const float* cb = p.in[11] + (size_t)ea.layer * DFF;
    u16* G = ea.layer ? B.G1_() : B.G0_();
#pragma unroll 1
    for (int it = 0; it < 4; ++it) {
      int id = it * 256 + tid, i = id >> 3, cc = id & 7;
      int grow = rowbase + i;
      if (i >= 1 && i <= 126 && grow < ea.seg_hi) {
        const bool hp = (grow - 1 >= ea.seg_lo), hn = (grow + 1 < ea.seg_hi);
        float v[8];
#pragma unroll
        for (int e = 0; e < 8; ++e) {
          int c = cc * 8 + e, fc = nt * 64 + c;
          float a = Ct[i * CLD + c];
          float ap = hp ? Ct[(i - 1) * CLD + c] : 0.f;
          float an = hn ? Ct[(i + 1) * CLD + c] : 0.f;
          float u = Ct[i * CLD + 64 + c];
          float av = ap * cw[fc] + a * cw[DFF + fc] + an * cw[2 * DFF + fc] + cb[fc];
          v[e] = siluf(av) * u;
        }
        *(u32x4*)(G + (size_t)grow * DFF + nt * 64 + cc * 8) = pack8(v);
      }
    }
  }
}

template <int EPI, bool SUMSQ>
DI void gemm_tile(char* smem, const Params& p, const Bufs& B, const u16* __restrict__ A, int lda, int rowbase,
                  int rlo, int rhi, const u16* __restrict__ Bt, int K, int n0, const EpiArgs& ea) {
  u16* As = (u16*)smem;
  u16* Bs = As + 2 * 128 * LDT;
  float* Ct = (float*)smem;
  float* rowss = Ct + 128 * CLD;
  const int tid = threadIdx.x, lane = tid & 63, wid = tid >> 6, wm = wid >> 1, wn = wid & 1, r = lane & 31,
            h = lane >> 5;
  const int lrow = tid >> 3, lkc = tid & 7;
  int aoff[4], boff[4];
#pragma unroll
  for (int it = 0; it < 4; ++it) {
    int gr = rowbase + it * 32 + lrow;
    gr = gr < rlo ? rlo : (gr > rhi - 1 ? rhi - 1 : gr);
    aoff[it] = gr * lda + lkc * 8;
    boff[it] = (n0 + it * 32 + lrow) * K + lkc * 8;
  }
  u32x4 ra[4], rb[4];
  float ssq[4] = {0.f, 0.f, 0.f, 0.f};
  f32x16 acc[2][2];
#pragma unroll
  for (int i = 0; i < 2; ++i)
#pragma unroll
    for (int j = 0; j < 2; ++j)
#pragma unroll
      for (int g = 0; g < 16; ++g) acc[i][j][g] = 0.f;
  const int nk = K >> 6;
#pragma unroll
  for (int it = 0; it < 4; ++it) {
    ra[it] = *(const u32x4*)(A + aoff[it]);
    rb[it] = *(const u32x4*)(Bt + boff[it]);
  }
  for (int t = 0; t < nk; ++t) {
    u16* Aw = As + (t & 1) * 128 * LDT;
    u16* Bw = Bs + (t & 1) * 128 * LDT;
#pragma unroll
    for (int it = 0; it < 4; ++it) {
      *(u32x4*)(Aw + (it * 32 + lrow) * LDT + lkc * 8) = ra[it];
      *(u32x4*)(Bw + (it * 32 + lrow) * LDT + lkc * 8) = rb[it];
      if (SUMSQ) {
#pragma unroll
        for (int q = 0; q < 4; ++q) {
          float lo = bflo(ra[it][q]), hi = bfhi(ra[it][q]);
          ssq[it] += lo * lo + hi * hi;
        }
      }
    }
    __syncthreads();
    if (t + 1 < nk) {
#pragma unroll
      for (int it = 0; it < 4; ++it) {
        ra[it] = *(const u32x4*)(A + aoff[it] + (t + 1) * 64);
        rb[it] = *(const u32x4*)(Bt + boff[it] + (t + 1) * 64);
      }
    }
    mma_ktile(Aw, Bw, acc, wm, wn, r, h);
  }
  __syncthreads();
  acc_to_lds(Ct, acc, wm, wn, r, h);
  if (SUMSQ) {
#pragma unroll
    for (int it = 0; it < 4; ++it) {
      float s = ssq[it];
      s += __shfl_xor(s, 1); s += __shfl_xor(s, 2); s += __shfl_xor(s, 4);
      if (lkc == 0) rowss[it * 32 + lrow] = s;
    }
  }
  __syncthreads();
  epilogue<EPI>(p, B, Ct, rowss, rowbase, n0, ea);
  __syncthreads();
}

DI void pool_tile(char* smem, const Params& p, const Bufs& B, int rt, int g) {
  u16* As = (u16*)smem;
  u16* Bs = As + 2 * 128 * LDT;
  float* Ct = (float*)smem;
  const int tid = threadIdx.x, lane = tid & 63, wid = tid >> 6, wm = wid >> 1, wn = wid & 1, r = lane & 31,
            h = lane >> 5;
  const int rowbase = rt * 128;
  const int b = rowbase / LT, pos0 = rowbase - b * LT;
  const int seg_lo = (pos0 < CTX) ? b * LT : b * LT + CTX;
  const int seg_hi = (pos0 < CTX) ? b * LT + CTX : (b + 1) * LT;
#pragma unroll
  for (int it = 0; it < 8; ++it) {
    int c = it * 256 + tid, n = c >> 4, kc = c & 15;
    u32x4 v = *(const u32x4*)(B.wt_pool_() + (size_t)g * 128 * 128 + n * 128 + kc * 8);
    *(u32x4*)(Bs + (kc >> 3) * 128 * LDT + n * LDT + (kc & 7) * 8) = v;
  }
  {
    const int ch = tid & 127, rh = tid >> 7, hw = 1 << g;
    const u16* Ucol = B.U_() + g * 128 + ch;
    const int t0 = rowbase + rh * 64;
    int lo = max(t0 - hw, seg_lo), hi = min(t0 + hw, seg_hi);
    float sum = 0.f;
    for (int s = lo; s < hi; ++s) sum += bf2f(Ucol[(size_t)s * 512]);
    u16* Ad = As + (ch >> 6) * 128 * LDT + (ch & 63);
    for (int i = 0; i < 64; ++i) {
      int t = t0 + i;
      float cnt = (float)(hi - lo);
      float d = sum / cnt - bf2f(Ucol[(size_t)t * 512]);
      Ad[(rh * 64 + i) * LDT] = f2bf(d);
      if (t + hw < seg_hi) { sum += bf2f(Ucol[(size_t)(t + hw) * 512]); hi = t + hw + 1; }
      if (t - hw >= seg_lo) { sum -= bf2f(Ucol[(size_t)(t - hw) * 512]); lo = t - hw + 1; }
    }
  }
  __syncthreads();
  f32x16 acc[2][2];
#pragma unroll
  for (int i = 0; i < 2; ++i)
#pragma unroll
    for (int j = 0; j < 2; ++j)
#pragma unroll
      for (int q = 0; q < 16; ++q) acc[i][j][q] = 0.f;
  mma_ktile(As, Bs, acc, wm, wn, r, h);
  mma_ktile(As + 128 * LDT, Bs + 128 * LDT, acc, wm, wn, r, h);
  __syncthreads();
  acc_to_lds(Ct, acc, wm, wn, r, h);
  __syncthreads();
  EpiArgs ea{}; ea.aux = g;
  epilogue<EPI_POOL>(p, B, Ct, nullptr, rowbase, 0, ea);
  __syncthreads();
}

template <int DQK, int KT>
DI void attn_pass(char* smem, const u16* __restrict__ Qg, const u16* __restrict__ Kg, const u16* __restrict__ VTg,
                  int nk, f32x16 (&O)[4], float& l_out) {
  constexpr int KLD = DQK + 8, NKS = DQK / 16, KCH = DQK / 8, KPT = KT * KCH / 256, VLD = KT + 8, VPT = KT / 16,
                KB = KT / 32, VCH = KT / 8;
  u16* Ks = (u16*)smem;
  u16* Vs = Ks + KT * KLD;
  const int tid = threadIdx.x, lane = tid & 63, wid = tid >> 6, r = lane & 31, h = lane >> 5;
  bf16x8 qf[NKS];
#pragma unroll
  for (int ks = 0; ks < NKS; ++ks) qf[ks] = *(const bf16x8*)(Qg + (size_t)(wid * 32 + r) * DQK + ks * 16 + h * 8);
  u32x4 rk[KPT], rv[VPT];
#pragma unroll
  for (int dvb = 0; dvb < 4; ++dvb)
#pragma unroll
    for (int g = 0; g < 16; ++g) O[dvb][g] = 0.f;
  float m = -1e30f, l = 0.f;
  const int nt = nk / KT;
  int kgo[KPT], klo[KPT], vgo[VPT], vlo[VPT];
#pragma unroll
  for (int it = 0; it < KPT; ++it) {
    int c = it * 256 + tid, key = c / KCH, kc = c - key * KCH;
    int rho = (key & ~12) | ((key & 4) << 1) | ((key & 8) >> 1);
    kgo[it] = key * DQK + kc * 8;
    klo[it] = rho * KLD + kc * 8;
  }
#pragma unroll
  for (int it = 0; it < VPT; ++it) {
    int c = it * 256 + tid, dv = c / VCH, kc = c - dv * VCH;
    vgo[it] = dv * LT + kc * 8;
    vlo[it] = dv * VLD + kc * 8;
  }
#pragma unroll
  for (int it = 0; it < KPT; ++it) rk[it] = *(const u32x4*)(Kg + kgo[it]);
#pragma unroll
  for (int it = 0; it < VPT; ++it) rv[it] = *(const u32x4*)(VTg + vgo[it]);
  for (int t = 0; t < nt; ++t) {
    __syncthreads();
#pragma unroll
    for (int it = 0; it < KPT; ++it) *(u32x4*)(Ks + klo[it]) = rk[it];
#pragma unroll
    for (int it = 0; it < VPT; ++it) *(u32x4*)(Vs + vlo[it]) = rv[it];
    __syncthreads();
    if (t + 1 < nt) {
      const u16* Kn = Kg + (size_t)(t + 1) * KT * DQK;
      const u16* Vn = VTg + (t + 1) * KT;
#pragma unroll
      for (int it = 0; it < KPT; ++it) rk[it] = *(const u32x4*)(Kn + kgo[it]);
#pragma unroll
      for (int it = 0; it < VPT; ++it) rv[it] = *(const u32x4*)(Vn + vgo[it]);
    }
    f32x16 S[KB];
#pragma unroll
    for (int kb = 0; kb < KB; ++kb) {
#pragma unroll
      for (int g = 0; g < 16; ++g) S[kb][g] = 0.f;
#pragma unroll
      for (int ks = 0; ks < NKS; ++ks) {
        bf16x8 a = *(const bf16x8*)(Ks + (kb * 32 + r) * KLD + ks * 16 + h * 8);
        S[kb] = MFMA32(a, qf[ks], S[kb]);
      }
    }
    float mx = -1e30f;
#pragma unroll
    for (int kb = 0; kb < KB; ++kb)
#pragma unroll
      for (int g = 0; g < 16; ++g) mx = fmaxf(mx, S[kb][g]);
    mx = fmaxf(mx, __shfl_xor(mx, 32));
    const float mn = fmaxf(m, mx);
    const float alpha = __builtin_amdgcn_exp2f(m - mn);
    m = mn;
    float ps = 0.f;
#pragma unroll
    for (int kb = 0; kb < KB; ++kb)
#pragma unroll
      for (int g = 0; g < 16; ++g) {
        float pv = __builtin_amdgcn_exp2f(S[kb][g] - mn);
        S[kb][g] = pv;
        ps += pv;
      }
    l = l * alpha + ps;
#pragma unroll
    for (int dvb = 0; dvb < 4; ++dvb)
#pragma unroll
      for (int g = 0; g < 16; ++g) O[dvb][g] *= alpha;
    bf16x8 pf[KB][2];
#pragma unroll
    for (int kb = 0; kb < KB; ++kb)
#pragma unroll
      for (int s = 0; s < 2; ++s) {
        u32x4 o;
#pragma unroll
        for (int q = 0; q < 4; ++q) o[q] = pk2(S[kb][8 * s + 2 * q], S[kb][8 * s + 2 * q + 1]);
        pf[kb][s] = __builtin_bit_cast(bf16x8, o);
      }
#pragma unroll
    for (int dvb = 0; dvb < 4; ++dvb) {
#pragma unroll
      for (int kb = 0; kb < KB; ++kb)
#pragma unroll
        for (int s = 0; s < 2; ++s) {
          bf16x8 a = *(const bf16x8*)(Vs + (dvb * 32 + r) * VLD + kb * 32 + s * 16 + h * 8);
          O[dvb] = MFMA32(a, pf[kb][s], O[dvb]);
        }
      if (dvb & 1) asm volatile("" ::: "memory");
    }
  }
  l_out = l + __shfl_xor(l, 32);
}

DI void diff_attn_item(char* smem, const Params& p, const Bufs& B, int b, int vh, int pos0, int nk) {
  const int tid = threadIdx.x, lane = tid & 63, wid = tid >> 6, r = lane & 31, h = lane >> 5;
  f32x16 O[4];
  unsigned* Okl = (unsigned*)(smem + 40960);
  const float lam = B.lam_()[0];
  const u16* VT = B.VT0_() + (size_t)(b * 4 + vh) * 128 * LT;
  float ss = 0.f;
#pragma unroll
  for (int e = 0; e < 2; ++e) {
    const int head = 2 * vh + e;
    const u16* Q = B.Q0_() + ((size_t)(b * 8 + head) * LT + pos0) * 64;
    const u16* K = B.K0_() + (size_t)(b * 8 + head) * LT * 64;
    float l;
    attn_pass<64, 64>(smem, Q, K, VT, nk, O, l);
    const float inv = 1.f / l;
    if (e == 0) {
#pragma unroll
      for (int dvb = 0; dvb < 4; ++dvb)
#pragma unroll
        for (int q = 0; q < 8; ++q) Okl[(dvb * 8 + q) * 256 + tid] = pk2(O[dvb][2 * q] * inv, O[dvb][2 * q + 1] * inv);
    } else {
#pragma unroll
      for (int dvb = 0; dvb < 4; ++dvb)
#pragma unroll
        for (int q = 0; q < 8; ++q) {
          unsigned o0 = Okl[(dvb * 8 + q) * 256 + tid];
          float a0 = bflo(o0) - lam * (O[dvb][2 * q] * inv), a1 = bfhi(o0) - lam * (O[dvb][2 * q + 1] * inv);
          O[dvb][2 * q] = a0; O[dvb][2 * q + 1] = a1;
          ss += a0 * a0 + a1 * a1;
        }
    }
  }
  ss += __shfl_xor(ss, 32);
  const float rstd = rsqrtf(ss * (1.f / 128.f) + EPS) * 0.8f;
  const float* sub = p.in[17];
  u16* orow = B.MIX0_() + (size_t)(b * LT + pos0 + wid * 32 + r) * 1024 + 512 + vh * 128;
#pragma unroll
  for (int dvb = 0; dvb < 4; ++dvb)
#pragma unroll
    for (int g = 0; g < 4; ++g) {
      int dv0 = dvb * 32 + 8 * g + 4 * h;
      u32x2 o;
      o[0] = pk2(O[dvb][4 * g] * rstd * sub[dv0], O[dvb][4 * g + 1] * rstd * sub[dv0 + 1]);
      o[1] = pk2(O[dvb][4 * g + 2] * rstd * sub[dv0 + 2], O[dvb][4 * g + 3] * rstd * sub[dv0 + 3]);
      *(u32x2*)(orow + dv0) = o;
    }
}

DI void mla_attn_item(char* smem, const Bufs& B, int b, int hd, int qt) {
  const int lane = threadIdx.x & 63, wid = threadIdx.x >> 6, r = lane & 31, h = lane >> 5;
  f32x16 O[4];
  float l;
  const u16* Q = B.QF_() + ((size_t)(b * 4 + hd) * SEQ + qt * 128) * 192;
  const u16* K = B.KF_() + (size_t)(b * 4 + hd) * LT * 192;
  const u16* VT = B.VT1_() + (size_t)(b * 4 + hd) * 128 * LT;
  attn_pass<192, 32>(smem, Q, K, VT, LT, O, l);
  const float inv = 1.f / l;
  u16* orow = B.MIX1_() + (size_t)(b * LT + CTX + qt * 128 + wid * 32 + r) * 1024 + hd * 128;
#pragma unroll
  for (int dvb = 0; dvb < 4; ++dvb)
#pragma unroll
    for (int g = 0; g < 4; ++g) {
      int dv0 = dvb * 32 + 8 * g + 4 * h;
      u32x2 o;
      o[0] = pk2(O[dvb][4 * g] * inv, O[dvb][4 * g + 1] * inv);
      o[1] = pk2(O[dvb][4 * g + 2] * inv, O[dvb][4 * g + 3] * inv);
      *(u32x2*)(orow + dv0) = o;
    }
}

constexpr int HLD = 136;
DI void hgrn_item(char* smem, const Bufs& B, int b, int hd, int dir) {
  u16* Qs = (u16*)smem;
  u16* Ksm = Qs + 64 * HLD;
  u16* KsT = Ksm + 64 * HLD;
  u16* VsT = KsT + 128 * LDT;
  float* emid = (float*)(VsT + 128 * LDT);
  float* ecm = emid + 128;
  const int tid = threadIdx.x, lane = tid & 63, w = tid >> 6, r = lane & 31, h = lane >> 5;
  f32x16 S[4];
#pragma unroll
  for (int kb = 0; kb < 4; ++kb)
#pragma unroll
    for (int g = 0; g < 16; ++g) S[kb][g] = 0.f;
  const u16* LFd = B.LF_() + (size_t)dir * M * 512;
  u16* OHd = B.OH_() + (size_t)dir * M * 512;
  for (int ci = 0; ci < 68; ++ci) {
    const int c = dir ? (ci < 4 ? 3 - ci : 71 - ci) : ci;
    const int rowc = b * LT + c * 64;
#pragma unroll
    for (int it = 0; it < 4; ++it) {
      int cid = it * 256 + tid, pp = cid >> 4, cc = cid & 15;
      size_t grow = (size_t)(rowc + (dir ? 63 - pp : pp));
      u32x4 qv = *(const u32x4*)(B.HQ_() + grow * 512 + hd * 128 + cc * 8);
      u32x4 lv = *(const u32x4*)(LFd + grow * 512 + hd * 128 + cc * 8);
      u32x4 vv = *(const u32x4*)(B.HI_() + grow * 512 + hd * 128 + cc * 8);
      *(u32x4*)(Qs + pp * HLD + cc * 8) = qv;
      *(u32x4*)(Ksm + pp * HLD + cc * 8) = lv;
#pragma unroll
      for (int q = 0; q < 4; ++q) {
        VsT[(cc * 8 + 2 * q) * LDT + pp] = (u16)(vv[q] & 0xffffu);
        VsT[(cc * 8 + 2 * q + 1) * LDT + pp] = (u16)(vv[q] >> 16);
      }
    }
    __syncthreads();
    {
      const int ch = tid & 127, half = tid >> 7;
      float tot0 = 0.f;
      for (int pp = 0; pp < 32; ++pp) tot0 += h2f(Ksm[pp * HLD + ch]);
      __syncthreads();
      float run = half ? 0.f : -tot0;
#pragma unroll
      for (int p8 = 0; p8 < 4; ++p8) {
        float kt[8];
#pragma unroll
        for (int e = 0; e < 8; ++e) {
          int pp = half * 32 + p8 * 8 + e;
          float lf = h2f(Ksm[pp * HLD + ch]);
          run += lf;
          float q = bf2f(Qs[pp * HLD + ch]);
          float er = __expf(run);
          Qs[pp * HLD + ch] = f2bf(q * er);
          kt[e] = (1.f - __expf(lf)) / er;
          Ksm[pp * HLD + ch] = f2bf(kt[e]);
        }
        *(u32x4*)(KsT + ch * LDT + half * 32 + p8 * 8) = pack8(kt);
      }
      if (half == 0) emid[ch] = __expf(tot0); else ecm[ch] = __expf(run);
    }
    __syncthreads();
    bf16x8 xa[4][2];
#pragma unroll
    for (int kb = 0; kb < 4; ++kb) {
#pragma unroll
      for (int g = 0; g < 16; ++g) S[kb][g] *= emid[kb * 32 + crow(g, h)];
#pragma unroll
      for (int s = 0; s < 2; ++s) {
        u32x4 o;
#pragma unroll
        for (int q = 0; q < 4; ++q) o[q] = pk2(S[kb][8 * s + 2 * q], S[kb][8 * s + 2 * q + 1]);
        xa[kb][s] = __builtin_bit_cast(bf16x8, o);
      }
    }
#pragma unroll
    for (int tb = 0; tb < 2; ++tb) {
      f32x16 oT;
#pragma unroll
      for (int g = 0; g < 16; ++g) oT[g] = 0.f;
#pragma unroll
      for (int kb = 0; kb < 4; ++kb)
#pragma unroll
        for (int s = 0; s < 2; ++s) {
          const u16* qp = Qs + (tb * 32 + r) * HLD + kb * 32 + s * 16 + 4 * h;
          u32x2 lo = *(const u32x2*)qp, hi = *(const u32x2*)(qp + 8);
          u32x4 bq = {lo[0], lo[1], hi[0], hi[1]};
          oT = MFMA32(xa[kb][s], __builtin_bit_cast(bf16x8, bq), oT);
        }
#pragma unroll
      for (int sb = 0; sb <= tb; ++sb) {
        f32x16 P;
#pragma unroll
        for (int g = 0; g < 16; ++g) P[g] = 0.f;
#pragma unroll
        for (int ks = 0; ks < 8; ++ks) {
          bf16x8 a = *(const bf16x8*)(Ksm + (sb * 32 + r) * HLD + ks * 16 + h * 8);
          bf16x8 bb = *(const bf16x8*)(Qs + (tb * 32 + r) * HLD + ks * 16 + h * 8);
          P = MFMA32(a, bb, P);
        }
        if (sb == tb) {
#pragma unroll
          for (int g = 0; g < 16; ++g) P[g] = (crow(g, h) <= r) ? P[g] : 0.f;
        }
#pragma unroll
        for (int s = 0; s < 2; ++s) {
          u32x4 o;
#pragma unroll
          for (int q = 0; q < 4; ++q) o[q] = pk2(P[8 * s + 2 * q], P[8 * s + 2 * q + 1]);
          const u16* vp = VsT + (w * 32 + r) * LDT + sb * 32 + s * 16 + 4 * h;
          u32x2 lo = *(const u32x2*)vp, hi = *(const u32x2*)(vp + 8);
          u32x4 av = {lo[0], lo[1], hi[0], hi[1]};
          oT = MFMA32(__builtin_bit_cast(bf16x8, av), __builtin_bit_cast(bf16x8, o), oT);
        }
      }
      {
        int pp = tb * 32 + r;
        size_t grow = (size_t)(rowc + (dir ? 63 - pp : pp));
        u16* op = OHd + grow * 512 + hd * 128 + w * 32;
#pragma unroll
        for (int g4 = 0; g4 < 4; ++g4) {
          u32x2 o;
          o[0] = pk2(oT[4 * g4], oT[4 * g4 + 1]);
          o[1] = pk2(oT[4 * g4 + 2], oT[4 * g4 + 3]);
          *(u32x2*)(op + 8 * g4 + 4 * h) = o;
        }
      }
    }
#pragma unroll
    for (int kb = 0; kb < 4; ++kb) {
#pragma unroll
      for (int ts = 0; ts < 4; ++ts) {
        bf16x8 a = *(const bf16x8*)(KsT + (kb * 32 + r) * LDT + ts * 16 + h * 8);
        bf16x8 bb = *(const bf16x8*)(VsT + (w * 32 + r) * LDT + ts * 16 + h * 8);
        S[kb] = MFMA32(a, bb, S[kb]);
      }
#pragma unroll
      for (int g = 0; g < 16; ++g) S[kb][g] *= ecm[kb * 32 + crow(g, h)];
    }
    __syncthreads();
  }
}

DI void hgrn_readout_row(const Params& p, const Bufs& B, int grow, int hd, int lane) {
  const size_t o = (size_t)grow * 512 + hd * 128 + lane * 2;
  unsigned a = *(const unsigned*)(B.OH_() + o), bq = *(const unsigned*)(B.OH_() + (size_t)M * 512 + o);
  unsigned gq = *(const unsigned*)(B.HG_() + o);
  float v0 = bflo(a) + bflo(bq), v1 = bfhi(a) + bfhi(bq);
  float ss = wave_sum(v0 * v0 + v1 * v1);
  float rstd = rsqrtf(ss * (1.f / 128.f) + EPS);
  const float* hn = p.in[23];
  float g0 = bflo(gq), g1 = bfhi(gq);
  unsigned out = pk2(v0 * rstd * hn[lane * 2] * siluf(g0), v1 * rstd * hn[lane * 2 + 1] * siluf(g1));
  *(unsigned*)(B.MIX1_() + (size_t)grow * 1024 + 512 + hd * 128 + lane * 2) = out;
}

constexpr int NPHASE = 18;

DI int lat_rowbase(int rt) { return (rt >> 5) * LT + CTX + (rt & 31) * 128; }

DI void run_phase(int ph, const Params& p, const Bufs& B, char* smem) {
  const int bid = blockIdx.x, nb = gridDim.x, tid = threadIdx.x, lane = tid & 63, wid = tid >> 6;
  switch (ph) {
    case 0: {
      const int n = NW_P0 + 192 + 1;
      for (int it = bid; it < n; it += nb) {
        if (it < NW_P0) prep_weight_item(smem, p, B, it);
        else if (it < NW_P0 + 192) mod_gemv_item(smem, p, B, it - NW_P0);
        else tables_item(p, B);
      }
    } break;
    case 1: {
      for (int it = bid; it < M / 32; it += nb) {
        for (int rr = 0; rr < 8; ++rr) {
          int row = it * 32 + rr * 4 + wid;
          RowInfo ri = row_info(row);
          const float* x = (ri.lat ? p.in[0] : p.in[2]) + resid_off(ri);
          const float* md = B.mod_() + (size_t)(0 * 9 + ri.mi) * 6144;
          norm_mod_row(x, p.in[6] + 0, md, md + 1024, B.H_() + (size_t)row * 1024, lane);
        }
      }
    } break;
    case 2: {
      const int n = 272 * 16;
      EpiArgs ea{};
      for (int it = bid; it < n; it += nb) {
        int rt = it >> 4, nt = it & 15;
        gemm_tile<EPI_IN0, false>(smem, p, B, B.H_(), 1024, rt * 128, 0, M, B.wt_ev_(), 1024, nt * 128, ea);
      }
    } break;
    case 3: {
      const int n_lat = 8 * 4 * 32, n_ctx = 8 * 4 * 2, n_pool = 272 * 4;
      for (int it = bid; it < n_lat; it += nb) {
        int b = it >> 7, vh = (it >> 5) & 3, qt = it & 31;
        diff_attn_item(smem, p, B, b, vh, CTX + qt * 128, LT);
      }
      for (int it = nb - 1 - bid; it < n_ctx; it += nb) {
        int b = it >> 3, vh = (it >> 1) & 3, qt = it & 1;
        diff_attn_item(smem, p, B, b, vh, qt * 128, CTX);
      }
      for (int it = nb - 1 - bid; it < n_pool; it += nb) pool_tile(smem, p, B, it >> 2, it & 3);
    } break;
    case 4: {
      EpiArgs ea{}; ea.outf = B.Y0_();
      for (int it = bid; it < 272 * 8; it += nb) {
        int rt = it >> 3, nt = it & 7;
        gemm_tile<EPI_F32, false>(smem, p, B, B.MIX0_(), 1024, rt * 128, 0, M, B.wt_out_(), 1024, nt * 128, ea);
      }
    } break;
    case 5: case 8: {
      const bool first = (ph == 5);
      const float* Yb = B.Y0_();
      for (int it = bid; it < M / 32; it += nb) {
        for (int rr = 0; rr < 8; ++rr) {
          int row = it * 32 + rr * 4 + wid;
          RowInfo ri = row_info(row);
          size_t ro = resid_off(ri);
          const float* md0 = B.mod_() + (size_t)(0 * 9 + ri.mi) * 6144;
          const float* md1 = B.mod_() + (size_t)(1 * 9 + ri.mi) * 6144;
          float* xd = (ri.lat ? p.out : B.xc_()) + ro;
          if (first) {
            const float* xs = (ri.lat ? p.in[0] : p.in[2]) + ro;
            resid_row<true>(Yb + (size_t)row * 1024, xs, xd, md0 + 2 * 1024, p.in[6] + 1 * 1024, p.in[6] + 2 * 1024,
                            md0 + 3 * 1024, md0 + 4 * 1024, B.H_() + (size_t)row * 1024, lane);
          } else {
            resid_row<true>(Yb + (size_t)row * 1024, xd, xd, md0 + 5 * 1024, p.in[6] + 3 * 1024,
                            p.in[6] + 4 * 1024 + 0, md1, md1 + 1024, B.H_() + (size_t)row * 1024, lane);
          }
        }
      }
    } break;
    case 6: {
      const int n = 288 * 44;
      for (int it = bid; it < n; it += nb) {
        int rtile = it / 44, nt = it - rtile * 44;
        int b = rtile / 36, jj = rtile - b * 36;
        EpiArgs ea{}; ea.layer = 0;
        int j;
        if (jj < 3) { ea.seg_lo = b * LT; ea.seg_hi = b * LT + CTX; j = jj; }
        else { ea.seg_lo = b * LT + CTX; ea.seg_hi = (b + 1) * LT; j = jj - 3; }
        gemm_tile<EPI_FFN1, false>(smem, p, B, B.H_(), 1024, ea.seg_lo + 126 * j - 1, ea.seg_lo, ea.seg_hi, B.wt_f1_(), 1024,
                                   nt * 128, ea);
      }
    } break;
    case 7: {
      EpiArgs ea{}; ea.outf = B.Y0_();
      for (int it = bid; it < 272 * 8; it += nb) {
        int rt = it >> 3, nt = it & 7;
        gemm_tile<EPI_F32, false>(smem, p, B, B.G0_(), DFF, rt * 128, 0, M, B.wt_f2_(), DFF, nt * 128, ea);
      }
    } break;
    case 9: {
      const int n = 272 * 27;
      EpiArgs ea{};
      for (int it = bid; it < n; it += nb) {
        int rt = it / 27, nt = it - rt * 27;
        gemm_tile<EPI_IN1, false>(smem, p, B, B.H_(), 1024, rt * 128, 0, M, B.wt_od_(), 1024, nt * 128, ea);
      }
    } break;
    case 10: {
      const int n_q = 256 * 6, n_kv = 272 * 8;
      EpiArgs ea{};
      for (int it = bid; it < n_q; it += nb) {
        int rt = it / 6, nt = it - rt * 6;
        gemm_tile<EPI_UQ, true>(smem, p, B, B.CQ_(), 512, lat_rowbase(rt), 0, M, B.wt_uq_(), 512, nt * 128, ea);
      }
      for (int it = bid; it < n_kv; it += nb) {
        int rt = it >> 3, nt = it & 7;
        gemm_tile<EPI_UKV, true>(smem, p, B, B.CKV_(), 256, rt * 128, 0, M, B.wt_ukv_(), 256, nt * 128, ea);
      }
      for (int it = nb - 1 - bid; it < NW_FFN; it += nb) ffn_weight_item(smem, p, B, 1, it);
    } break;
    case 11: {
      const int n_h = 64, n_a = 8 * 4 * 32;
      for (int it = bid; it < n_h; it += nb) hgrn_item(smem, B, it >> 3, (it >> 1) & 3, it & 1);
      for (int it = nb - 1 - bid; it < n_a; it += nb) mla_attn_item(smem, B, it >> 7, (it >> 5) & 3, it & 31);
    } break;
    case 12: {
      const int n = NB * SEQ * 4 / 4;
      for (int it = bid; it < n; it += nb) {
        int j = it * 4 + wid, rl = j >> 2, hd = j & 3;
        int grow = (rl >> 12) * LT + CTX + (rl & 4095);
        hgrn_readout_row(p, B, grow, hd, lane);
      }
    } break;
    case 13: {
      EpiArgs ea{}; ea.outf = B.Y1_();
      for (int it = bid; it < 256 * 8; it += nb) {
        int rt = it >> 3, nt = it & 7;
        gemm_tile<EPI_F32, false>(smem, p, B, B.MIX1_(), 1024, lat_rowbase(rt), 0, M, B.wt_out_() + 1024 * 1024, 1024,
                                  nt * 128, ea);
      }
    } break;
    case 14: case 17: {
      const bool first = (ph == 14);
      for (int it = bid; it < NB * SEQ / 32; it += nb) {
        for (int rr = 0; rr < 8; ++rr) {
          int rl = it * 32 + rr * 4 + wid;
          int bb = rl >> 12, row = bb * LT + CTX + (rl & 4095);
          float* xd = p.out + (size_t)rl * 1024;
          const float* md1 = B.mod_() + (size_t)(1 * 9 + bb) * 6144;
          const float* ng = p.in[6] + 4 * 1024;
          if (first)
            resid_row<true>(B.Y1_() + (size_t)row * 1024, xd, xd, md1 + 2 * 1024, ng + 1 * 1024, ng + 2 * 1024,
                            md1 + 3 * 1024, md1 + 4 * 1024, B.H_() + (size_t)row * 1024, lane);
          else
            resid_row<false>(B.Y1_() + (size_t)row * 1024, xd, xd, md1 + 5 * 1024, ng + 3 * 1024, nullptr, nullptr, nullptr,
                             nullptr, lane);
        }
      }
    } break;
    case 15: {
      const int n = 264 * 44;
      for (int it = bid; it < n; it += nb) {
        int rtile = it / 44, nt = it - rtile * 44;
        int b = rtile / 33, j = rtile - b * 33;
        EpiArgs ea{}; ea.layer = 1; ea.seg_lo = b * LT + CTX; ea.seg_hi = (b + 1) * LT;
        gemm_tile<EPI_FFN1, false>(smem, p, B, B.H_(), 1024, ea.seg_lo + 126 * j - 1, ea.seg_lo, ea.seg_hi, B.wt_f1_(), 1024,
                                   nt * 128, ea);
      }
    } break;
    case 16: {
      EpiArgs ea{}; ea.outf = B.Y1_();
      for (int it = bid; it < 256 * 8; it += nb) {
        int rt = it >> 3, nt = it & 7;
        gemm_tile<EPI_F32, false>(smem, p, B, B.G1_(), DFF, lat_rowbase(rt), 0, M, B.wt_f2_(), DFF, nt * 128, ea);
      }
    } break;
    default: break;
  }
}

#define RUNPH(k)                                                   \
  if (p.ph_lo <= (k) && (k) < p.ph_hi) {                           \
    run_phase((k), p, B, smem);                                    \
    if ((k) + 1 < p.ph_hi) cg::this_grid().sync();                 \
  }
__global__ void __launch_bounds__(NTHR, 2) fwd_megakernel(Params p) {
  extern __shared__ __attribute__((aligned(16))) char smem[];
  const Bufs B = make_bufs(p.ws);
  RUNPH(0) RUNPH(1) RUNPH(2) RUNPH(3) RUNPH(4) RUNPH(5) RUNPH(6) RUNPH(7) RUNPH(8)
  RUNPH(9) RUNPH(10) RUNPH(11) RUNPH(12) RUNPH(13) RUNPH(14) RUNPH(15) RUNPH(16) RUNPH(17)
}

constexpr bool ONE_LAUNCH = true;

extern "C" void kernel_launch(void* const* d_in, const int* in_sizes, int n_in, void* d_out, int out_size, void* d_ws,
                              size_t ws_size, hipStream_t stream) {
  static int grid_blocks = 0;
  if (!grid_blocks) {
    int dev = 0, cus = 0, per_cu = 0;
    hipGetDevice(&dev);
    hipDeviceGetAttribute(&cus, hipDeviceAttributeMultiprocessorCount, dev);
    hipFuncSetAttribute((const void*)fwd_megakernel, hipFuncAttributeMaxDynamicSharedMemorySize, SMEM_BYTES);
    hipOccupancyMaxActiveBlocksPerMultiprocessor(&per_cu, fwd_megakernel, NTHR, SMEM_BYTES);
    if (per_cu < 1) per_cu = 1;
    if (per_cu > 2) per_cu = 2;
    grid_blocks = cus * per_cu;
  }
  if (ws_size < WS_NEEDED) {
    fprintf(stderr, "workspace too small: %zu < %zu\n", ws_size, (size_t)WS_NEEDED);
    return;
  }
  Params p{};
  for (int i = 0; i < 25; ++i) p.in[i] = (const float*)d_in[i];
  p.out = (float*)d_out;
  p.ws = (char*)d_ws;
  if (ONE_LAUNCH) {
    p.ph_lo = 0; p.ph_hi = NPHASE;
    void* args[] = {&p};
    hipError_t e = hipLaunchCooperativeKernel((const void*)fwd_megakernel, dim3(grid_blocks), dim3(NTHR), args,
                                              SMEM_BYTES, stream);
    if (e != hipSuccess) fprintf(stderr, "cooperative launch failed: %s (grid %d)\n", hipGetErrorString(e), grid_blocks);
  } else {
    for (int ph = 0; ph < NPHASE; ++ph) {
      p.ph_lo = ph; p.ph_hi = ph + 1;
      hipLaunchKernelGGL(fwd_megakernel, dim3(grid_blocks), dim3(NTHR), SMEM_BYTES, stream, p);
    }
  }
}
```

```cpp
#include <hip/hip_runtime.h>
#include <hip/hip_fp16.h>
#include <hip/hip_cooperative_groups.h>
#include <cstdio>
#include <cstdint>
namespace cg = cooperative_groups;

#define DI __device__ __forceinline__
typedef unsigned short u16;
typedef __attribute__((ext_vector_type(8))) short bf16x8;
typedef __attribute__((ext_vector_type(16))) float f32x16;
typedef __attribute__((ext_vector_type(4))) unsigned u32x4;
typedef __attribute__((ext_vector_type(2))) unsigned u32x2;

constexpr int D = 1024, NB = 8, SEQ = 4096, CTX = 256, LT = 4352, M = NB * LT, DFF = 2816;
constexpr float EPS = 1e-6f;
constexpr float LOG2E = 1.4426950408889634f;
constexpr float QS_DIFF = 0.125f * LOG2E;
constexpr float QS_MLA = 0.07216878364870323f * LOG2E;
constexpr int NTHR = 256;

constexpr size_t SZ_WT_OUT = 2ull * 1024 * 1024 * 2;
constexpr size_t SZ_WT_F1 = 5632ull * 1024 * 2;
constexpr size_t SZ_WT_F2 = 1024ull * 2816 * 2;
constexpr size_t SZ_WT_EV = 2048ull * 1024 * 2;
constexpr size_t SZ_WT_OD = 3456ull * 1024 * 2;
constexpr size_t SZ_WT_UQ = 768ull * 512 * 2;
constexpr size_t SZ_WT_UKV = 1024ull * 256 * 2;
constexpr size_t SZ_WT_POOL = 4ull * 128 * 128 * 2;
constexpr size_t SZ_MOD = 2ull * 9 * 6144 * 4;
constexpr size_t SZ_ROPE = 2ull * 1024 * 4;
constexpr size_t SZ_LB = 1024 * 4;
constexpr size_t SZ_LAM = 256;
constexpr size_t SZ_XC = 2048ull * 1024 * 4;
constexpr size_t SZ_H = (size_t)M * 1024 * 2;
constexpr size_t SZ_M512 = (size_t)M * 512 * 2;

constexpr size_t OFF_WT_OUT = 0;
constexpr size_t OFF_WT_F1 = OFF_WT_OUT + SZ_WT_OUT;
constexpr size_t OFF_WT_F2 = OFF_WT_F1 + SZ_WT_F1;
constexpr size_t OFF_WT_EV = OFF_WT_F2 + SZ_WT_F2;
constexpr size_t OFF_WT_OD = OFF_WT_EV + SZ_WT_EV;
constexpr size_t OFF_WT_UQ = OFF_WT_OD + SZ_WT_OD;
constexpr size_t OFF_WT_UKV = OFF_WT_UQ + SZ_WT_UQ;
constexpr size_t OFF_WT_POOL = OFF_WT_UKV + SZ_WT_UKV;
constexpr size_t OFF_MOD = OFF_WT_POOL + SZ_WT_POOL;
constexpr size_t OFF_ROPE = OFF_MOD + SZ_MOD;
constexpr size_t OFF_LB = OFF_ROPE + SZ_ROPE;
constexpr size_t OFF_LAM = OFF_LB + SZ_LB;
constexpr size_t OFF_XC = OFF_LAM + SZ_LAM;
constexpr size_t OFF_H = OFF_XC + SZ_XC;
constexpr size_t OFF_R = OFF_H + SZ_H;
constexpr size_t R_U = 0;
constexpr size_t R_Q0 = R_U + SZ_M512;
constexpr size_t R_K0 = R_Q0 + SZ_M512;
constexpr size_t R_VT0 = R_K0 + SZ_M512;
constexpr size_t R_MIX0 = R_VT0 + SZ_M512;
constexpr size_t R_Y0 = R_MIX0 + SZ_H;
constexpr size_t R_G0 = 0;
constexpr size_t R_MIX1 = 0;
constexpr size_t R_CQ = 0;
constexpr size_t R_CKV = SZ_M512;
constexpr size_t R_KF = SZ_H;
constexpr size_t SZ_KF = 8ull * 4 * LT * 192 * 2;
constexpr size_t R_VT1 = R_KF + SZ_KF;
constexpr size_t R_HQ = R_VT1 + SZ_M512;
constexpr size_t R_LF = R_HQ + SZ_M512;
constexpr size_t R_HI = R_LF + 2 * SZ_M512;
constexpr size_t R_HG = R_HI + SZ_M512;
constexpr size_t R_OH = R_HG + SZ_M512;
constexpr size_t R_END1 = R_OH + 2 * SZ_M512;
constexpr size_t R_Y1 = R_KF;
constexpr size_t SZ_Y = (size_t)M * 1024 * 4;
constexpr size_t R_G1 = R_Y1 + SZ_Y;
constexpr size_t SZ_G = (size_t)M * DFF * 2;
constexpr size_t R_SIZE = (R_G1 + SZ_G > R_END1) ? (R_G1 + SZ_G) : R_END1;
constexpr size_t WS_NEEDED = OFF_R + R_SIZE;
static_assert(R_Y0 + SZ_Y <= R_SIZE, "layer0 region");
static_assert(R_G0 + SZ_G <= R_Y0, "G0 overlap");
static_assert(WS_NEEDED <= 536870912ull, "ws too big");

struct Params {
  const float* in[25];
  float* out;
  char* ws;
  int ph_lo, ph_hi;
};

constexpr int SMEM_BYTES = 73728;
constexpr int LDT = 72;
constexpr int CLD = 132;

DI int otid() { int t = threadIdx.x; asm volatile("" : "+v"(t)); return t; }
DI u16 f2bf(float x) { return __builtin_bit_cast(u16, (__bf16)x); }
DI unsigned pk2(float a, float b) { return (unsigned)f2bf(a) | ((unsigned)f2bf(b) << 16); }
DI float bflo(unsigned u) { return __uint_as_float(u << 16); }
DI float bfhi(unsigned u) { return __uint_as_float(u & 0xffff0000u); }
DI float bf2f(u16 v) { return __uint_as_float(((unsigned)v) << 16); }
DI float h2f(u16 v) { return __half2float(__ushort_as_half(v)); }
DI u16 f2h(float x) { return __half_as_ushort(__float2half(x)); }
DI float siluf(float x) { return x / (1.f + __expf(-x)); }
DI float wave_sum(float v) {
#pragma unroll
  for (int o = 32; o > 0; o >>= 1) v += __shfl_xor(v, o);
  return v;
}
DI u32x4 pack8(const float* v) {
  u32x4 o;
  o[0] = pk2(v[0], v[1]); o[1] = pk2(v[2], v[3]); o[2] = pk2(v[4], v[5]); o[3] = pk2(v[6], v[7]);
  return o;
}
DI int crow(int reg, int h) { return (reg & 3) + 8 * (reg >> 2) + 4 * h; }
#define MFMA32(a, b, c) __builtin_amdgcn_mfma_f32_32x32x16_bf16((a), (b), (c), 0, 0, 0)

struct Bufs {
  char* ws;
#define BUFP(T, name, off) DI T* name##_() const { return (T*)(ws + (off)); }
  BUFP(u16, wt_out, OFF_WT_OUT) BUFP(u16, wt_f1, OFF_WT_F1) BUFP(u16, wt_f2, OFF_WT_F2) BUFP(u16, wt_ev, OFF_WT_EV)
  BUFP(u16, wt_od, OFF_WT_OD) BUFP(u16, wt_uq, OFF_WT_UQ) BUFP(u16, wt_ukv, OFF_WT_UKV) BUFP(u16, wt_pool, OFF_WT_POOL)
  BUFP(float, mod, OFF_MOD) BUFP(float, ropec, OFF_ROPE) BUFP(float, ropes, OFF_ROPE + 4096) BUFP(float, lb, OFF_LB)
  BUFP(float, lam, OFF_LAM) BUFP(float, xc, OFF_XC) BUFP(u16, H, OFF_H)
  BUFP(u16, U, OFF_R + R_U) BUFP(u16, Q0, OFF_R + R_Q0) BUFP(u16, K0, OFF_R + R_K0) BUFP(u16, VT0, OFF_R + R_VT0)
  BUFP(u16, MIX0, OFF_R + R_MIX0) BUFP(float, Y0, OFF_R + R_Y0) BUFP(u16, G0, OFF_R + R_G0)
  BUFP(u16, CQ, OFF_R + R_CQ) BUFP(u16, CKV, OFF_R + R_CKV) BUFP(u16, MIX1, OFF_R + R_MIX1) BUFP(u16, KF, OFF_R + R_KF)
  BUFP(u16, VT1, OFF_R + R_VT1) BUFP(u16, HQ, OFF_R + R_HQ) BUFP(u16, LF, OFF_R + R_LF) BUFP(u16, HI, OFF_R + R_HI)
  BUFP(u16, HG, OFF_R + R_HG) BUFP(u16, OH, OFF_R + R_OH) BUFP(u16, QF, OFF_H) BUFP(float, Y1, OFF_R + R_Y1)
  BUFP(u16, G1, OFF_R + R_G1)
};
DI Bufs make_bufs(char* ws) { Bufs b; b.ws = ws; return b; }

DI void wt_tile(char* smem, const float* __restrict__ src, int ld, int kt, int ncol0, u16* __restrict__ dst, int K,
                int dst_row0, const float* __restrict__ scale) {
  float* t = (float*)smem;
  const int tid = otid(), col = tid & 63, r0 = tid >> 6;
#pragma unroll 4
  for (int i = 0; i < 16; ++i) {
    int row = i * 4 + r0;
    float v = src[(size_t)(kt * 64 + row) * ld + ncol0 + col];
    if (scale) v *= scale[kt * 64 + row];
    t[row * 65 + col] = v;
  }
  __syncthreads();
#pragma unroll
  for (int it = 0; it < 2; ++it) {
    int c = it * 256 + tid, j = c >> 3, kc = c & 7;
    u32x4 o;
#pragma unroll
    for (int q = 0; q < 4; ++q) o[q] = pk2(t[(kc * 8 + 2 * q) * 65 + j], t[(kc * 8 + 2 * q + 1) * 65 + j]);
    *(u32x4*)(dst + (size_t)(dst_row0 + j) * K + kt * 64 + kc * 8) = o;
  }
  __syncthreads();
}

#define WJOB(SRC, LDD, KK, NN, DST, TS, ROFF, SC)                                        \
  {                                                                                       \
    const int ntn = (NN) / 64, cnt = ((KK) / 64) * ntn;                                   \
    if (idx < cnt) {                                                                      \
      int kt = idx / ntn, nt = idx % ntn;                                                 \
      wt_tile(smem, (SRC), (LDD), kt, nt * 64, (DST), (KK), nt * (TS) + (ROFF), (SC));    \
      return;                                                                             \
    }                                                                                     \
    idx -= cnt;                                                                           \
  }

constexpr int NW_FFN = 704 * 3;
constexpr int NW_P0 = 256 + 256 + NW_FFN + 512 + 848 + 96 + 64 + 16;

DI void ffn_weight_item(char* smem, const Params& p, const Bufs& B, int layer, int idx) {
  WJOB(p.in[8] + (size_t)layer * 1024 * DFF, DFF, 1024, DFF, B.wt_f1_(), 128, 0, nullptr)
  WJOB(p.in[9] + (size_t)layer * 1024 * DFF, DFF, 1024, DFF, B.wt_f1_(), 128, 64, nullptr)
  WJOB(p.in[12] + (size_t)layer * DFF * 1024, 1024, DFF, 1024, B.wt_f2_(), 64, 0, nullptr)
}

DI void prep_weight_item(char* smem, const Params& p, const Bufs& B, int idx) {
  WJOB(p.in[7], 1024, 1024, 1024, B.wt_out_(), 64, 0, nullptr)
  WJOB(p.in[7] + 1024 * 1024, 1024, 1024, 1024, B.wt_out_() + 1024 * 1024, 64, 0, nullptr)
  if (idx < NW_FFN) { ffn_weight_item(smem, p, B, 0, idx); return; }
  idx -= NW_FFN;
  WJOB(p.in[13], 2048, 1024, 2048, B.wt_ev_(), 64, 0, nullptr)
  WJOB(p.in[18], 3392, 1024, 3392, B.wt_od_(), 64, 0, nullptr)
  WJOB(p.in[20], 768, 512, 768, B.wt_uq_(), 64, 0, p.in[19])
  WJOB(p.in[22], 1024, 256, 1024, B.wt_ukv_(), 64, 0, p.in[21])
  {
    int g = idx >> 2, t = idx & 3;
    wt_tile(smem, p.in[14] + g * 128 * 128, 128, t >> 1, (t & 1) * 64, B.wt_pool_() + g * 128 * 128, 128, (t & 1) * 64,
            nullptr);
  }
}

DI void mod_gemv_item(char* smem, const Params& p, const Bufs& B, int idx) {
  const int layer = idx / 96, c0 = (idx % 96) * 64, tid = otid();
  float* sc = (float*)smem;
  float* red = sc + 9 * 1024;
  for (int i = tid; i < 9 * 1024; i += NTHR) {
    int rr = i >> 10, k = i & 1023;
    float v = (rr < 8) ? p.in[1][rr * 1024 + k] : p.in[3][k];
    sc[i] = siluf(v);
  }
  __syncthreads();
  const int cq = tid & 15, kg = tid >> 4;
  float acc[9][4];
#pragma unroll
  for (int a = 0; a < 9; ++a)
#pragma unroll
    for (int e = 0; e < 4; ++e) acc[a][e] = 0.f;
  const float* W = p.in[4] + (size_t)layer * 1024 * 6144 + c0 + cq * 4;
#pragma unroll 4
  for (int kk = 0; kk < 64; ++kk) {
    int k = kg * 64 + kk;
    float4 w = *(const float4*)(W + (size_t)k * 6144);
#pragma unroll
    for (int a = 0; a < 9; ++a) {
      float s = sc[a * 1024 + k];
      acc[a][0] += s * w.x; acc[a][1] += s * w.y; acc[a][2] += s * w.z; acc[a][3] += s * w.w;
    }
  }
#pragma unroll
  for (int a = 0; a < 9; ++a)
#pragma unroll
    for (int e = 0; e < 4; ++e) red[(kg * 9 + a) * 64 + cq * 4 + e] = acc[a][e];
  __syncthreads();
  for (int i = tid; i < 9 * 64; i += NTHR) {
    int a = i >> 6, c = i & 63;
    float s = 0.f;
    for (int g = 0; g < 16; ++g) s += red[(g * 9 + a) * 64 + c];
    B.mod_()[(size_t)(layer * 9 + a) * 6144 + c0 + c] = s + p.in[5][layer * 6144 + c0 + c];
  }
  __syncthreads();
}

DI void tables_item(const Params& p, const Bufs& B) {
  const int tid = otid();
  for (int i = tid; i < 1024; i += NTHR) {
    int pos = i >> 4, f = i & 15;
    float inv = powf(10000.f, -(float)f / 16.f);
    float ang = (float)pos * inv;
    B.ropec_()[i] = cosf(ang);
    B.ropes_()[i] = sinf(ang);
    int dir = i >> 9, ch = i & 511;
    float a0 = p.in[24][(dir * 2 + 0) * 512 + ch], a1 = p.in[24][(dir * 2 + 1) * 512 + ch];
    B.lb_()[i] = 1.f / (1.f + expf(a0 - a1));
  }
  if (tid < 64) {
    const float* L = p.in[16];
    float s1 = wave_sum(L[tid] * L[64 + tid]);
    float s2 = wave_sum(L[128 + tid] * L[192 + tid]);
    if (tid == 0) B.lam_()[0] = expf(s1) - expf(s2) + 0.2f;
  }
  for (int i = tid; i < 64 * 1024 / 8; i += NTHR) {
    u32x4 z = {0u, 0u, 0u, 0u};
    *(u32x4*)(B.wt_od_() + (size_t)3392 * 1024 + i * 8) = z;
  }
}

struct RowInfo { int b, pos, mi; bool lat; };
DI RowInfo row_info(int r) {
  RowInfo ri;
  ri.b = r / LT; ri.pos = r - ri.b * LT; ri.lat = ri.pos >= CTX; ri.mi = ri.lat ? ri.b : 8;
  return ri;
}
DI size_t resid_off(const RowInfo& ri) {
  return ri.lat ? ((size_t)ri.b * SEQ + (ri.pos - CTX)) * 1024 : ((size_t)ri.b * CTX + ri.pos) * 1024;
}

DI void norm_mod_row(const float* __restrict__ x, const float* __restrict__ g, const float* __restrict__ sh,
                     const float* __restrict__ sc, u16* __restrict__ hrow, int lane) {
  float4 v[4];
  float ss = 0.f;
#pragma unroll
  for (int i = 0; i < 4; ++i) {
    v[i] = *(const float4*)(x + i * 256 + lane * 4);
    ss += v[i].x * v[i].x + v[i].y * v[i].y + v[i].z * v[i].z + v[i].w * v[i].w;
  }
  ss = wave_sum(ss);
  const float rstd = rsqrtf(ss * (1.f / 1024.f) + EPS);
#pragma unroll
  for (int i = 0; i < 4; ++i) {
    int c = i * 256 + lane * 4;
    float4 gg = *(const float4*)(g + c), s1 = *(const float4*)(sh + c), s2 = *(const float4*)(sc + c);
    u32x2 o;
    o[0] = pk2(v[i].x * rstd * gg.x * (1.f + s2.x) + s1.x, v[i].y * rstd * gg.y * (1.f + s2.y) + s1.y);
    o[1] = pk2(v[i].z * rstd * gg.z * (1.f + s2.z) + s1.z, v[i].w * rstd * gg.w * (1.f + s2.w) + s1.w);
    *(u32x2*)(hrow + c) = o;
  }
}

template <bool NEXT>
DI void resid_row(const float* __restrict__ y, const float* xs, float* xd, const float* __restrict__ gate,
                  const float* __restrict__ ny, const float* __restrict__ nx, const float* __restrict__ sh,
                  const float* __restrict__ sc, u16* __restrict__ hrow, int lane) {
  float4 v[4];
  float ss = 0.f;
#pragma unroll
  for (int i = 0; i < 4; ++i) {
    v[i] = *(const float4*)(y + i * 256 + lane * 4);
    ss += v[i].x * v[i].x + v[i].y * v[i].y + v[i].z * v[i].z + v[i].w * v[i].w;
  }
  ss = wave_sum(ss);
  const float rstd = rsqrtf(ss * (1.f / 1024.f) + EPS);
  float ss2 = 0.f;
#pragma unroll
  for (int i = 0; i < 4; ++i) {
    int c = i * 256 + lane * 4;
    float4 xv = *(const float4*)(xs + c), gt = *(const float4*)(gate + c), nn = *(const float4*)(ny + c);
    float4 o;
    o.x = xv.x + gt.x * (v[i].x * rstd * nn.x); o.y = xv.y + gt.y * (v[i].y * rstd * nn.y);
    o.z = xv.z + gt.z * (v[i].z * rstd * nn.z); o.w = xv.w + gt.w * (v[i].w * rstd * nn.w);
    *(float4*)(xd + c) = o;
    v[i] = o;
    ss2 += o.x * o.x + o.y * o.y + o.z * o.z + o.w * o.w;
  }
  if (NEXT) {
    ss2 = wave_sum(ss2);
    const float rstd2 = rsqrtf(ss2 * (1.f / 1024.f) + EPS);
#pragma unroll
    for (int i = 0; i < 4; ++i) {
      int c = i * 256 + lane * 4;
      float4 gg = *(const float4*)(nx + c), s1 = *(const float4*)(sh + c), s2 = *(const float4*)(sc + c);
      u32x2 o;
      o[0] = pk2(v[i].x * rstd2 * gg.x * (1.f + s2.x) + s1.x, v[i].y * rstd2 * gg.y * (1.f + s2.y) + s1.y);
      o[1] = pk2(v[i].z * rstd2 * gg.z * (1.f + s2.z) + s1.z, v[i].w * rstd2 * gg.w * (1.f + s2.w) + s1.w);
      *(u32x2*)(hrow + c) = o;
    }
  }
}

enum { EPI_F32 = 0, EPI_IN0, EPI_IN1, EPI_FFN1, EPI_UQ, EPI_UKV, EPI_POOL };

struct EpiArgs {
  float* outf;
  int layer;
  int seg_lo, seg_hi;
  int aux;
};

DI void mma_ktile(const u16* As, const u16* Bs, f32x16 (&acc)[2][2], int wm, int wn, int r, int h) {
#pragma unroll
  for (int ks = 0; ks < 4; ++ks) {
    bf16x8 a[2], b[2];
#pragma unroll
    for (int i = 0; i < 2; ++i) a[i] = *(const bf16x8*)(As + (wm * 64 + i * 32 + r) * LDT + ks * 16 + h * 8);
#pragma unroll
    for (int j = 0; j < 2; ++j) b[j] = *(const bf16x8*)(Bs + (wn * 64 + j * 32 + r) * LDT + ks * 16 + h * 8);
#pragma unroll
    for (int i = 0; i < 2; ++i)
#pragma unroll
      for (int j = 0; j < 2; ++j) acc[i][j] = MFMA32(a[i], b[j], acc[i][j]);
  }
}

DI void acc_to_lds(float* Ct, f32x16 (&acc)[2][2], int wm, int wn, int r, int h) {
#pragma unroll
  for (int i = 0; i < 2; ++i)
#pragma unroll
    for (int j = 0; j < 2; ++j)
#pragma unroll
      for (int g = 0; g < 16; ++g)
        Ct[(wm * 64 + i * 32 + crow(g, h)) * CLD + wn * 64 + j * 32 + r] = acc[i][j][g];
}

DI void rope8(float* v, const float* Ct_row, int cc8, int d, int n, const Bufs& B) {
  const int axis = d >> 5, pa = axis ? (n & 63) : (n >> 6), f0 = d & 15;
  const bool first = (d & 16) == 0;
  const int pc = first ? cc8 + 16 : cc8 - 16;
  const float4 c0 = *(const float4*)(B.ropec_() + pa * 16 + f0), c1 = *(const float4*)(B.ropec_() + pa * 16 + f0 + 4);
  const float4 s0 = *(const float4*)(B.ropes_() + pa * 16 + f0), s1 = *(const float4*)(B.ropes_() + pa * 16 + f0 + 4);
  const float4 x0 = *(const float4*)(Ct_row + pc), x1 = *(const float4*)(Ct_row + pc + 4);
  const float cs[8] = {c0.x, c0.y, c0.z, c0.w, c1.x, c1.y, c1.z, c1.w};
  const float sn[8] = {s0.x, s0.y, s0.z, s0.w, s1.x, s1.y, s1.z, s1.w};
  const float xp[8] = {x0.x, x0.y, x0.z, x0.w, x1.x, x1.y, x1.z, x1.w};
#pragma unroll
  for (int e = 0; e < 8; ++e) v[e] = first ? v[e] * cs[e] - xp[e] * sn[e] : v[e] * cs[e] + xp[e] * sn[e];
}

DI void ld8(float* v, const float* src) {
  const float4 a = *(const float4*)src, b = *(const float4*)(src + 4);
  v[0] = a.x; v[1] = a.y; v[2] = a.z; v[3] = a.w; v[4] = b.x; v[5] = b.y; v[6] = b.z; v[7] = b.w;
}

template <int EPI>
DI void epilogue(const Params& p, const Bufs& B, const float* Ct, const float* rowss, int rowbase, int n0,
                 const EpiArgs& ea) {
  const int tid = otid();
  if (EPI == EPI_F32) {
#pragma unroll 1
    for (int it = 0; it < 8; ++it) {
      int id = it * 256 + tid, i = id >> 4, cc = id & 15;
      float4 v0 = *(const float4*)(Ct + i * CLD + cc * 8), v1 = *(const float4*)(Ct + i * CLD + cc * 8 + 4);
      float* o = ea.outf + (size_t)(rowbase + i) * 1024 + n0 + cc * 8;
      *(float4*)o = v0; *(float4*)(o + 4) = v1;
    }
  } else if (EPI == EPI_POOL) {
#pragma unroll 1
    for (int it = 0; it < 8; ++it) {
      int id = it * 256 + tid, i = id >> 4, cc = id & 15;
      float v[8];
#pragma unroll
      for (int e = 0; e < 8; ++e) v[e] = Ct[i * CLD + cc * 8 + e] * p.in[15][ea.aux * 128 + cc * 8 + e];
      *(u32x4*)(B.MIX0_() + (size_t)(rowbase + i) * 1024 + ea.aux * 128 + cc * 8) = pack8(v);
    }
  } else if (EPI == EPI_IN0) {
    const int seg = n0 >> 9, b = rowbase / LT, pos0 = rowbase - b * LT;
    if (seg == 3) {
#pragma unroll 1
      for (int it = 0; it < 8; ++it) {
        int id = it * 256 + tid, c = id & 127, rc = id >> 7;
        float v[8];
#pragma unroll
        for (int e = 0; e < 8; ++e) v[e] = Ct[(rc * 8 + e) * CLD + c];
        int hc = n0 - 1536 + c, vh = hc >> 7, dv = hc & 127;
        *(u32x4*)(B.VT0_() + ((size_t)(b * 4 + vh) * 128 + dv) * LT + pos0 + rc * 8) = pack8(v);
      }
    } else {
#pragma unroll 1
      for (int it = 0; it < 8; ++it) {
        int id = it * 256 + tid, i = id >> 4, cc = id & 15;
        float v[8];
        ld8(v, Ct + i * CLD + cc * 8);
        if (seg == 0) {
          *(u32x4*)(B.U_() + (size_t)(rowbase + i) * 512 + n0 + cc * 8) = pack8(v);
        } else {
          int hc = n0 - 512 * seg + cc * 8, head = hc >> 6, d = hc & 63, pos = pos0 + i;
          if (pos >= CTX) rope8(v, Ct + i * CLD, cc * 8, d, pos - CTX, B);
          if (seg == 1) {
#pragma unroll
            for (int e = 0; e < 8; ++e) v[e] *= QS_DIFF;
          }
          u16* dst = (seg == 1 ? B.Q0_() : B.K0_()) + ((size_t)(b * 8 + head) * LT + pos) * 64 + d;
          *(u32x4*)dst = pack8(v);
        }
      }
    }
  } else if (EPI == EPI_IN1) {
    const int b = rowbase / LT, pos0 = rowbase - b * LT;
#pragma unroll 1
    for (int it = 0; it < 8; ++it) {
      int id = it * 256 + tid, i = id >> 4, cc = id & 15;
      int gc = n0 + cc * 8, pos = pos0 + i;
      size_t grow = (size_t)(rowbase + i);
      float v[8];
      ld8(v, Ct + i * CLD + cc * 8);
      if (gc < 512) {
        *(u32x4*)(B.CQ_() + grow * 512 + gc) = pack8(v);
      } else if (gc < 768) {
        *(u32x4*)(B.CKV_() + grow * 256 + (gc - 512)) = pack8(v);
      } else if (gc < 832) {
        int d = gc - 768;
        if (pos >= CTX) rope8(v, Ct + i * CLD, cc * 8, d, pos - CTX, B);
        u32x4 o = pack8(v);
#pragma unroll
        for (int hh = 0; hh < 4; ++hh) *(u32x4*)(B.KF_() + ((size_t)(b * 4 + hh) * LT + pos) * 192 + 128 + d) = o;
      } else if (gc < 1344) {
#pragma unroll
        for (int e = 0; e < 8; ++e) v[e] = siluf(v[e]);
        *(u32x4*)(B.HQ_() + grow * 512 + (gc - 832)) = pack8(v);
      } else if (gc < 2368) {
        int dir = gc >= 1856, ch = gc - (dir ? 1856 : 1344);
        u32x4 o;
        float lf[8];
        float lb8[8];
        ld8(lb8, B.lb_() + dir * 512 + ch);
#pragma unroll
        for (int e = 0; e < 8; ++e) {
          float lbv = lb8[e];
          float f = lbv + (1.f - lbv) / (1.f + __expf(-v[e]));
          lf[e] = logf(f);
        }
#pragma unroll
        for (int q = 0; q < 4; ++q) o[q] = (unsigned)f2h(lf[2 * q]) | ((unsigned)f2h(lf[2 * q + 1]) << 16);
        *(u32x4*)(B.LF_() + (size_t)dir * M * 512 + grow * 512 + ch) = o;
      } else if (gc < 2880) {
        *(u32x4*)(B.HI_() + grow * 512 + (gc - 2368)) = pack8(v);
      } else if (gc < 3392) {
        *(u32x4*)(B.HG_() + grow * 512 + (gc - 2880)) = pack8(v);
      }
    }
  } else if (EPI == EPI_UQ) {
    const int b = rowbase / LT, nl0 = rowbase - b * LT - CTX;
#pragma unroll 1
    for (int it = 0; it < 8; ++it) {
      int id = it * 256 + tid, i = id >> 4, cc = id & 15;
      int gc = n0 + cc * 8, head = gc / 192, dd = gc - head * 192, n = nl0 + i;
      float v[8];
      ld8(v, Ct + i * CLD + cc * 8);
      if (dd >= 128) rope8(v, Ct + i * CLD, cc * 8, dd - 128, n, B);
      const float s = rsqrtf(rowss[i] * (1.f / 512.f) + EPS) * QS_MLA;
#pragma unroll
      for (int e = 0; e < 8; ++e) v[e] *= s;
      *(u32x4*)(B.QF_() + ((size_t)(b * 4 + head) * SEQ + n) * 192 + dd) = pack8(v);
    }
  } else if (EPI == EPI_UKV) {
    const int b = rowbase / LT, pos0 = rowbase - b * LT, head = n0 >> 8;
    if ((n0 & 128) == 0) {
#pragma unroll 1
      for (int it = 0; it < 8; ++it) {
        int id = it * 256 + tid, i = id >> 4, cc = id & 15;
        const float s = rsqrtf(rowss[i] * (1.f / 256.f) + EPS);
        float v[8];
#pragma unroll
        for (int e = 0; e < 8; ++e) v[e] = Ct[i * CLD + cc * 8 + e] * s;
        *(u32x4*)(B.KF_() + ((size_t)(b * 4 + head) * LT + pos0 + i) * 192 + cc * 8) = pack8(v);
      }
    } else {
#pragma unroll 1
      for (int it = 0; it < 8; ++it) {
        int id = it * 256 + tid, c = id & 127, rc = id >> 7;
        float v[8];
#pragma unroll
        for (int e = 0; e < 8; ++e)
          v[e] = Ct[(rc * 8 + e) * CLD + c] * rsqrtf(rowss[rc * 8 + e] * (1.f / 256.f) + EPS);
        *(u32x4*)(B.VT1_() + ((size_t)(b * 4 + head) * 128 + c) * LT + pos0 + rc * 8) = pack8(v);
      }
    }
  } else if (EPI == EPI_FFN1) {
    const int nt = n0 >> 7;
    const float* cw = p.in[10] + (size_t)ea.layer * 3 * DFF;
    const float* cb = p.in[11] + (size_t)ea.layer * DFF;
    u16* G = ea.layer ? B.G1_() : B.G0_();
#pragma unroll 1
    for (int it = 0; it < 4; ++it) {
      int id = it * 256 + tid, i = id >> 3, cc = id & 7;
      int grow = rowbase + i;
      if (i >= 1 && i <= 126 && grow < ea.seg_hi) {
        const bool hp = (grow - 1 >= ea.seg_lo), hn = (grow + 1 < ea.seg_hi);
        float a[8], ap[8], an[8], u[8], w0[8], w1[8], w2[8], bb[8], v[8];
        const int fc0 = nt * 64 + cc * 8;
        ld8(a, Ct + i * CLD + cc * 8); ld8(ap, Ct + (i - 1) * CLD + cc * 8); ld8(an, Ct + (i + 1) * CLD + cc * 8);
        ld8(u, Ct + i * CLD + 64 + cc * 8);
        ld8(w0, cw + fc0); ld8(w1, cw + DFF + fc0); ld8(w2, cw + 2 * DFF + fc0); ld8(bb, cb + fc0);
#pragma unroll
        for (int e = 0; e < 8; ++e) {
          float av = (hp ? ap[e] : 0.f) * w0[e] + a[e] * w1[e] + (hn ? an[e] : 0.f) * w2[e] + bb[e];
          v[e] = siluf(av) * u[e];
        }
        *(u32x4*)(G + (size_t)grow * DFF + nt * 64 + cc * 8) = pack8(v);
      }
    }
  }
}

template <int EPI, bool SUMSQ>
DI void gemm_tile(char* smem, const Params& p, const Bufs& B, const u16* __restrict__ A, int lda, int rowbase,
                  int rlo, int rhi, const u16* __restrict__ Bt, int K, int n0, const EpiArgs& ea) {
  u16* As = (u16*)smem;
  u16* Bs = As + 2 * 128 * LDT;
  float* Ct = (float*)smem;
  float* rowss = Ct + 128 * CLD;
  const int tid = otid(), lane = tid & 63, wid = tid >> 6, wm = wid >> 1, wn = wid & 1, r = lane & 31,
            h = lane >> 5;
  const int lrow = tid >> 3, lkc = tid & 7;
  int aoff[4], boff[4];
#pragma unroll
  for (int it = 0; it < 4; ++it) {
    int gr = rowbase + it * 32 + lrow;
    gr = gr < rlo ? rlo : (gr > rhi - 1 ? rhi - 1 : gr);
    aoff[it] = gr * lda + lkc * 8;
    boff[it] = (n0 + it * 32 + lrow) * K + lkc * 8;
  }
  u32x4 ra0[4], rb0[4], ra1[4], rb1[4];
  float ssq[4] = {0.f, 0.f, 0.f, 0.f};
  f32x16 acc[2][2];
#pragma unroll
  for (int i = 0; i < 2; ++i)
#pragma unroll
    for (int j = 0; j < 2; ++j)
#pragma unroll
      for (int g = 0; g < 16; ++g) acc[i][j][g] = 0.f;
  const int nk = K >> 6;
#pragma unroll
  for (int it = 0; it < 4; ++it) {
    ra0[it] = *(const u32x4*)(A + aoff[it]);
    rb0[it] = *(const u32x4*)(Bt + boff[it]);
  }
#pragma unroll
  for (int it = 0; it < 4; ++it) {
    ra1[it] = *(const u32x4*)(A + aoff[it] + 64);
    rb1[it] = *(const u32x4*)(Bt + boff[it] + 64);
  }
#define GEMM_STEP(RA, RB, BUF, TNEXT)                                                  \
  {                                                                                    \
    u16* Aw = As + (BUF) * 128 * LDT;                                                  \
    u16* Bw = Bs + (BUF) * 128 * LDT;                                                  \
    _Pragma("unroll") for (int it = 0; it < 4; ++it) {                                 \
      *(u32x4*)(Aw + (it * 32 + lrow) * LDT + lkc * 8) = RA[it];                       \
      *(u32x4*)(Bw + (it * 32 + lrow) * LDT + lkc * 8) = RB[it];                       \
      if (SUMSQ) {                                                                     \
        _Pragma("unroll") for (int q = 0; q < 4; ++q) {                                \
          float lo = bflo(RA[it][q]), hi = bfhi(RA[it][q]);                            \
          ssq[it] += lo * lo + hi * hi;                                                \
        }                                                                              \
      }                                                                                \
    }                                                                                  \
    __syncthreads();                                                                   \
    if ((TNEXT) < nk) {                                                                \
      _Pragma("unroll") for (int it = 0; it < 4; ++it) {                               \
        RA[it] = *(const u32x4*)(A + aoff[it] + (TNEXT) * 64);                         \
        RB[it] = *(const u32x4*)(Bt + boff[it] + (TNEXT) * 64);                        \
      }                                                                                \
    }                                                                                  \
    mma_ktile(Aw, Bw, acc, wm, wn, r, h);                                              \
  }
  for (int t = 0; t < nk; t += 2) {
    GEMM_STEP(ra0, rb0, 0, t + 2)
    GEMM_STEP(ra1, rb1, 1, t + 3)
  }
#undef GEMM_STEP
  __syncthreads();
  acc_to_lds(Ct, acc, wm, wn, r, h);
  if (SUMSQ) {
#pragma unroll
    for (int it = 0; it < 4; ++it) {
      float s = ssq[it];
      s += __shfl_xor(s, 1); s += __shfl_xor(s, 2); s += __shfl_xor(s, 4);
      if (lkc == 0) rowss[it * 32 + lrow] = s;
    }
  }
  __syncthreads();
  epilogue<EPI>(p, B, Ct, rowss, rowbase, n0, ea);
  __syncthreads();
}

DI void pool_tile(char* smem, const Params& p, const Bufs& B, int rt, int g) {
  u16* As = (u16*)smem;
  u16* Bs = As + 2 * 128 * LDT;
  float* Ct = (float*)smem;
  const int tid = otid(), lane = tid & 63, wid = tid >> 6, wm = wid >> 1, wn = wid & 1, r = lane & 31,
            h = lane >> 5;
  const int rowbase = rt * 128;
  const int b = rowbase / LT, pos0 = rowbase - b * LT;
  const int seg_lo = (pos0 < CTX) ? b * LT : b * LT + CTX;
  const int seg_hi = (pos0 < CTX) ? b * LT + CTX : (b + 1) * LT;
#pragma unroll
  for (int it = 0; it < 8; ++it) {
    int c = it * 256 + tid, n = c >> 4, kc = c & 15;
    u32x4 v = *(const u32x4*)(B.wt_pool_() + (size_t)g * 128 * 128 + n * 128 + kc * 8);
    *(u32x4*)(Bs + (kc >> 3) * 128 * LDT + n * LDT + (kc & 7) * 8) = v;
  }
  {
    const int ch = tid & 127, rh = tid >> 7, hw = 1 << g;
    const u16* Ucol = B.U_() + g * 128 + ch;
    const int t0 = rowbase + rh * 64;
    int lo = max(t0 - hw, seg_lo), hi = min(t0 + hw, seg_hi);
    float sum = 0.f;
    for (int s = lo; s < hi; ++s) sum += bf2f(Ucol[(size_t)s * 512]);
    u16* Ad = As + (ch >> 6) * 128 * LDT + (ch & 63);
    for (int i = 0; i < 64; ++i) {
      int t = t0 + i;
      float cnt = (float)(hi - lo);
      float d = sum / cnt - bf2f(Ucol[(size_t)t * 512]);
      Ad[(rh * 64 + i) * LDT] = f2bf(d);
      if (t + hw < seg_hi) { sum += bf2f(Ucol[(size_t)(t + hw) * 512]); hi = t + hw + 1; }
      if (t - hw >= seg_lo) { sum -= bf2f(Ucol[(size_t)(t - hw) * 512]); lo = t - hw + 1; }
    }
  }
  __syncthreads();
  f32x16 acc[2][2];
#pragma unroll
  for (int i = 0; i < 2; ++i)
#pragma unroll
    for (int j = 0; j < 2; ++j)
#pragma unroll
      for (int q = 0; q < 16; ++q) acc[i][j][q] = 0.f;
  mma_ktile(As, Bs, acc, wm, wn, r, h);
  mma_ktile(As + 128 * LDT, Bs + 128 * LDT, acc, wm, wn, r, h);
  __syncthreads();
  acc_to_lds(Ct, acc, wm, wn, r, h);
  __syncthreads();
  EpiArgs ea{}; ea.aux = g;
  epilogue<EPI_POOL>(p, B, Ct, nullptr, rowbase, 0, ea);
  __syncthreads();
}

template <int DQK, int KT>
DI void attn_pass(char* smem, const u16* __restrict__ Qg, const u16* __restrict__ Kg, const u16* __restrict__ VTg,
                  int nk, f32x16 (&O)[4], float& l_out) {
  constexpr int KLD = DQK + 8, NKS = DQK / 16, KCH = DQK / 8, KPT = KT * KCH / 256, VLD = KT + 8, VPT = KT / 16,
                KB = KT / 32, VCH = KT / 8;
  u16* Ks = (u16*)smem;
  u16* Vs = Ks + KT * KLD;
  const int tid = otid(), lane = tid & 63, wid = tid >> 6, r = lane & 31, h = lane >> 5;
  bf16x8 qf[NKS];
#pragma unroll
  for (int ks = 0; ks < NKS; ++ks) qf[ks] = *(const bf16x8*)(Qg + (size_t)(wid * 32 + r) * DQK + ks * 16 + h * 8);
  u32x4 rk[KPT], rv[VPT];
#pragma unroll
  for (int dvb = 0; dvb < 4; ++dvb)
#pragma unroll
    for (int g = 0; g < 16; ++g) O[dvb][g] = 0.f;
  float m = -1e30f, l = 0.f;
  const int nt = nk / KT;
  int kgo[KPT], klo[KPT], vgo[VPT], vlo[VPT];
#pragma unroll
  for (int it = 0; it < KPT; ++it) {
    int c = it * 256 + tid, key = c / KCH, kc = c - key * KCH;
    int rho = (key & ~12) | ((key & 4) << 1) | ((key & 8) >> 1);
    kgo[it] = key * DQK + kc * 8;
    klo[it] = rho * KLD + kc * 8;
  }
#pragma unroll
  for (int it = 0; it < VPT; ++it) {
    int c = it * 256 + tid, dv = c / VCH, kc = c - dv * VCH;
    vgo[it] = dv * LT + kc * 8;
    vlo[it] = dv * VLD + kc * 8;
  }
#pragma unroll
  for (int it = 0; it < KPT; ++it) rk[it] = *(const u32x4*)(Kg + kgo[it]);
#pragma unroll
  for (int it = 0; it < VPT; ++it) rv[it] = *(const u32x4*)(VTg + vgo[it]);
  for (int t = 0; t < nt; ++t) {
    __syncthreads();
#pragma unroll
    for (int it = 0; it < KPT; ++it) *(u32x4*)(Ks + klo[it]) = rk[it];
#pragma unroll
    for (int it = 0; it < VPT; ++it) *(u32x4*)(Vs + vlo[it]) = rv[it];
    __syncthreads();
    if (t + 1 < nt) {
      const u16* Kn = Kg + (size_t)(t + 1) * KT * DQK;
      const u16* Vn = VTg + (t + 1) * KT;
#pragma unroll
      for (int it = 0; it < KPT; ++it) rk[it] = *(const u32x4*)(Kn + kgo[it]);
#pragma unroll
      for (int it = 0; it < VPT; ++it) rv[it] = *(const u32x4*)(Vn + vgo[it]);
    }
    f32x16 S[KB];
#pragma unroll
    for (int kb = 0; kb < KB; ++kb) {
#pragma unroll
      for (int g = 0; g < 16; ++g) S[kb][g] = 0.f;
#pragma unroll
      for (int ks = 0; ks < NKS; ++ks) {
        bf16x8 a = *(const bf16x8*)(Ks + (kb * 32 + r) * KLD + ks * 16 + h * 8);
        S[kb] = MFMA32(a, qf[ks], S[kb]);
      }
    }
    float mx = -1e30f;
#pragma unroll
    for (int kb = 0; kb < KB; ++kb)
#pragma unroll
      for (int g = 0; g < 16; ++g) mx = fmaxf(mx, S[kb][g]);
    mx = fmaxf(mx, __shfl_xor(mx, 32));
    const float mn = fmaxf(m, mx);
    const float alpha = __builtin_amdgcn_exp2f(m - mn);
    m = mn;
    float ps = 0.f;
#pragma unroll
    for (int kb = 0; kb < KB; ++kb)
#pragma unroll
      for (int g = 0; g < 16; ++g) {
        float pv = __builtin_amdgcn_exp2f(S[kb][g] - mn);
        S[kb][g] = pv;
        ps += pv;
      }
    l = l * alpha + ps;
#pragma unroll
    for (int dvb = 0; dvb < 4; ++dvb)
#pragma unroll
      for (int g = 0; g < 16; ++g) O[dvb][g] *= alpha;
    bf16x8 pf[KB][2];
#pragma unroll
    for (int kb = 0; kb < KB; ++kb)
#pragma unroll
      for (int s = 0; s < 2; ++s) {
        u32x4 o;
#pragma unroll
        for (int q = 0; q < 4; ++q) o[q] = pk2(S[kb][8 * s + 2 * q], S[kb][8 * s + 2 * q + 1]);
        pf[kb][s] = __builtin_bit_cast(bf16x8, o);
      }
#pragma unroll
    for (int dvb = 0; dvb < 4; ++dvb) {
#pragma unroll
      for (int kb = 0; kb < KB; ++kb)
#pragma unroll
        for (int s = 0; s < 2; ++s) {
          bf16x8 a = *(const bf16x8*)(Vs + (dvb * 32 + r) * VLD + kb * 32 + s * 16 + h * 8);
          O[dvb] = MFMA32(a, pf[kb][s], O[dvb]);
        }
      if (dvb & 1) asm volatile("" ::: "memory");
    }
  }
  l_out = l + __shfl_xor(l, 32);
}

DI void diff_attn_item(char* smem, const Params& p, const Bufs& B, int b, int vh, int pos0, int nk) {
  const int tid = otid(), lane = tid & 63, wid = tid >> 6, r = lane & 31, h = lane >> 5;
  f32x16 O[4];
  unsigned* Okl = (unsigned*)(smem + 40960);
  const float lam = B.lam_()[0];
  const u16* VT = B.VT0_() + (size_t)(b * 4 + vh) * 128 * LT;
  float ss = 0.f;
#pragma unroll
  for (int e = 0; e < 2; ++e) {
    const int head = 2 * vh + e;
    const u16* Q = B.Q0_() + ((size_t)(b * 8 + head) * LT + pos0) * 64;
    const u16* K = B.K0_() + (size_t)(b * 8 + head) * LT * 64;
    float l;
    attn_pass<64, 64>(smem, Q, K, VT, nk, O, l);
    const float inv = 1.f / l;
    if (e == 0) {
#pragma unroll
      for (int dvb = 0; dvb < 4; ++dvb)
#pragma unroll
        for (int q = 0; q < 8; ++q) Okl[(dvb * 8 + q) * 256 + tid] = pk2(O[dvb][2 * q] * inv, O[dvb][2 * q + 1] * inv);
    } else {
#pragma unroll
      for (int dvb = 0; dvb < 4; ++dvb)
#pragma unroll
        for (int q = 0; q < 8; ++q) {
          unsigned o0 = Okl[(dvb * 8 + q) * 256 + tid];
          float a0 = bflo(o0) - lam * (O[dvb][2 * q] * inv), a1 = bfhi(o0) - lam * (O[dvb][2 * q + 1] * inv);
          O[dvb][2 * q] = a0; O[dvb][2 * q + 1] = a1;
          ss += a0 * a0 + a1 * a1;
        }
    }
  }
  ss += __shfl_xor(ss, 32);
  const float rstd = rsqrtf(ss * (1.f / 128.f) + EPS) * 0.8f;
  const float* sub = p.in[17];
  u16* orow = B.MIX0_() + (size_t)(b * LT + pos0 + wid * 32 + r) * 1024 + 512 + vh * 128;
#pragma unroll
  for (int dvb = 0; dvb < 4; ++dvb)
#pragma unroll
    for (int g = 0; g < 4; ++g) {
      int dv0 = dvb * 32 + 8 * g + 4 * h;
      u32x2 o;
      o[0] = pk2(O[dvb][4 * g] * rstd * sub[dv0], O[dvb][4 * g + 1] * rstd * sub[dv0 + 1]);
      o[1] = pk2(O[dvb][4 * g + 2] * rstd * sub[dv0 + 2], O[dvb][4 * g + 3] * rstd * sub[dv0 + 3]);
      *(u32x2*)(orow + dv0) = o;
    }
}

DI void mla_attn_item(char* smem, const Bufs& B, int b, int hd, int qt) {
  const int lane = otid() & 63, wid = otid() >> 6, r = lane & 31, h = lane >> 5;
  f32x16 O[4];
  float l;
  const u16* Q = B.QF_() + ((size_t)(b * 4 + hd) * SEQ + qt * 128) * 192;
  const u16* K = B.KF_() + (size_t)(b * 4 + hd) * LT * 192;
  const u16* VT = B.VT1_() + (size_t)(b * 4 + hd) * 128 * LT;
  attn_pass<192, 32>(smem, Q, K, VT, LT, O, l);
  const float inv = 1.f / l;
  u16* orow = B.MIX1_() + (size_t)(b * LT + CTX + qt * 128 + wid * 32 + r) * 1024 + hd * 128;
#pragma unroll
  for (int dvb = 0; dvb < 4; ++dvb)
#pragma unroll
    for (int g = 0; g < 4; ++g) {
      int dv0 = dvb * 32 + 8 * g + 4 * h;
      u32x2 o;
      o[0] = pk2(O[dvb][4 * g] * inv, O[dvb][4 * g + 1] * inv);
      o[1] = pk2(O[dvb][4 * g + 2] * inv, O[dvb][4 * g + 3] * inv);
      *(u32x2*)(orow + dv0) = o;
    }
}

constexpr int HLD = 136;
DI void hgrn_item(char* smem, const Bufs& B, int b, int hd, int dir) {
  u16* Qs = (u16*)smem;
  u16* Ksm = Qs + 64 * HLD;
  u16* KsT = Ksm + 64 * HLD;
  u16* VsT = KsT + 128 * LDT;
  float* emid = (float*)(VsT + 128 * LDT);
  float* ecm = emid + 128;
  const int tid = otid(), lane = tid & 63, w = tid >> 6, r = lane & 31, h = lane >> 5;
  f32x16 S[4];
#pragma unroll
  for (int kb = 0; kb < 4; ++kb)
#pragma unroll
    for (int g = 0; g < 16; ++g) S[kb][g] = 0.f;
  const u16* LFd = B.LF_() + (size_t)dir * M * 512;
  u16* OHd = B.OH_() + (size_t)dir * M * 512;
  for (int ci = 0; ci < 68; ++ci) {
    const int c = dir ? (ci < 4 ? 3 - ci : 71 - ci) : ci;
    const int rowc = b * LT + c * 64;
#pragma unroll
    for (int it = 0; it < 4; ++it) {
      int cid = it * 256 + tid, pp = cid >> 4, cc = cid & 15;
      size_t grow = (size_t)(rowc + (dir ? 63 - pp : pp));
      u32x4 qv = *(const u32x4*)(B.HQ_() + grow * 512 + hd * 128 + cc * 8);
      u32x4 lv = *(const u32x4*)(LFd + grow * 512 + hd * 128 + cc * 8);
      u32x4 vv = *(const u32x4*)(B.HI_() + grow * 512 + hd * 128 + cc * 8);
      *(u32x4*)(Qs + pp * HLD + cc * 8) = qv;
      *(u32x4*)(Ksm + pp * HLD + cc * 8) = lv;
#pragma unroll
      for (int q = 0; q < 4; ++q) {
        VsT[(cc * 8 + 2 * q) * LDT + pp] = (u16)(vv[q] & 0xffffu);
        VsT[(cc * 8 + 2 * q + 1) * LDT + pp] = (u16)(vv[q] >> 16);
      }
    }
    __syncthreads();
    {
      const int ch = tid & 127, half = tid >> 7;
      float tot0 = 0.f;
      for (int pp = 0; pp < 32; ++pp) tot0 += h2f(Ksm[pp * HLD + ch]);
      __syncthreads();
      float run = half ? 0.f : -tot0;
#pragma unroll
      for (int p8 = 0; p8 < 4; ++p8) {
        float kt[8];
#pragma unroll
        for (int e = 0; e < 8; ++e) {
          int pp = half * 32 + p8 * 8 + e;
          float lf = h2f(Ksm[pp * HLD + ch]);
          run += lf;
          float q = bf2f(Qs[pp * HLD + ch]);
          float er = __expf(run);
          Qs[pp * HLD + ch] = f2bf(q * er);
          kt[e] = (1.f - __expf(lf)) / er;
          Ksm[pp * HLD + ch] = f2bf(kt[e]);
        }
        *(u32x4*)(KsT + ch * LDT + half * 32 + p8 * 8) = pack8(kt);
      }
      if (half == 0) emid[ch] = __expf(tot0); else ecm[ch] = __expf(run);
    }
    __syncthreads();
    bf16x8 xa[4][2];
#pragma unroll
    for (int kb = 0; kb < 4; ++kb) {
#pragma unroll
      for (int g = 0; g < 16; ++g) S[kb][g] *= emid[kb * 32 + crow(g, h)];
#pragma unroll
      for (int s = 0; s < 2; ++s) {
        u32x4 o;
#pragma unroll
        for (int q = 0; q < 4; ++q) o[q] = pk2(S[kb][8 * s + 2 * q], S[kb][8 * s + 2 * q + 1]);
        xa[kb][s] = __builtin_bit_cast(bf16x8, o);
      }
    }
#pragma unroll
    for (int tb = 0; tb < 2; ++tb) {
      f32x16 oT;
#pragma unroll
      for (int g = 0; g < 16; ++g) oT[g] = 0.f;
#pragma unroll
      for (int kb = 0; kb < 4; ++kb)
#pragma unroll
        for (int s = 0; s < 2; ++s) {
          const u16* qp = Qs + (tb * 32 + r) * HLD + kb * 32 + s * 16 + 4 * h;
          u32x2 lo = *(const u32x2*)qp, hi = *(const u32x2*)(qp + 8);
          u32x4 bq = {lo[0], lo[1], hi[0], hi[1]};
          oT = MFMA32(xa[kb][s], __builtin_bit_cast(bf16x8, bq), oT);
        }
#pragma unroll
      for (int sb = 0; sb <= tb; ++sb) {
        f32x16 P;
#pragma unroll
        for (int g = 0; g < 16; ++g) P[g] = 0.f;
#pragma unroll
        for (int ks = 0; ks < 8; ++ks) {
          bf16x8 a = *(const bf16x8*)(Ksm + (sb * 32 + r) * HLD + ks * 16 + h * 8);
          bf16x8 bb = *(const bf16x8*)(Qs + (tb * 32 + r) * HLD + ks * 16 + h * 8);
          P = MFMA32(a, bb, P);
        }
        if (sb == tb) {
#pragma unroll
          for (int g = 0; g < 16; ++g) P[g] = (crow(g, h) <= r) ? P[g] : 0.f;
        }
#pragma unroll
        for (int s = 0; s < 2; ++s) {
          u32x4 o;
#pragma unroll
          for (int q = 0; q < 4; ++q) o[q] = pk2(P[8 * s + 2 * q], P[8 * s + 2 * q + 1]);
          const u16* vp = VsT + (w * 32 + r) * LDT + sb * 32 + s * 16 + 4 * h;
          u32x2 lo = *(const u32x2*)vp, hi = *(const u32x2*)(vp + 8);
          u32x4 av = {lo[0], lo[1], hi[0], hi[1]};
          oT = MFMA32(__builtin_bit_cast(bf16x8, av), __builtin_bit_cast(bf16x8, o), oT);
        }
      }
      {
        int pp = tb * 32 + r;
        size_t grow = (size_t)(rowc + (dir ? 63 - pp : pp));
        u16* op = OHd + grow * 512 + hd * 128 + w * 32;
#pragma unroll
        for (int g4 = 0; g4 < 4; ++g4) {
          u32x2 o;
          o[0] = pk2(oT[4 * g4], oT[4 * g4 + 1]);
          o[1] = pk2(oT[4 * g4 + 2], oT[4 * g4 + 3]);
          *(u32x2*)(op + 8 * g4 + 4 * h) = o;
        }
      }
    }
#pragma unroll
    for (int kb = 0; kb < 4; ++kb) {
#pragma unroll
      for (int ts = 0; ts < 4; ++ts) {
        bf16x8 a = *(const bf16x8*)(KsT + (kb * 32 + r) * LDT + ts * 16 + h * 8);
        bf16x8 bb = *(const bf16x8*)(VsT + (w * 32 + r) * LDT + ts * 16 + h * 8);
        S[kb] = MFMA32(a, bb, S[kb]);
      }
#pragma unroll
      for (int g = 0; g < 16; ++g) S[kb][g] *= ecm[kb * 32 + crow(g, h)];
    }
    __syncthreads();
  }
}

DI void hgrn_readout_row(const Params& p, const Bufs& B, int grow, int hd, int lane) {
  const size_t o = (size_t)grow * 512 + hd * 128 + lane * 2;
  unsigned a = *(const unsigned*)(B.OH_() + o), bq = *(const unsigned*)(B.OH_() + (size_t)M * 512 + o);
  unsigned gq = *(const unsigned*)(B.HG_() + o);
  float v0 = bflo(a) + bflo(bq), v1 = bfhi(a) + bfhi(bq);
  float ss = wave_sum(v0 * v0 + v1 * v1);
  float rstd = rsqrtf(ss * (1.f / 128.f) + EPS);
  const float* hn = p.in[23];
  float g0 = bflo(gq), g1 = bfhi(gq);
  unsigned out = pk2(v0 * rstd * hn[lane * 2] * siluf(g0), v1 * rstd * hn[lane * 2 + 1] * siluf(g1));
  *(unsigned*)(B.MIX1_() + (size_t)grow * 1024 + 512 + hd * 128 + lane * 2) = out;
}

constexpr int NPHASE = 18;


struct TileIter {
  int qg, step, ntn, nloc, total, xcd;
  DI TileIter(int nrt, int ntn_) {
    xcd = blockIdx.x & 7; qg = blockIdx.x >> 3; step = gridDim.x >> 3; ntn = ntn_;
    nloc = (nrt - xcd + 7) >> 3;
    total = ((nloc + 7) >> 3) * 8 * ntn;
  }
  DI bool next(int& rt, int& nt) {
    const int per = 8 * ntn, full = ntn >> 3, wrem = ntn & 7;
    while (qg < total) {
      int grp = qg / per, q = qg - grp * per, r, c;
      qg += step;
      if (q < full * 64) { int ch = q >> 6, qq = q & 63; r = qq >> 3; c = ch * 8 + (qq & 7); }
      else { int qq = q - full * 64; r = qq / wrem; c = full * 8 + (qq - r * wrem); }
      int rl = grp * 8 + r;
      if (rl < nloc) { rt = rl * 8 + xcd; nt = c; return true; }
    }
    return false;
  }
};

DI int lat_rowbase(int rt) { return (rt >> 5) * LT + CTX + (rt & 31) * 128; }

DI void run_phase(int ph, const Params& p, const Bufs& B, char* smem) {
  const int bid = blockIdx.x, nb = gridDim.x, tid = otid(), lane = tid & 63, wid = tid >> 6;
  switch (ph) {
    case 0: {
      const int n = NW_P0 + 192 + 1;
      for (int it = bid; it < n; it += nb) {
        if (it < NW_P0) prep_weight_item(smem, p, B, it);
        else if (it < NW_P0 + 192) mod_gemv_item(smem, p, B, it - NW_P0);
        else tables_item(p, B);
      }
    } break;
    case 1: {
      for (int it = bid; it < M / 32; it += nb) {
        for (int rr = 0; rr < 8; ++rr) {
          int row = it * 32 + rr * 4 + wid;
          RowInfo ri = row_info(row);
          const float* x = (ri.lat ? p.in[0] : p.in[2]) + resid_off(ri);
          const float* md = B.mod_() + (size_t)(0 * 9 + ri.mi) * 6144;
          norm_mod_row(x, p.in[6] + 0, md, md + 1024, B.H_() + (size_t)row * 1024, lane);
        }
      }
    } break;
    case 2: {
      const int n = 272 * 16;
      EpiArgs ea{};
      TileIter ti(272, 16);
      for (int rt, nt; ti.next(rt, nt);) {
        gemm_tile<EPI_IN0, false>(smem, p, B, B.H_(), 1024, rt * 128, 0, M, B.wt_ev_(), 1024, nt * 128, ea);
      }
    } break;
    case 3: {
      const int n_lat = 8 * 4 * 32, n_ctx = 8 * 4 * 2, n_pool = 272 * 4;
      for (int it = bid; it < n_lat; it += nb) {
        int b = it >> 7, vh = (it >> 5) & 3, qt = it & 31;
        diff_attn_item(smem, p, B, b, vh, CTX + qt * 128, LT);
      }
      for (int it = nb - 1 - bid; it < n_ctx; it += nb) {
        int b = it >> 3, vh = (it >> 1) & 3, qt = it & 1;
        diff_attn_item(smem, p, B, b, vh, qt * 128, CTX);
      }
      for (int it = nb - 1 - bid; it < n_pool; it += nb) pool_tile(smem, p, B, it >> 2, it & 3);
    } break;
    case 4: {
      EpiArgs ea{}; ea.outf = B.Y0_();
      TileIter ti(272, 8);
      for (int rt, nt; ti.next(rt, nt);) {
        gemm_tile<EPI_F32, false>(smem, p, B, B.MIX0_(), 1024, rt * 128, 0, M, B.wt_out_(), 1024, nt * 128, ea);
      }
    } break;
    case 5: case 8: {
      const bool first = (ph == 5);
      const float* Yb = B.Y0_();
      for (int it = bid; it < M / 32; it += nb) {
        for (int rr = 0; rr < 8; ++rr) {
          int row = it * 32 + rr * 4 + wid;
          RowInfo ri = row_info(row);
          size_t ro = resid_off(ri);
          const float* md0 = B.mod_() + (size_t)(0 * 9 + ri.mi) * 6144;
          const float* md1 = B.mod_() + (size_t)(1 * 9 + ri.mi) * 6144;
          float* xd = (ri.lat ? p.out : B.xc_()) + ro;
          if (first) {
            const float* xs = (ri.lat ? p.in[0] : p.in[2]) + ro;
            resid_row<true>(Yb + (size_t)row * 1024, xs, xd, md0 + 2 * 1024, p.in[6] + 1 * 1024, p.in[6] + 2 * 1024,
                            md0 + 3 * 1024, md0 + 4 * 1024, B.H_() + (size_t)row * 1024, lane);
          } else {
            resid_row<true>(Yb + (size_t)row * 1024, xd, xd, md0 + 5 * 1024, p.in[6] + 3 * 1024,
                            p.in[6] + 4 * 1024 + 0, md1, md1 + 1024, B.H_() + (size_t)row * 1024, lane);
          }
        }
      }
    } break;
    case 6: {
      const int n = 288 * 44;
      TileIter ti(288, 44);
      for (int rtile, nt; ti.next(rtile, nt);) {
        int b = rtile / 36, jj = rtile - b * 36;
        EpiArgs ea{}; ea.layer = 0;
        int j;
        if (jj < 3) { ea.seg_lo = b * LT; ea.seg_hi = b * LT + CTX; j = jj; }
        else { ea.seg_lo = b * LT + CTX; ea.seg_hi = (b + 1) * LT; j = jj - 3; }
        gemm_tile<EPI_FFN1, false>(smem, p, B, B.H_(), 1024, ea.seg_lo + 126 * j - 1, ea.seg_lo, ea.seg_hi, B.wt_f1_(), 1024,
                                   nt * 128, ea);
      }
    } break;
    case 7: {
      EpiArgs ea{}; ea.outf = B.Y0_();
      TileIter ti(272, 8);
      for (int rt, nt; ti.next(rt, nt);) {
        gemm_tile<EPI_F32, false>(smem, p, B, B.G0_(), DFF, rt * 128, 0, M, B.wt_f2_(), DFF, nt * 128, ea);
      }
    } break;
    case 9: {
      const int n = 272 * 27;
      EpiArgs ea{};
      TileIter ti(272, 27);
      for (int rt, nt; ti.next(rt, nt);) {
        gemm_tile<EPI_IN1, false>(smem, p, B, B.H_(), 1024, rt * 128, 0, M, B.wt_od_(), 1024, nt * 128, ea);
      }
    } break;
    case 10: {
      const int n_q = 256 * 6, n_kv = 272 * 8;
      EpiArgs ea{};
      TileIter tq(256, 6);
      for (int rt, nt; tq.next(rt, nt);) {
        gemm_tile<EPI_UQ, true>(smem, p, B, B.CQ_(), 512, lat_rowbase(rt), 0, M, B.wt_uq_(), 512, nt * 128, ea);
      }
      TileIter tk(272, 8);
      for (int rt, nt; tk.next(rt, nt);) {
        gemm_tile<EPI_UKV, true>(smem, p, B, B.CKV_(), 256, rt * 128, 0, M, B.wt_ukv_(), 256, nt * 128, ea);
      }
      for (int it = nb - 1 - bid; it < NW_FFN; it += nb) ffn_weight_item(smem, p, B, 1, it);
    } break;
    case 11: {
      const int n_h = 64, n_a = 8 * 4 * 32;
      for (int it = bid; it < n_h; it += nb) hgrn_item(smem, B, it >> 3, (it >> 1) & 3, it & 1);
      for (int it = nb - 1 - bid; it < n_a; it += nb) mla_attn_item(smem, B, it >> 7, (it >> 5) & 3, it & 31);
    } break;
    case 12: {
      const int n = NB * SEQ * 4 / 4;
      for (int it = bid; it < n; it += nb) {
        int j = it * 4 + wid, rl = j >> 2, hd = j & 3;
        int grow = (rl >> 12) * LT + CTX + (rl & 4095);
        hgrn_readout_row(p, B, grow, hd, lane);
      }
    } break;
    case 13: {
      EpiArgs ea{}; ea.outf = B.Y1_();
      TileIter ti(256, 8);
      for (int rt, nt; ti.next(rt, nt);) {
        gemm_tile<EPI_F32, false>(smem, p, B, B.MIX1_(), 1024, lat_rowbase(rt), 0, M, B.wt_out_() + 1024 * 1024, 1024,
                                  nt * 128, ea);
      }
    } break;
    case 14: case 17: {
      const bool first = (ph == 14);
      for (int it = bid; it < NB * SEQ / 32; it += nb) {
        for (int rr = 0; rr < 8; ++rr) {
          int rl = it * 32 + rr * 4 + wid;
          int bb = rl >> 12, row = bb * LT + CTX + (rl & 4095);
          float* xd = p.out + (size_t)rl * 1024;
          const float* md1 = B.mod_() + (size_t)(1 * 9 + bb) * 6144;
          const float* ng = p.in[6] + 4 * 1024;
          if (first)
            resid_row<true>(B.Y1_() + (size_t)row * 1024, xd, xd, md1 + 2 * 1024, ng + 1 * 1024, ng + 2 * 1024,
                            md1 + 3 * 1024, md1 + 4 * 1024, B.H_() + (size_t)row * 1024, lane);
          else
            resid_row<false>(B.Y1_() + (size_t)row * 1024, xd, xd, md1 + 5 * 1024, ng + 3 * 1024, nullptr, nullptr, nullptr,
                             nullptr, lane);
        }
      }
    } break;
    case 15: {
      const int n = 264 * 44;
      TileIter ti(264, 44);
      for (int rtile, nt; ti.next(rtile, nt);) {
        int b = rtile / 33, j = rtile - b * 33;
        EpiArgs ea{}; ea.layer = 1; ea.seg_lo = b * LT + CTX; ea.seg_hi = (b + 1) * LT;
        gemm_tile<EPI_FFN1, false>(smem, p, B, B.H_(), 1024, ea.seg_lo + 126 * j - 1, ea.seg_lo, ea.seg_hi, B.wt_f1_(), 1024,
                                   nt * 128, ea);
      }
    } break;
    case 16: {
      EpiArgs ea{}; ea.outf = B.Y1_();
      TileIter ti(256, 8);
      for (int rt, nt; ti.next(rt, nt);) {
        gemm_tile<EPI_F32, false>(smem, p, B, B.G1_(), DFF, lat_rowbase(rt), 0, M, B.wt_f2_(), DFF, nt * 128, ea);
      }
    } break;
    default: break;
  }
}

DI void grid_bar(unsigned* ctr, unsigned target) {
  asm volatile("s_waitcnt vmcnt(0)" ::: "memory");
  __syncthreads();
  if (threadIdx.x == 0) {
    __builtin_amdgcn_fence(__ATOMIC_RELEASE, "agent");
    asm volatile("s_waitcnt vmcnt(0)" ::: "memory");
    __hip_atomic_fetch_add(ctr, 1u, __ATOMIC_RELAXED, __HIP_MEMORY_SCOPE_AGENT);
    while (__hip_atomic_load(ctr, __ATOMIC_RELAXED, __HIP_MEMORY_SCOPE_AGENT) < target) __builtin_amdgcn_s_sleep(2);
    __builtin_amdgcn_fence(__ATOMIC_ACQUIRE, "agent");
    asm volatile("s_waitcnt vmcnt(0)" ::: "memory");
  }
  __syncthreads();
}
#define RUNPH(k)                                                                       \
  if (p.ph_lo <= (k) && (k) < p.ph_hi) {                                               \
    run_phase((k), p, B, smem);                                                        \
    if ((k) + 1 < p.ph_hi) {                                                           \
      if ((k) == 0) cg::this_grid().sync();                                            \
      else grid_bar((unsigned*)(p.ws + OFF_LAM + 128), (unsigned)(k) * gridDim.x);     \
    }                                                                                  \
  }
__global__ void __launch_bounds__(NTHR, 2) fwd_megakernel(Params p) {
  extern __shared__ __attribute__((aligned(16))) char smem[];
  const Bufs B = make_bufs(p.ws);
  RUNPH(0) RUNPH(1) RUNPH(2) RUNPH(3) RUNPH(4) RUNPH(5) RUNPH(6) RUNPH(7) RUNPH(8)
  RUNPH(9) RUNPH(10) RUNPH(11) RUNPH(12) RUNPH(13) RUNPH(14) RUNPH(15) RUNPH(16) RUNPH(17)
}

constexpr bool ONE_LAUNCH = true;

extern "C" void kernel_launch(void* const* d_in, const int* in_sizes, int n_in, void* d_out, int out_size, void* d_ws,
                              size_t ws_size, hipStream_t stream) {
  static int grid_blocks = 0;
  if (!grid_blocks) {
    int dev = 0, cus = 0, per_cu = 0;
    hipGetDevice(&dev);
    hipDeviceGetAttribute(&cus, hipDeviceAttributeMultiprocessorCount, dev);
    hipFuncSetAttribute((const void*)fwd_megakernel, hipFuncAttributeMaxDynamicSharedMemorySize, SMEM_BYTES);
    hipOccupancyMaxActiveBlocksPerMultiprocessor(&per_cu, fwd_megakernel, NTHR, SMEM_BYTES);
    if (per_cu < 1) per_cu = 1;
    if (per_cu > 2) per_cu = 2;
    grid_blocks = cus * per_cu;
  }
  if (ws_size < WS_NEEDED) {
    fprintf(stderr, "workspace too small: %zu < %zu\n", ws_size, (size_t)WS_NEEDED);
    return;
  }
  Params p{};
  for (int i = 0; i < 25; ++i) p.in[i] = (const float*)d_in[i];
  p.out = (float*)d_out;
  p.ws = (char*)d_ws;
  if (ONE_LAUNCH) {
    p.ph_lo = 0; p.ph_hi = NPHASE;
    hipMemsetAsync((char*)d_ws + OFF_LAM + 128, 0, 64, stream);
    void* args[] = {&p};
    hipError_t e = hipLaunchCooperativeKernel((const void*)fwd_megakernel, dim3(grid_blocks), dim3(NTHR), args,
                                              SMEM_BYTES, stream);
    if (e != hipSuccess) fprintf(stderr, "cooperative launch failed: %s (grid %d)\n", hipGetErrorString(e), grid_blocks);
  } else {
    for (int ph = 0; ph < NPHASE; ++ph) {
      p.ph_lo = ph; p.ph_hi = ph + 1;
      hipLaunchKernelGGL(fwd_megakernel, dim3(grid_blocks), dim3(NTHR), SMEM_BYTES, stream, p);
    }
  }
}
```

```cpp
#include <hip/hip_runtime.h>
#include <hip/hip_fp16.h>
#include <hip/hip_cooperative_groups.h>
#include <cstdio>
#include <cstdint>
namespace cg = cooperative_groups;

#define DI __device__ __forceinline__
typedef unsigned short u16;
typedef __attribute__((ext_vector_type(8))) short bf16x8;
typedef __attribute__((ext_vector_type(16))) float f32x16;
typedef __attribute__((ext_vector_type(4))) unsigned u32x4;
typedef __attribute__((ext_vector_type(2))) unsigned u32x2;

constexpr int D = 1024, NB = 8, SEQ = 4096, CTX = 256, LT = 4352, M = NB * LT, DFF = 2816;
constexpr float EPS = 1e-6f;
constexpr float LOG2E = 1.4426950408889634f;
constexpr float QS_DIFF = 0.125f * LOG2E;
constexpr float QS_MLA = 0.07216878364870323f * LOG2E;
constexpr int NTHR = 256;

constexpr size_t SZ_WT_OUT = 2ull * 1024 * 1024 * 2;
constexpr size_t SZ_WT_F1 = 5632ull * 1024 * 2;
constexpr size_t SZ_WT_F2 = 1024ull * 2816 * 2;
constexpr size_t SZ_WT_EV = 2048ull * 1024 * 2;
constexpr size_t SZ_WT_OD = 3456ull * 1024 * 2;
constexpr size_t SZ_WT_UQ = 768ull * 512 * 2;
constexpr size_t SZ_WT_UKV = 1024ull * 256 * 2;
constexpr size_t SZ_WT_POOL = 4ull * 128 * 128 * 2;
constexpr size_t SZ_MOD = 2ull * 9 * 6144 * 4;
constexpr size_t SZ_ROPE = 2ull * 1024 * 4;
constexpr size_t SZ_LB = 1024 * 4;
constexpr size_t SZ_LAM = 256 + 16384;
constexpr size_t SZ_XC = 2048ull * 1024 * 4;
constexpr size_t SZ_H = (size_t)M * 1024 * 2;
constexpr size_t SZ_M512 = (size_t)M * 512 * 2;

constexpr size_t OFF_WT_OUT = 0;
constexpr size_t OFF_WT_F1 = OFF_WT_OUT + SZ_WT_OUT;
constexpr size_t OFF_WT_F2 = OFF_WT_F1 + SZ_WT_F1;
constexpr size_t OFF_WT_EV = OFF_WT_F2 + SZ_WT_F2;
constexpr size_t OFF_WT_OD = OFF_WT_EV + SZ_WT_EV;
constexpr size_t OFF_WT_UQ = OFF_WT_OD + SZ_WT_OD;
constexpr size_t OFF_WT_UKV = OFF_WT_UQ + SZ_WT_UQ;
constexpr size_t OFF_WT_POOL = OFF_WT_UKV + SZ_WT_UKV;
constexpr size_t OFF_MOD = OFF_WT_POOL + SZ_WT_POOL;
constexpr size_t OFF_ROPE = OFF_MOD + SZ_MOD;
constexpr size_t OFF_LB = OFF_ROPE + SZ_ROPE;
constexpr size_t OFF_LAM = OFF_LB + SZ_LB;
constexpr size_t OFF_XC = OFF_LAM + SZ_LAM;
constexpr size_t OFF_H = OFF_XC + SZ_XC;
constexpr size_t OFF_R = OFF_H + SZ_H;
constexpr size_t R_U = 0;
constexpr size_t R_Q0 = R_U + SZ_M512;
constexpr size_t R_K0 = R_Q0 + SZ_M512;
constexpr size_t R_VT0 = R_K0 + SZ_M512;
constexpr size_t R_MIX0 = R_VT0 + SZ_M512;
constexpr size_t R_Y0 = R_MIX0 + SZ_H;
constexpr size_t R_G0 = 0;
constexpr size_t R_MIX1 = 0;
constexpr size_t R_CQ = 0;
constexpr size_t R_CKV = SZ_M512;
constexpr size_t R_KF = SZ_H;
constexpr size_t SZ_KF = 8ull * 4 * LT * 192 * 2;
constexpr size_t R_VT1 = R_KF + SZ_KF;
constexpr size_t R_HQ = R_VT1 + SZ_M512;
constexpr size_t R_LF = R_HQ + SZ_M512;
constexpr size_t R_HI = R_LF + 2 * SZ_M512;
constexpr size_t R_HG = R_HI + SZ_M512;
constexpr size_t R_OH = R_HG + SZ_M512;
constexpr size_t R_END1 = R_OH + 2 * SZ_M512;
constexpr size_t R_Y1 = R_KF;
constexpr size_t SZ_Y = (size_t)M * 1024 * 4;
constexpr size_t R_G1 = R_Y1 + SZ_Y;
constexpr size_t SZ_G = (size_t)M * DFF * 2;
constexpr size_t R_SIZE = (R_G1 + SZ_G > R_END1) ? (R_G1 + SZ_G) : R_END1;
constexpr size_t WS_NEEDED = OFF_R + R_SIZE;
static_assert(R_Y0 + SZ_Y <= R_SIZE, "layer0 region");
static_assert(R_G0 + SZ_G <= R_Y0, "G0 overlap");
static_assert(WS_NEEDED <= 536870912ull, "ws too big");

struct Params {
  const float* in[25];
  float* out;
  char* ws;
  int ph_lo, ph_hi;
};

constexpr int SMEM_MAIN = 73728;
constexpr int SMEM_BYTES = SMEM_MAIN + 16;
constexpr int LDT = 72;
constexpr int CLD = 132;

DI int otid() { int t = threadIdx.x; asm volatile("" : "+v"(t)); return t; }
DI u16 f2bf(float x) { return __builtin_bit_cast(u16, (__bf16)x); }
DI unsigned pk2(float a, float b) { return (unsigned)f2bf(a) | ((unsigned)f2bf(b) << 16); }
DI float bflo(unsigned u) { return __uint_as_float(u << 16); }
DI float bfhi(unsigned u) { return __uint_as_float(u & 0xffff0000u); }
DI float bf2f(u16 v) { return __uint_as_float(((unsigned)v) << 16); }
DI float h2f(u16 v) { return __half2float(__ushort_as_half(v)); }
DI u16 f2h(float x) { return __half_as_ushort(__float2half(x)); }
DI float siluf(float x) { return x / (1.f + __expf(-x)); }
DI float wave_sum(float v) {
#pragma unroll
  for (int o = 32; o > 0; o >>= 1) v += __shfl_xor(v, o);
  return v;
}
DI u32x4 pack8(const float* v) {
  u32x4 o;
  o[0] = pk2(v[0], v[1]); o[1] = pk2(v[2], v[3]); o[2] = pk2(v[4], v[5]); o[3] = pk2(v[6], v[7]);
  return o;
}
DI int crow(int reg, int h) { return (reg & 3) + 8 * (reg >> 2) + 4 * h; }
#define MFMA32(a, b, c) __builtin_amdgcn_mfma_f32_32x32x16_bf16((a), (b), (c), 0, 0, 0)

struct Bufs {
  char* ws;
#define BUFP(T, name, off) DI T* name##_() const { return (T*)(ws + (off)); }
  BUFP(u16, wt_out, OFF_WT_OUT) BUFP(u16, wt_f1, OFF_WT_F1) BUFP(u16, wt_f2, OFF_WT_F2) BUFP(u16, wt_ev, OFF_WT_EV)
  BUFP(u16, wt_od, OFF_WT_OD) BUFP(u16, wt_uq, OFF_WT_UQ) BUFP(u16, wt_ukv, OFF_WT_UKV) BUFP(u16, wt_pool, OFF_WT_POOL)
  BUFP(float, mod, OFF_MOD) BUFP(float, ropec, OFF_ROPE) BUFP(float, ropes, OFF_ROPE + 4096) BUFP(float, lb, OFF_LB)
  BUFP(float, lam, OFF_LAM) BUFP(float, xc, OFF_XC) BUFP(u16, H, OFF_H)
  BUFP(u16, U, OFF_R + R_U) BUFP(u16, Q0, OFF_R + R_Q0) BUFP(u16, K0, OFF_R + R_K0) BUFP(u16, VT0, OFF_R + R_VT0)
  BUFP(u16, MIX0, OFF_R + R_MIX0) BUFP(float, Y0, OFF_R + R_Y0) BUFP(u16, G0, OFF_R + R_G0)
  BUFP(u16, CQ, OFF_R + R_CQ) BUFP(u16, CKV, OFF_R + R_CKV) BUFP(u16, MIX1, OFF_R + R_MIX1) BUFP(u16, KF, OFF_R + R_KF)
  BUFP(u16, VT1, OFF_R + R_VT1) BUFP(u16, HQ, OFF_R + R_HQ) BUFP(u16, LF, OFF_R + R_LF) BUFP(u16, HI, OFF_R + R_HI)
  BUFP(u16, HG, OFF_R + R_HG) BUFP(u16, OH, OFF_R + R_OH) BUFP(u16, QF, OFF_H) BUFP(float, Y1, OFF_R + R_Y1)
  BUFP(u16, G1, OFF_R + R_G1)
};
DI Bufs make_bufs(char* ws) { Bufs b; b.ws = ws; return b; }

DI void wt_tile(char* smem, const float* __restrict__ src, int ld, int kt, int ncol0, u16* __restrict__ dst, int K,
                int dst_row0, const float* __restrict__ scale) {
  float* t = (float*)smem;
  const int tid = otid(), col = tid & 63, r0 = tid >> 6;
#pragma unroll 4
  for (int i = 0; i < 16; ++i) {
    int row = i * 4 + r0;
    float v = src[(size_t)(kt * 64 + row) * ld + ncol0 + col];
    if (scale) v *= scale[kt * 64 + row];
    t[row * 65 + col] = v;
  }
  __syncthreads();
#pragma unroll
  for (int it = 0; it < 2; ++it) {
    int c = it * 256 + tid, j = c >> 3, kc = c & 7;
    u32x4 o;
#pragma unroll
    for (int q = 0; q < 4; ++q) o[q] = pk2(t[(kc * 8 + 2 * q) * 65 + j], t[(kc * 8 + 2 * q + 1) * 65 + j]);
    *(u32x4*)(dst + (size_t)(dst_row0 + j) * K + kt * 64 + kc * 8) = o;
  }
  __syncthreads();
}

#define WJOB(SRC, LDD, KK, NN, DST, TS, ROFF, SC)                                        \
  {                                                                                       \
    const int ntn = (NN) / 64, cnt = ((KK) / 64) * ntn;                                   \
    if (idx < cnt) {                                                                      \
      int kt = idx / ntn, nt = idx % ntn;                                                 \
      wt_tile(smem, (SRC), (LDD), kt, nt * 64, (DST), (KK), nt * (TS) + (ROFF), (SC));    \
      return;                                                                             \
    }                                                                                     \
    idx -= cnt;                                                                           \
  }

constexpr int NW_FFN = 704 * 3;
constexpr int NW_P0 = 256 + 256 + NW_FFN + 512 + 848 + 96 + 64 + 16;

DI void ffn_weight_item(char* smem, const Params& p, const Bufs& B, int layer, int idx) {
  WJOB(p.in[8] + (size_t)layer * 1024 * DFF, DFF, 1024, DFF, B.wt_f1_(), 128, 0, nullptr)
  WJOB(p.in[9] + (size_t)layer * 1024 * DFF, DFF, 1024, DFF, B.wt_f1_(), 128, 64, nullptr)
  WJOB(p.in[12] + (size_t)layer * DFF * 1024, 1024, DFF, 1024, B.wt_f2_(), 64, 0, nullptr)
}

DI void prep_weight_item(char* smem, const Params& p, const Bufs& B, int idx) {
  WJOB(p.in[7], 1024, 1024, 1024, B.wt_out_(), 64, 0, nullptr)
  WJOB(p.in[7] + 1024 * 1024, 1024, 1024, 1024, B.wt_out_() + 1024 * 1024, 64, 0, nullptr)
  if (idx < NW_FFN) { ffn_weight_item(smem, p, B, 0, idx); return; }
  idx -= NW_FFN;
  WJOB(p.in[13], 2048, 1024, 2048, B.wt_ev_(), 64, 0, nullptr)
  WJOB(p.in[18], 3392, 1024, 3392, B.wt_od_(), 64, 0, nullptr)
  WJOB(p.in[20], 768, 512, 768, B.wt_uq_(), 64, 0, p.in[19])
  WJOB(p.in[22], 1024, 256, 1024, B.wt_ukv_(), 64, 0, p.in[21])
  {
    int g = idx >> 2, t = idx & 3;
    wt_tile(smem, p.in[14] + g * 128 * 128, 128, t >> 1, (t & 1) * 64, B.wt_pool_() + g * 128 * 128, 128, (t & 1) * 64,
            nullptr);
  }
}

DI void mod_gemv_item(char* smem, const Params& p, const Bufs& B, int idx) {
  const int layer = idx / 96, c0 = (idx % 96) * 64, tid = otid();
  float* sc = (float*)smem;
  float* red = sc + 9 * 1024;
  for (int i = tid; i < 9 * 1024; i += NTHR) {
    int rr = i >> 10, k = i & 1023;
    float v = (rr < 8) ? p.in[1][rr * 1024 + k] : p.in[3][k];
    sc[i] = siluf(v);
  }
  __syncthreads();
  const int cq = tid & 15, kg = tid >> 4;
  float acc[9][4];
#pragma unroll
  for (int a = 0; a < 9; ++a)
#pragma unroll
    for (int e = 0; e < 4; ++e) acc[a][e] = 0.f;
  const float* W = p.in[4] + (size_t)layer * 1024 * 6144 + c0 + cq * 4;
#pragma unroll 4
  for (int kk = 0; kk < 64; ++kk) {
    int k = kg * 64 + kk;
    float4 w = *(const float4*)(W + (size_t)k * 6144);
#pragma unroll
    for (int a = 0; a < 9; ++a) {
      float s = sc[a * 1024 + k];
      acc[a][0] += s * w.x; acc[a][1] += s * w.y; acc[a][2] += s * w.z; acc[a][3] += s * w.w;
    }
  }
#pragma unroll
  for (int a = 0; a < 9; ++a)
#pragma unroll
    for (int e = 0; e < 4; ++e) red[(kg * 9 + a) * 64 + cq * 4 + e] = acc[a][e];
  __syncthreads();
  for (int i = tid; i < 9 * 64; i += NTHR) {
    int a = i >> 6, c = i & 63;
    float s = 0.f;
    for (int g = 0; g < 16; ++g) s += red[(g * 9 + a) * 64 + c];
    B.mod_()[(size_t)(layer * 9 + a) * 6144 + c0 + c] = s + p.in[5][layer * 6144 + c0 + c];
  }
  __syncthreads();
}

DI void tables_item(const Params& p, const Bufs& B) {
  const int tid = otid();
  for (int i = tid; i < 1024; i += NTHR) {
    int pos = i >> 4, f = i & 15;
    float inv = powf(10000.f, -(float)f / 16.f);
    float ang = (float)pos * inv;
    B.ropec_()[i] = cosf(ang);
    B.ropes_()[i] = sinf(ang);
    int dir = i >> 9, ch = i & 511;
    float a0 = p.in[24][(dir * 2 + 0) * 512 + ch], a1 = p.in[24][(dir * 2 + 1) * 512 + ch];
    B.lb_()[i] = 1.f / (1.f + expf(a0 - a1));
  }
  if (tid < 64) {
    const float* L = p.in[16];
    float s1 = wave_sum(L[tid] * L[64 + tid]);
    float s2 = wave_sum(L[128 + tid] * L[192 + tid]);
    if (tid == 0) B.lam_()[0] = expf(s1) - expf(s2) + 0.2f;
  }
  for (int i = tid; i < 64 * 1024 / 8; i += NTHR) {
    u32x4 z = {0u, 0u, 0u, 0u};
    *(u32x4*)(B.wt_od_() + (size_t)3392 * 1024 + i * 8) = z;
  }
}

struct RowInfo { int b, pos, mi; bool lat; };
DI RowInfo row_info(int r) {
  RowInfo ri;
  ri.b = r / LT; ri.pos = r - ri.b * LT; ri.lat = ri.pos >= CTX; ri.mi = ri.lat ? ri.b : 8;
  return ri;
}
DI size_t resid_off(const RowInfo& ri) {
  return ri.lat ? ((size_t)ri.b * SEQ + (ri.pos - CTX)) * 1024 : ((size_t)ri.b * CTX + ri.pos) * 1024;
}

DI void norm_mod_row(const float* __restrict__ x, const float* __restrict__ g, const float* __restrict__ sh,
                     const float* __restrict__ sc, u16* __restrict__ hrow, int lane) {
  float4 v[4];
  float ss = 0.f;
#pragma unroll
  for (int i = 0; i < 4; ++i) {
    v[i] = *(const float4*)(x + i * 256 + lane * 4);
    ss += v[i].x * v[i].x + v[i].y * v[i].y + v[i].z * v[i].z + v[i].w * v[i].w;
  }
  ss = wave_sum(ss);
  const float rstd = rsqrtf(ss * (1.f / 1024.f) + EPS);
#pragma unroll
  for (int i = 0; i < 4; ++i) {
    int c = i * 256 + lane * 4;
    float4 gg = *(const float4*)(g + c), s1 = *(const float4*)(sh + c), s2 = *(const float4*)(sc + c);
    u32x2 o;
    o[0] = pk2(v[i].x * rstd * gg.x * (1.f + s2.x) + s1.x, v[i].y * rstd * gg.y * (1.f + s2.y) + s1.y);
    o[1] = pk2(v[i].z * rstd * gg.z * (1.f + s2.z) + s1.z, v[i].w * rstd * gg.w * (1.f + s2.w) + s1.w);
    *(u32x2*)(hrow + c) = o;
  }
}

template <bool NEXT>
DI void resid_row(const u16* __restrict__ y, const float* xs, float* xd, const float* __restrict__ gate,
                  const float* __restrict__ ny, const float* __restrict__ nx, const float* __restrict__ sh,
                  const float* __restrict__ sc, u16* __restrict__ hrow, int lane) {
  float4 v[4];
  float ss = 0.f;
#pragma unroll
  for (int i = 0; i < 4; ++i) {
    u32x2 yy = *(const u32x2*)(y + i * 256 + lane * 4);
    v[i].x = bflo(yy[0]); v[i].y = bfhi(yy[0]); v[i].z = bflo(yy[1]); v[i].w = bfhi(yy[1]);
    ss += v[i].x * v[i].x + v[i].y * v[i].y + v[i].z * v[i].z + v[i].w * v[i].w;
  }
  ss = wave_sum(ss);
  const float rstd = rsqrtf(ss * (1.f / 1024.f) + EPS);
  float ss2 = 0.f;
#pragma unroll
  for (int i = 0; i < 4; ++i) {
    int c = i * 256 + lane * 4;
    float4 xv = *(const float4*)(xs + c), gt = *(const float4*)(gate + c), nn = *(const float4*)(ny + c);
    float4 o;
    o.x = xv.x + gt.x * (v[i].x * rstd * nn.x); o.y = xv.y + gt.y * (v[i].y * rstd * nn.y);
    o.z = xv.z + gt.z * (v[i].z * rstd * nn.z); o.w = xv.w + gt.w * (v[i].w * rstd * nn.w);
    *(float4*)(xd + c) = o;
    v[i] = o;
    ss2 += o.x * o.x + o.y * o.y + o.z * o.z + o.w * o.w;
  }
  if (NEXT) {
    ss2 = wave_sum(ss2);
    const float rstd2 = rsqrtf(ss2 * (1.f / 1024.f) + EPS);
#pragma unroll
    for (int i = 0; i < 4; ++i) {
      int c = i * 256 + lane * 4;
      float4 gg = *(const float4*)(nx + c), s1 = *(const float4*)(sh + c), s2 = *(const float4*)(sc + c);
      u32x2 o;
      o[0] = pk2(v[i].x * rstd2 * gg.x * (1.f + s2.x) + s1.x, v[i].y * rstd2 * gg.y * (1.f + s2.y) + s1.y);
      o[1] = pk2(v[i].z * rstd2 * gg.z * (1.f + s2.z) + s1.z, v[i].w * rstd2 * gg.w * (1.f + s2.w) + s1.w);
      *(u32x2*)(hrow + c) = o;
    }
  }
}

enum { EPI_F32 = 0, EPI_IN0, EPI_IN1, EPI_FFN1, EPI_UQ, EPI_UKV, EPI_POOL };

struct EpiArgs {
  float* outf;
  int layer;
  int seg_lo, seg_hi;
  int aux;
};

DI void mma_ktile(const u16* As, const u16* Bs, f32x16 (&acc)[2][2], int wm, int wn, int r, int h) {
#pragma unroll
  for (int ks = 0; ks < 4; ++ks) {
    bf16x8 a[2], b[2];
#pragma unroll
    for (int i = 0; i < 2; ++i) a[i] = *(const bf16x8*)(As + (wm * 64 + i * 32 + r) * LDT + ks * 16 + h * 8);
#pragma unroll
    for (int j = 0; j < 2; ++j) b[j] = *(const bf16x8*)(Bs + (wn * 64 + j * 32 + r) * LDT + ks * 16 + h * 8);
#pragma unroll
    for (int i = 0; i < 2; ++i)
#pragma unroll
      for (int j = 0; j < 2; ++j) acc[i][j] = MFMA32(a[i], b[j], acc[i][j]);
  }
}

DI void acc_to_lds(float* Ct, f32x16 (&acc)[2][2], int wm, int wn, int r, int h) {
#pragma unroll
  for (int i = 0; i < 2; ++i)
#pragma unroll
    for (int j = 0; j < 2; ++j)
#pragma unroll
      for (int g = 0; g < 16; ++g)
        Ct[(wm * 64 + i * 32 + crow(g, h)) * CLD + wn * 64 + j * 32 + r] = acc[i][j][g];
}

DI void rope8(float* v, const float* Ct_row, int cc8, int d, int n, const Bufs& B) {
  const int axis = d >> 5, pa = axis ? (n & 63) : (n >> 6), f0 = d & 15;
  const bool first = (d & 16) == 0;
  const int pc = first ? cc8 + 16 : cc8 - 16;
  const float4 c0 = *(const float4*)(B.ropec_() + pa * 16 + f0), c1 = *(const float4*)(B.ropec_() + pa * 16 + f0 + 4);
  const float4 s0 = *(const float4*)(B.ropes_() + pa * 16 + f0), s1 = *(const float4*)(B.ropes_() + pa * 16 + f0 + 4);
  const float4 x0 = *(const float4*)(Ct_row + pc), x1 = *(const float4*)(Ct_row + pc + 4);
  const float cs[8] = {c0.x, c0.y, c0.z, c0.w, c1.x, c1.y, c1.z, c1.w};
  const float sn[8] = {s0.x, s0.y, s0.z, s0.w, s1.x, s1.y, s1.z, s1.w};
  const float xp[8] = {x0.x, x0.y, x0.z, x0.w, x1.x, x1.y, x1.z, x1.w};
#pragma unroll
  for (int e = 0; e < 8; ++e) v[e] = first ? v[e] * cs[e] - xp[e] * sn[e] : v[e] * cs[e] + xp[e] * sn[e];
}

DI void ld8(float* v, const float* src) {
  const float4 a = *(const float4*)src, b = *(const float4*)(src + 4);
  v[0] = a.x; v[1] = a.y; v[2] = a.z; v[3] = a.w; v[4] = b.x; v[5] = b.y; v[6] = b.z; v[7] = b.w;
}

template <int EPI>
DI void epilogue(const Params& p, const Bufs& B, const float* Ct, const float* rowss, int rowbase, int n0,
                 const EpiArgs& ea) {
  const int tid = otid();
  if (EPI == EPI_F32) {
#pragma unroll 1
    for (int it = 0; it < 8; ++it) {
      int id = it * 256 + tid, i = id >> 4, cc = id & 15;
      float v[8];
      ld8(v, Ct + i * CLD + cc * 8);
      *(u32x4*)((u16*)ea.outf + (size_t)(rowbase + i) * 1024 + n0 + cc * 8) = pack8(v);
    }
  } else if (EPI == EPI_POOL) {
#pragma unroll 1
    for (int it = 0; it < 8; ++it) {
      int id = it * 256 + tid, i = id >> 4, cc = id & 15;
      float v[8];
#pragma unroll
      for (int e = 0; e < 8; ++e) v[e] = Ct[i * CLD + cc * 8 + e] * p.in[15][ea.aux * 128 + cc * 8 + e];
      *(u32x4*)(B.MIX0_() + (size_t)(rowbase + i) * 1024 + ea.aux * 128 + cc * 8) = pack8(v);
    }
  } else if (EPI == EPI_IN0) {
    const int seg = n0 >> 9, b = rowbase / LT, pos0 = rowbase - b * LT;
    if (seg == 3) {
#pragma unroll 1
      for (int it = 0; it < 8; ++it) {
        int id = it * 256 + tid, c = id & 127, rc = id >> 7;
        float v[8];
#pragma unroll
        for (int e = 0; e < 8; ++e) v[e] = Ct[(rc * 8 + e) * CLD + c];
        int hc = n0 - 1536 + c, vh = hc >> 7, dv = hc & 127;
        *(u32x4*)(B.VT0_() + ((size_t)(b * 4 + vh) * 128 + dv) * LT + pos0 + rc * 8) = pack8(v);
      }
    } else {
#pragma unroll 1
      for (int it = 0; it < 8; ++it) {
        int id = it * 256 + tid, i = id >> 4, cc = id & 15;
        float v[8];
        ld8(v, Ct + i * CLD + cc * 8);
        if (seg == 0) {
          *(u32x4*)(B.U_() + (size_t)(rowbase + i) * 512 + n0 + cc * 8) = pack8(v);
        } else {
          int hc = n0 - 512 * seg + cc * 8, head = hc >> 6, d = hc & 63, pos = pos0 + i;
          if (pos >= CTX) rope8(v, Ct + i * CLD, cc * 8, d, pos - CTX, B);
          if (seg == 1) {
#pragma unroll
            for (int e = 0; e < 8; ++e) v[e] *= QS_DIFF;
          }
          u16* dst = (seg == 1 ? B.Q0_() : B.K0_()) + ((size_t)(b * 8 + head) * LT + pos) * 64 + d;
          *(u32x4*)dst = pack8(v);
        }
      }
    }
  } else if (EPI == EPI_IN1) {
    const int b = rowbase / LT, pos0 = rowbase - b * LT;
#pragma unroll 1
    for (int it = 0; it < 8; ++it) {
      int id = it * 256 + tid, i = id >> 4, cc = id & 15;
      int gc = n0 + cc * 8, pos = pos0 + i;
      size_t grow = (size_t)(rowbase + i);
      float v[8];
      ld8(v, Ct + i * CLD + cc * 8);
      if (gc < 512) {
        *(u32x4*)(B.CQ_() + grow * 512 + gc) = pack8(v);
      } else if (gc < 768) {
        *(u32x4*)(B.CKV_() + grow * 256 + (gc - 512)) = pack8(v);
      } else if (gc < 832) {
        int d = gc - 768;
        if (pos >= CTX) rope8(v, Ct + i * CLD, cc * 8, d, pos - CTX, B);
        u32x4 o = pack8(v);
#pragma unroll
        for (int hh = 0; hh < 4; ++hh) *(u32x4*)(B.KF_() + ((size_t)(b * 4 + hh) * LT + pos) * 192 + 128 + d) = o;
      } else if (gc < 1344) {
#pragma unroll
        for (int e = 0; e < 8; ++e) v[e] = siluf(v[e]);
        *(u32x4*)(B.HQ_() + grow * 512 + (gc - 832)) = pack8(v);
      } else if (gc < 2368) {
        int dir = gc >= 1856, ch = gc - (dir ? 1856 : 1344);
        u32x4 o;
        float lf[8];
        float lb8[8];
        ld8(lb8, B.lb_() + dir * 512 + ch);
#pragma unroll
        for (int e = 0; e < 8; ++e) {
          float lbv = lb8[e];
          float f = lbv + (1.f - lbv) / (1.f + __expf(-v[e]));
          lf[e] = logf(f);
        }
#pragma unroll
        for (int q = 0; q < 4; ++q) o[q] = (unsigned)f2h(lf[2 * q]) | ((unsigned)f2h(lf[2 * q + 1]) << 16);
        *(u32x4*)(B.LF_() + (size_t)dir * M * 512 + grow * 512 + ch) = o;
      } else if (gc < 2880) {
        *(u32x4*)(B.HI_() + grow * 512 + (gc - 2368)) = pack8(v);
      } else if (gc < 3392) {
        *(u32x4*)(B.HG_() + grow * 512 + (gc - 2880)) = pack8(v);
      }
    }
  } else if (EPI == EPI_UQ) {
    const int b = rowbase / LT, nl0 = rowbase - b * LT - CTX;
#pragma unroll 1
    for (int it = 0; it < 8; ++it) {
      int id = it * 256 + tid, i = id >> 4, cc = id & 15;
      int gc = n0 + cc * 8, head = gc / 192, dd = gc - head * 192, n = nl0 + i;
      float v[8];
      ld8(v, Ct + i * CLD + cc * 8);
      if (dd >= 128) rope8(v, Ct + i * CLD, cc * 8, dd - 128, n, B);
      const float s = rsqrtf(rowss[i] * (1.f / 512.f) + EPS) * QS_MLA;
#pragma unroll
      for (int e = 0; e < 8; ++e) v[e] *= s;
      *(u32x4*)(B.QF_() + ((size_t)(b * 4 + head) * SEQ + n) * 192 + dd) = pack8(v);
    }
  } else if (EPI == EPI_UKV) {
    const int b = rowbase / LT, pos0 = rowbase - b * LT, head = n0 >> 8;
    if ((n0 & 128) == 0) {
#pragma unroll 1
      for (int it = 0; it < 8; ++it) {
        int id = it * 256 + tid, i = id >> 4, cc = id & 15;
        const float s = rsqrtf(rowss[i] * (1.f / 256.f) + EPS);
        float v[8];
#pragma unroll
        for (int e = 0; e < 8; ++e) v[e] = Ct[i * CLD + cc * 8 + e] * s;
        *(u32x4*)(B.KF_() + ((size_t)(b * 4 + head) * LT + pos0 + i) * 192 + cc * 8) = pack8(v);
      }
    } else {
#pragma unroll 1
      for (int it = 0; it < 8; ++it) {
        int id = it * 256 + tid, c = id & 127, rc = id >> 7;
        float v[8];
#pragma unroll
        for (int e = 0; e < 8; ++e)
          v[e] = Ct[(rc * 8 + e) * CLD + c] * rsqrtf(rowss[rc * 8 + e] * (1.f / 256.f) + EPS);
        *(u32x4*)(B.VT1_() + ((size_t)(b * 4 + head) * 128 + c) * LT + pos0 + rc * 8) = pack8(v);
      }
    }
  } else if (EPI == EPI_FFN1) {
    const int nt = n0 >> 7;
    const float* cw = p.in[10] + (size_t)ea.layer * 3 * DFF;
    const float* cb = p.in[11] + (size_t)ea.layer * DFF;
    u16* G = ea.layer ? B.G1_() : B.G0_();
#pragma unroll 1
    for (int it = 0; it < 4; ++it) {
      int id = it * 256 + tid, i = id >> 3, cc = id & 7;
      int grow = rowbase + i;
      if (i >= 1 && i <= 126 && grow < ea.seg_hi) {
        const bool hp = (grow - 1 >= ea.seg_lo), hn = (grow + 1 < ea.seg_hi);
        float a[8], ap[8], an[8], u[8], w0[8], w1[8], w2[8], bb[8], v[8];
        const int fc0 = nt * 64 + cc * 8;
        ld8(a, Ct + i * CLD + cc * 8); ld8(ap, Ct + (i - 1) * CLD + cc * 8); ld8(an, Ct + (i + 1) * CLD + cc * 8);
        ld8(u, Ct + i * CLD + 64 + cc * 8);
        ld8(w0, cw + fc0); ld8(w1, cw + DFF + fc0); ld8(w2, cw + 2 * DFF + fc0); ld8(bb, cb + fc0);
#pragma unroll
        for (int e = 0; e < 8; ++e) {
          float av = (hp ? ap[e] : 0.f) * w0[e] + a[e] * w1[e] + (hn ? an[e] : 0.f) * w2[e] + bb[e];
          v[e] = siluf(av) * u[e];
        }
        *(u32x4*)(G + (size_t)grow * DFF + nt * 64 + cc * 8) = pack8(v);
      }
    }
  }
}

template <int EPI, bool SUMSQ>
DI void gemm_tile(char* smem, const Params& p, const Bufs& B, const u16* __restrict__ A, int lda, int rowbase,
                  int rlo, int rhi, const u16* __restrict__ Bt, int K, int n0, const EpiArgs& ea) {
  u16* As = (u16*)smem;
  u16* Bs = As + 2 * 128 * LDT;
  float* Ct = (float*)smem;
  float* rowss = Ct + 128 * CLD;
  const int tid = otid(), lane = tid & 63, wid = tid >> 6, wm = wid >> 1, wn = wid & 1, r = lane & 31,
            h = lane >> 5;
  const int lrow = tid >> 3, lkc = tid & 7;
  int aoff[4], boff[4];
#pragma unroll
  for (int it = 0; it < 4; ++it) {
    int gr = rowbase + it * 32 + lrow;
    gr = gr < rlo ? rlo : (gr > rhi - 1 ? rhi - 1 : gr);
    aoff[it] = gr * lda + lkc * 8;
    boff[it] = (n0 + it * 32 + lrow) * K + lkc * 8;
  }
  u32x4 ra0[4], rb0[4], ra1[4], rb1[4];
  float ssq[4] = {0.f, 0.f, 0.f, 0.f};
  f32x16 acc[2][2];
#pragma unroll
  for (int i = 0; i < 2; ++i)
#pragma unroll
    for (int j = 0; j < 2; ++j)
#pragma unroll
      for (int g = 0; g < 16; ++g) acc[i][j][g] = 0.f;
  const int nk = K >> 6;
#pragma unroll
  for (int it = 0; it < 4; ++it) {
    ra0[it] = *(const u32x4*)(A + aoff[it]);
    rb0[it] = *(const u32x4*)(Bt + boff[it]);
  }
#pragma unroll
  for (int it = 0; it < 4; ++it) {
    ra1[it] = *(const u32x4*)(A + aoff[it] + 64);
    rb1[it] = *(const u32x4*)(Bt + boff[it] + 64);
  }
#define GEMM_STEP(RA, RB, BUF, TNEXT)                                                  \
  {                                                                                    \
    u16* Aw = As + (BUF) * 128 * LDT;                                                  \
    u16* Bw = Bs + (BUF) * 128 * LDT;                                                  \
    _Pragma("unroll") for (int it = 0; it < 4; ++it) {                                 \
      *(u32x4*)(Aw + (it * 32 + lrow) * LDT + lkc * 8) = RA[it];                       \
      *(u32x4*)(Bw + (it * 32 + lrow) * LDT + lkc * 8) = RB[it];                       \
      if (SUMSQ) {                                                                     \
        _Pragma("unroll") for (int q = 0; q < 4; ++q) {                                \
          float lo = bflo(RA[it][q]), hi = bfhi(RA[it][q]);                            \
          ssq[it] += lo * lo + hi * hi;                                                \
        }                                                                              \
      }                                                                                \
    }                                                                                  \
    __syncthreads();                                                                   \
    if ((TNEXT) < nk) {                                                                \
      _Pragma("unroll") for (int it = 0; it < 4; ++it) {                               \
        RA[it] = *(const u32x4*)(A + aoff[it] + (TNEXT) * 64);                         \
        RB[it] = *(const u32x4*)(Bt + boff[it] + (TNEXT) * 64);                        \
      }                                                                                \
    }                                                                                  \
    mma_ktile(Aw, Bw, acc, wm, wn, r, h);                                              \
  }
  for (int t = 0; t < nk; t += 2) {
    GEMM_STEP(ra0, rb0, 0, t + 2)
    GEMM_STEP(ra1, rb1, 1, t + 3)
  }
#undef GEMM_STEP
  __syncthreads();
  acc_to_lds(Ct, acc, wm, wn, r, h);
  if (SUMSQ) {
#pragma unroll
    for (int it = 0; it < 4; ++it) {
      float s = ssq[it];
      s += __shfl_xor(s, 1); s += __shfl_xor(s, 2); s += __shfl_xor(s, 4);
      if (lkc == 0) rowss[it * 32 + lrow] = s;
    }
  }
  __syncthreads();
  epilogue<EPI>(p, B, Ct, rowss, rowbase, n0, ea);
  __syncthreads();
}

DI void pool_tile(char* smem, const Params& p, const Bufs& B, int rt, int g) {
  u16* As = (u16*)smem;
  u16* Bs = As + 2 * 128 * LDT;
  float* Ct = (float*)smem;
  const int tid = otid(), lane = tid & 63, wid = tid >> 6, wm = wid >> 1, wn = wid & 1, r = lane & 31,
            h = lane >> 5;
  const int rowbase = rt * 128;
  const int b = rowbase / LT, pos0 = rowbase - b * LT;
  const int seg_lo = (pos0 < CTX) ? b * LT : b * LT + CTX;
  const int seg_hi = (pos0 < CTX) ? b * LT + CTX : (b + 1) * LT;
#pragma unroll
  for (int it = 0; it < 8; ++it) {
    int c = it * 256 + tid, n = c >> 4, kc = c & 15;
    u32x4 v = *(const u32x4*)(B.wt_pool_() + (size_t)g * 128 * 128 + n * 128 + kc * 8);
    *(u32x4*)(Bs + (kc >> 3) * 128 * LDT + n * LDT + (kc & 7) * 8) = v;
  }
  {
    const int ch = tid & 127, rh = tid >> 7, hw = 1 << g;
    const u16* Ucol = B.U_() + g * 128 + ch;
    const int t0 = rowbase + rh * 64;
    int lo = max(t0 - hw, seg_lo), hi = min(t0 + hw, seg_hi);
    float sum = 0.f;
    for (int s = lo; s < hi; ++s) sum += bf2f(Ucol[(size_t)s * 512]);
    u16* Ad = As + (ch >> 6) * 128 * LDT + (ch & 63);
    for (int i = 0; i < 64; ++i) {
      int t = t0 + i;
      float cnt = (float)(hi - lo);
      float d = sum / cnt - bf2f(Ucol[(size_t)t * 512]);
      Ad[(rh * 64 + i) * LDT] = f2bf(d);
      if (t + hw < seg_hi) { sum += bf2f(Ucol[(size_t)(t + hw) * 512]); hi = t + hw + 1; }
      if (t - hw >= seg_lo) { sum -= bf2f(Ucol[(size_t)(t - hw) * 512]); lo = t - hw + 1; }
    }
  }
  __syncthreads();
  f32x16 acc[2][2];
#pragma unroll
  for (int i = 0; i < 2; ++i)
#pragma unroll
    for (int j = 0; j < 2; ++j)
#pragma unroll
      for (int q = 0; q < 16; ++q) acc[i][j][q] = 0.f;
  mma_ktile(As, Bs, acc, wm, wn, r, h);
  mma_ktile(As + 128 * LDT, Bs + 128 * LDT, acc, wm, wn, r, h);
  __syncthreads();
  acc_to_lds(Ct, acc, wm, wn, r, h);
  __syncthreads();
  EpiArgs ea{}; ea.aux = g;
  epilogue<EPI_POOL>(p, B, Ct, nullptr, rowbase, 0, ea);
  __syncthreads();
}

template <int DQK, int KT>
DI void attn_pass(char* smem, const u16* __restrict__ Qg, const u16* __restrict__ Kg, const u16* __restrict__ VTg,
                  int nk, f32x16 (&O)[4], float& l_out) {
  constexpr int KLD = DQK + 8, NKS = DQK / 16, KCH = DQK / 8, KPT = KT * KCH / 256, VLD = KT + 8, VPT = KT / 16,
                KB = KT / 32, VCH = KT / 8;
  u16* Ks = (u16*)smem;
  u16* Vs = Ks + KT * KLD;
  const int tid = otid(), lane = tid & 63, wid = tid >> 6, r = lane & 31, h = lane >> 5;
  bf16x8 qf[NKS];
#pragma unroll
  for (int ks = 0; ks < NKS; ++ks) qf[ks] = *(const bf16x8*)(Qg + (size_t)(wid * 32 + r) * DQK + ks * 16 + h * 8);
  u32x4 rk[KPT], rv[VPT];
#pragma unroll
  for (int dvb = 0; dvb < 4; ++dvb)
#pragma unroll
    for (int g = 0; g < 16; ++g) O[dvb][g] = 0.f;
  float m = -1e30f, l = 0.f;
  const int nt = nk / KT;
  int kgo[KPT], klo[KPT], vgo[VPT], vlo[VPT];
#pragma unroll
  for (int it = 0; it < KPT; ++it) {
    int c = it * 256 + tid, key = c / KCH, kc = c - key * KCH;
    int rho = (key & ~12) | ((key & 4) << 1) | ((key & 8) >> 1);
    kgo[it] = key * DQK + kc * 8;
    klo[it] = rho * KLD + kc * 8;
  }
#pragma unroll
  for (int it = 0; it < VPT; ++it) {
    int c = it * 256 + tid, dv = c / VCH, kc = c - dv * VCH;
    vgo[it] = dv * LT + kc * 8;
    vlo[it] = dv * VLD + kc * 8;
  }
#pragma unroll
  for (int it = 0; it < KPT; ++it) rk[it] = *(const u32x4*)(Kg + kgo[it]);
#pragma unroll
  for (int it = 0; it < VPT; ++it) rv[it] = *(const u32x4*)(VTg + vgo[it]);
  for (int t = 0; t < nt; ++t) {
    __syncthreads();
#pragma unroll
    for (int it = 0; it < KPT; ++it) *(u32x4*)(Ks + klo[it]) = rk[it];
#pragma unroll
    for (int it = 0; it < VPT; ++it) *(u32x4*)(Vs + vlo[it]) = rv[it];
    __syncthreads();
    if (t + 1 < nt) {
      const u16* Kn = Kg + (size_t)(t + 1) * KT * DQK;
      const u16* Vn = VTg + (t + 1) * KT;
#pragma unroll
      for (int it = 0; it < KPT; ++it) rk[it] = *(const u32x4*)(Kn + kgo[it]);
#pragma unroll
      for (int it = 0; it < VPT; ++it) rv[it] = *(const u32x4*)(Vn + vgo[it]);
    }
    f32x16 S[KB];
#pragma unroll
    for (int kb = 0; kb < KB; ++kb) {
#pragma unroll
      for (int g = 0; g < 16; ++g) S[kb][g] = 0.f;
#pragma unroll
      for (int ks = 0; ks < NKS; ++ks) {
        bf16x8 a = *(const bf16x8*)(Ks + (kb * 32 + r) * KLD + ks * 16 + h * 8);
        S[kb] = MFMA32(a, qf[ks], S[kb]);
      }
    }
    float mx = -1e30f;
#pragma unroll
    for (int kb = 0; kb < KB; ++kb)
#pragma unroll
      for (int g = 0; g < 16; ++g) mx = fmaxf(mx, S[kb][g]);
    mx = fmaxf(mx, __shfl_xor(mx, 32));
    const float mn = fmaxf(m, mx);
    const float alpha = __builtin_amdgcn_exp2f(m - mn);
    const bool chg = __any(mn > m);
    m = mn;
    float ps = 0.f;
#pragma unroll
    for (int kb = 0; kb < KB; ++kb)
#pragma unroll
      for (int g = 0; g < 16; ++g) {
        float pv = __builtin_amdgcn_exp2f(S[kb][g] - mn);
        S[kb][g] = pv;
        ps += pv;
      }
    l = l * alpha + ps;
    if (chg) {
#pragma unroll
      for (int dvb = 0; dvb < 4; ++dvb)
#pragma unroll
        for (int g = 0; g < 16; ++g) O[dvb][g] *= alpha;
    }
    bf16x8 pf[KB][2];
#pragma unroll
    for (int kb = 0; kb < KB; ++kb)
#pragma unroll
      for (int s = 0; s < 2; ++s) {
        u32x4 o;
#pragma unroll
        for (int q = 0; q < 4; ++q) o[q] = pk2(S[kb][8 * s + 2 * q], S[kb][8 * s + 2 * q + 1]);
        pf[kb][s] = __builtin_bit_cast(bf16x8, o);
      }
#pragma unroll
    for (int dvb = 0; dvb < 4; ++dvb) {
#pragma unroll
      for (int kb = 0; kb < KB; ++kb)
#pragma unroll
        for (int s = 0; s < 2; ++s) {
          bf16x8 a = *(const bf16x8*)(Vs + (dvb * 32 + r) * VLD + kb * 32 + s * 16 + h * 8);
          O[dvb] = MFMA32(a, pf[kb][s], O[dvb]);
        }
      if (dvb & 1) asm volatile("" ::: "memory");
    }
  }
  l_out = l + __shfl_xor(l, 32);
}

DI void diff_attn_item(char* smem, const Params& p, const Bufs& B, int b, int vh, int pos0, int nk) {
  const int tid = otid(), lane = tid & 63, wid = tid >> 6, r = lane & 31, h = lane >> 5;
  f32x16 O[4];
  unsigned* Okl = (unsigned*)(smem + 40960);
  const float lam = B.lam_()[0];
  const u16* VT = B.VT0_() + (size_t)(b * 4 + vh) * 128 * LT;
  float ss = 0.f;
#pragma unroll
  for (int e = 0; e < 2; ++e) {
    const int head = 2 * vh + e;
    const u16* Q = B.Q0_() + ((size_t)(b * 8 + head) * LT + pos0) * 64;
    const u16* K = B.K0_() + (size_t)(b * 8 + head) * LT * 64;
    float l;
    attn_pass<64, 64>(smem, Q, K, VT, nk, O, l);
    const float inv = 1.f / l;
    if (e == 0) {
#pragma unroll
      for (int dvb = 0; dvb < 4; ++dvb)
#pragma unroll
        for (int q = 0; q < 8; ++q) Okl[(dvb * 8 + q) * 256 + tid] = pk2(O[dvb][2 * q] * inv, O[dvb][2 * q + 1] * inv);
    } else {
#pragma unroll
      for (int dvb = 0; dvb < 4; ++dvb)
#pragma unroll
        for (int q = 0; q < 8; ++q) {
          unsigned o0 = Okl[(dvb * 8 + q) * 256 + tid];
          float a0 = bflo(o0) - lam * (O[dvb][2 * q] * inv), a1 = bfhi(o0) - lam * (O[dvb][2 * q + 1] * inv);
          O[dvb][2 * q] = a0; O[dvb][2 * q + 1] = a1;
          ss += a0 * a0 + a1 * a1;
        }
    }
  }
  ss += __shfl_xor(ss, 32);
  const float rstd = rsqrtf(ss * (1.f / 128.f) + EPS) * 0.8f;
  const float* sub = p.in[17];
  u16* orow = B.MIX0_() + (size_t)(b * LT + pos0 + wid * 32 + r) * 1024 + 512 + vh * 128;
#pragma unroll
  for (int dvb = 0; dvb < 4; ++dvb)
#pragma unroll
    for (int g = 0; g < 4; ++g) {
      int dv0 = dvb * 32 + 8 * g + 4 * h;
      u32x2 o;
      o[0] = pk2(O[dvb][4 * g] * rstd * sub[dv0], O[dvb][4 * g + 1] * rstd * sub[dv0 + 1]);
      o[1] = pk2(O[dvb][4 * g + 2] * rstd * sub[dv0 + 2], O[dvb][4 * g + 3] * rstd * sub[dv0 + 3]);
      *(u32x2*)(orow + dv0) = o;
    }
}

DI void mla_attn_item(char* smem, const Bufs& B, int b, int hd, int qt) {
  const int lane = otid() & 63, wid = otid() >> 6, r = lane & 31, h = lane >> 5;
  f32x16 O[4];
  float l;
  const u16* Q = B.QF_() + ((size_t)(b * 4 + hd) * SEQ + qt * 128) * 192;
  const u16* K = B.KF_() + (size_t)(b * 4 + hd) * LT * 192;
  const u16* VT = B.VT1_() + (size_t)(b * 4 + hd) * 128 * LT;
  attn_pass<192, 32>(smem, Q, K, VT, LT, O, l);
  const float inv = 1.f / l;
  u16* orow = B.MIX1_() + (size_t)(b * LT + CTX + qt * 128 + wid * 32 + r) * 1024 + hd * 128;
#pragma unroll
  for (int dvb = 0; dvb < 4; ++dvb)
#pragma unroll
    for (int g = 0; g < 4; ++g) {
      int dv0 = dvb * 32 + 8 * g + 4 * h;
      u32x2 o;
      o[0] = pk2(O[dvb][4 * g] * inv, O[dvb][4 * g + 1] * inv);
      o[1] = pk2(O[dvb][4 * g + 2] * inv, O[dvb][4 * g + 3] * inv);
      *(u32x2*)(orow + dv0) = o;
    }
}

constexpr int HLD = 136;
DI void hgrn_item(char* smem, const Bufs& B, int b, int hd, int dir) {
  u16* Qs = (u16*)smem;
  u16* Ksm = Qs + 64 * HLD;
  u16* KsT = Ksm + 64 * HLD;
  u16* VsT = KsT + 128 * LDT;
  float* emid = (float*)(VsT + 128 * LDT);
  float* ecm = emid + 128;
  const int tid = otid(), lane = tid & 63, w = tid >> 6, r = lane & 31, h = lane >> 5;
  f32x16 S[4];
#pragma unroll
  for (int kb = 0; kb < 4; ++kb)
#pragma unroll
    for (int g = 0; g < 16; ++g) S[kb][g] = 0.f;
  const u16* LFd = B.LF_() + (size_t)dir * M * 512;
  u16* OHd = B.OH_() + (size_t)dir * M * 512;
  for (int ci = 0; ci < 68; ++ci) {
    const int c = dir ? (ci < 4 ? 3 - ci : 71 - ci) : ci;
    const int rowc = b * LT + c * 64;
#pragma unroll
    for (int it = 0; it < 4; ++it) {
      int cid = it * 256 + tid, pp = cid >> 4, cc = cid & 15;
      size_t grow = (size_t)(rowc + (dir ? 63 - pp : pp));
      u32x4 qv = *(const u32x4*)(B.HQ_() + grow * 512 + hd * 128 + cc * 8);
      u32x4 lv = *(const u32x4*)(LFd + grow * 512 + hd * 128 + cc * 8);
      u32x4 vv = *(const u32x4*)(B.HI_() + grow * 512 + hd * 128 + cc * 8);
      *(u32x4*)(Qs + pp * HLD + cc * 8) = qv;
      *(u32x4*)(Ksm + pp * HLD + cc * 8) = lv;
#pragma unroll
      for (int q = 0; q < 4; ++q) {
        VsT[(cc * 8 + 2 * q) * LDT + pp] = (u16)(vv[q] & 0xffffu);
        VsT[(cc * 8 + 2 * q + 1) * LDT + pp] = (u16)(vv[q] >> 16);
      }
    }
    __syncthreads();
    {
      const int ch = tid & 127, half = tid >> 7;
      float tot0 = 0.f;
      for (int pp = 0; pp < 32; ++pp) tot0 += h2f(Ksm[pp * HLD + ch]);
      __syncthreads();
      float run = half ? 0.f : -tot0;
#pragma unroll
      for (int p8 = 0; p8 < 4; ++p8) {
        float kt[8];
#pragma unroll
        for (int e = 0; e < 8; ++e) {
          int pp = half * 32 + p8 * 8 + e;
          float lf = h2f(Ksm[pp * HLD + ch]);
          run += lf;
          float q = bf2f(Qs[pp * HLD + ch]);
          float er = __expf(run);
          Qs[pp * HLD + ch] = f2bf(q * er);
          kt[e] = (1.f - __expf(lf)) / er;
          Ksm[pp * HLD + ch] = f2bf(kt[e]);
        }
        *(u32x4*)(KsT + ch * LDT + half * 32 + p8 * 8) = pack8(kt);
      }
      if (half == 0) emid[ch] = __expf(tot0); else ecm[ch] = __expf(run);
    }
    __syncthreads();
    bf16x8 xa[4][2];
#pragma unroll
    for (int kb = 0; kb < 4; ++kb) {
#pragma unroll
      for (int g = 0; g < 16; ++g) S[kb][g] *= emid[kb * 32 + crow(g, h)];
#pragma unroll
      for (int s = 0; s < 2; ++s) {
        u32x4 o;
#pragma unroll
        for (int q = 0; q < 4; ++q) o[q] = pk2(S[kb][8 * s + 2 * q], S[kb][8 * s + 2 * q + 1]);
        xa[kb][s] = __builtin_bit_cast(bf16x8, o);
      }
    }
#pragma unroll
    for (int tb = 0; tb < 2; ++tb) {
      f32x16 oT;
#pragma unroll
      for (int g = 0; g < 16; ++g) oT[g] = 0.f;
#pragma unroll
      for (int kb = 0; kb < 4; ++kb)
#pragma unroll
        for (int s = 0; s < 2; ++s) {
          const u16* qp = Qs + (tb * 32 + r) * HLD + kb * 32 + s * 16 + 4 * h;
          u32x2 lo = *(const u32x2*)qp, hi = *(const u32x2*)(qp + 8);
          u32x4 bq = {lo[0], lo[1], hi[0], hi[1]};
          oT = MFMA32(xa[kb][s], __builtin_bit_cast(bf16x8, bq), oT);
        }
#pragma unroll
      for (int sb = 0; sb <= tb; ++sb) {
        f32x16 P;
#pragma unroll
        for (int g = 0; g < 16; ++g) P[g] = 0.f;
#pragma unroll
        for (int ks = 0; ks < 8; ++ks) {
          bf16x8 a = *(const bf16x8*)(Ksm + (sb * 32 + r) * HLD + ks * 16 + h * 8);
          bf16x8 bb = *(const bf16x8*)(Qs + (tb * 32 + r) * HLD + ks * 16 + h * 8);
          P = MFMA32(a, bb, P);
        }
        if (sb == tb) {
#pragma unroll
          for (int g = 0; g < 16; ++g) P[g] = (crow(g, h) <= r) ? P[g] : 0.f;
        }
#pragma unroll
        for (int s = 0; s < 2; ++s) {
          u32x4 o;
#pragma unroll
          for (int q = 0; q < 4; ++q) o[q] = pk2(P[8 * s + 2 * q], P[8 * s + 2 * q + 1]);
          const u16* vp = VsT + (w * 32 + r) * LDT + sb * 32 + s * 16 + 4 * h;
          u32x2 lo = *(const u32x2*)vp, hi = *(const u32x2*)(vp + 8);
          u32x4 av = {lo[0], lo[1], hi[0], hi[1]};
          oT = MFMA32(__builtin_bit_cast(bf16x8, av), __builtin_bit_cast(bf16x8, o), oT);
        }
      }
      {
        int pp = tb * 32 + r;
        size_t grow = (size_t)(rowc + (dir ? 63 - pp : pp));
        u16* op = OHd + grow * 512 + hd * 128 + w * 32;
#pragma unroll
        for (int g4 = 0; g4 < 4; ++g4) {
          u32x2 o;
          o[0] = pk2(oT[4 * g4], oT[4 * g4 + 1]);
          o[1] = pk2(oT[4 * g4 + 2], oT[4 * g4 + 3]);
          *(u32x2*)(op + 8 * g4 + 4 * h) = o;
        }
      }
    }
#pragma unroll
    for (int kb = 0; kb < 4; ++kb) {
#pragma unroll
      for (int ts = 0; ts < 4; ++ts) {
        bf16x8 a = *(const bf16x8*)(KsT + (kb * 32 + r) * LDT + ts * 16 + h * 8);
        bf16x8 bb = *(const bf16x8*)(VsT + (w * 32 + r) * LDT + ts * 16 + h * 8);
        S[kb] = MFMA32(a, bb, S[kb]);
      }
#pragma unroll
      for (int g = 0; g < 16; ++g) S[kb][g] *= ecm[kb * 32 + crow(g, h)];
    }
    __syncthreads();
  }
}

DI void hgrn_readout_row(const Params& p, const Bufs& B, int grow, int hd, int lane) {
  const size_t o = (size_t)grow * 512 + hd * 128 + lane * 2;
  unsigned a = *(const unsigned*)(B.OH_() + o), bq = *(const unsigned*)(B.OH_() + (size_t)M * 512 + o);
  unsigned gq = *(const unsigned*)(B.HG_() + o);
  float v0 = bflo(a) + bflo(bq), v1 = bfhi(a) + bfhi(bq);
  float ss = wave_sum(v0 * v0 + v1 * v1);
  float rstd = rsqrtf(ss * (1.f / 128.f) + EPS);
  const float* hn = p.in[23];
  float g0 = bflo(gq), g1 = bfhi(gq);
  unsigned out = pk2(v0 * rstd * hn[lane * 2] * siluf(g0), v1 * rstd * hn[lane * 2 + 1] * siluf(g1));
  *(unsigned*)(B.MIX1_() + (size_t)grow * 1024 + 512 + hd * 128 + lane * 2) = out;
}

constexpr int NPHASE = 18;


struct TileIter {
  int qg, step, ntn, nloc, total, xcd;
  DI TileIter(int nrt, int ntn_) {
    xcd = blockIdx.x & 7; qg = blockIdx.x >> 3; step = gridDim.x >> 3; ntn = ntn_;
    nloc = (nrt - xcd + 7) >> 3;
    total = ((nloc + 7) >> 3) * 8 * ntn;
  }
  DI bool next(int& rt, int& nt) {
    const int per = 8 * ntn, full = ntn >> 3, wrem = ntn & 7;
    while (qg < total) {
      int grp = qg / per, q = qg - grp * per, r, c;
      qg += step;
      if (q < full * 64) { int ch = q >> 6, qq = q & 63; r = qq >> 3; c = ch * 8 + (qq & 7); }
      else { int qq = q - full * 64; r = qq / wrem; c = full * 8 + (qq - r * wrem); }
      int rl = grp * 8 + r;
      if (rl < nloc) { rt = rl * 8 + xcd; nt = c; return true; }
    }
    return false;
  }
};

DI int lat_rowbase(int rt) { return (rt >> 5) * LT + CTX + (rt & 31) * 128; }

DI void run_phase(int ph, const Params& p, const Bufs& B, char* smem) {
  const int bid = blockIdx.x, nb = gridDim.x, tid = otid(), lane = tid & 63, wid = tid >> 6;
  switch (ph) {
    case 0: {
      const int n = NW_P0 + 192 + 1;
      for (int it = bid; it < n; it += nb) {
        if (it < NW_P0) prep_weight_item(smem, p, B, it);
        else if (it < NW_P0 + 192) mod_gemv_item(smem, p, B, it - NW_P0);
        else tables_item(p, B);
      }
    } break;
    case 1: {
      for (int it = bid; it < M / 32; it += nb) {
        for (int rr = 0; rr < 8; ++rr) {
          int row = it * 32 + rr * 4 + wid;
          RowInfo ri = row_info(row);
          const float* x = (ri.lat ? p.in[0] : p.in[2]) + resid_off(ri);
          const float* md = B.mod_() + (size_t)(0 * 9 + ri.mi) * 6144;
          norm_mod_row(x, p.in[6] + 0, md, md + 1024, B.H_() + (size_t)row * 1024, lane);
        }
      }
    } break;
    case 2: {
      const int n = 272 * 16;
      EpiArgs ea{};
      TileIter ti(272, 16);
      for (int rt, nt; ti.next(rt, nt);) {
        gemm_tile<EPI_IN0, false>(smem, p, B, B.H_(), 1024, rt * 128, 0, M, B.wt_ev_(), 1024, nt * 128, ea);
      }
    } break;
    case 3: {
      const int n_lat = 8 * 4 * 32, n_ctx = 8 * 4 * 2, n_pool = 272 * 4;
      for (int it = bid; it < n_lat; it += nb) {
        int b = it >> 7, vh = (it >> 5) & 3, qt = it & 31;
        diff_attn_item(smem, p, B, b, vh, CTX + qt * 128, LT);
      }
      for (int it = nb - 1 - bid; it < n_ctx; it += nb) {
        int b = it >> 3, vh = (it >> 1) & 3, qt = it & 1;
        diff_attn_item(smem, p, B, b, vh, qt * 128, CTX);
      }
      for (int it = nb - 1 - bid; it < n_pool; it += nb) pool_tile(smem, p, B, it >> 2, it & 3);
    } break;
    case 4: {
      EpiArgs ea{}; ea.outf = B.Y0_();
      TileIter ti(272, 8);
      for (int rt, nt; ti.next(rt, nt);) {
        gemm_tile<EPI_F32, false>(smem, p, B, B.MIX0_(), 1024, rt * 128, 0, M, B.wt_out_(), 1024, nt * 128, ea);
      }
    } break;
    case 5: case 8: {
      const bool first = (ph == 5);
      const u16* Yb = (const u16*)B.Y0_();
      for (int it = bid; it < M / 32; it += nb) {
        for (int rr = 0; rr < 8; ++rr) {
          int row = it * 32 + rr * 4 + wid;
          RowInfo ri = row_info(row);
          size_t ro = resid_off(ri);
          const float* md0 = B.mod_() + (size_t)(0 * 9 + ri.mi) * 6144;
          const float* md1 = B.mod_() + (size_t)(1 * 9 + ri.mi) * 6144;
          float* xd = (ri.lat ? p.out : B.xc_()) + ro;
          if (first) {
            const float* xs = (ri.lat ? p.in[0] : p.in[2]) + ro;
            resid_row<true>(Yb + (size_t)row * 1024, xs, xd, md0 + 2 * 1024, p.in[6] + 1 * 1024, p.in[6] + 2 * 1024,
                            md0 + 3 * 1024, md0 + 4 * 1024, B.H_() + (size_t)row * 1024, lane);
          } else {
            resid_row<true>(Yb + (size_t)row * 1024, xd, xd, md0 + 5 * 1024, p.in[6] + 3 * 1024,
                            p.in[6] + 4 * 1024 + 0, md1, md1 + 1024, B.H_() + (size_t)row * 1024, lane);
          }
        }
      }
    } break;
    case 6: {
      const int n = 288 * 44;
      TileIter ti(288, 44);
      for (int rtile, nt; ti.next(rtile, nt);) {
        int b = rtile / 36, jj = rtile - b * 36;
        EpiArgs ea{}; ea.layer = 0;
        int j;
        if (jj < 3) { ea.seg_lo = b * LT; ea.seg_hi = b * LT + CTX; j = jj; }
        else { ea.seg_lo = b * LT + CTX; ea.seg_hi = (b + 1) * LT; j = jj - 3; }
        gemm_tile<EPI_FFN1, false>(smem, p, B, B.H_(), 1024, ea.seg_lo + 126 * j - 1, ea.seg_lo, ea.seg_hi, B.wt_f1_(), 1024,
                                   nt * 128, ea);
      }
    } break;
    case 7: {
      EpiArgs ea{}; ea.outf = B.Y0_();
      TileIter ti(272, 8);
      for (int rt, nt; ti.next(rt, nt);) {
        gemm_tile<EPI_F32, false>(smem, p, B, B.G0_(), DFF, rt * 128, 0, M, B.wt_f2_(), DFF, nt * 128, ea);
      }
    } break;
    case 9: {
      const int n = 272 * 27;
      EpiArgs ea{};
      TileIter ti(272, 27);
      for (int rt, nt; ti.next(rt, nt);) {
        gemm_tile<EPI_IN1, false>(smem, p, B, B.H_(), 1024, rt * 128, 0, M, B.wt_od_(), 1024, nt * 128, ea);
      }
    } break;
    case 10: {
      const int n_q = 256 * 6, n_kv = 272 * 8;
      EpiArgs ea{};
      TileIter tq(256, 6);
      for (int rt, nt; tq.next(rt, nt);) {
        gemm_tile<EPI_UQ, true>(smem, p, B, B.CQ_(), 512, lat_rowbase(rt), 0, M, B.wt_uq_(), 512, nt * 128, ea);
      }
      TileIter tk(272, 8);
      for (int rt, nt; tk.next(rt, nt);) {
        gemm_tile<EPI_UKV, true>(smem, p, B, B.CKV_(), 256, rt * 128, 0, M, B.wt_ukv_(), 256, nt * 128, ea);
      }
      for (int it = nb - 1 - bid; it < NW_FFN; it += nb) ffn_weight_item(smem, p, B, 1, it);
    } break;
    case 11: {
      const int n_h = 64, n_a = 8 * 4 * 32;
      for (int it = bid; it < n_h; it += nb) hgrn_item(smem, B, it >> 3, (it >> 1) & 3, it & 1);
      for (int it = nb - 1 - bid; it < n_a; it += nb) mla_attn_item(smem, B, it >> 7, (it >> 5) & 3, it & 31);
    } break;
    case 12: {
      const int n = NB * SEQ * 4 / 4;
      for (int it = bid; it < n; it += nb) {
        int j = it * 4 + wid, rl = j >> 2, hd = j & 3;
        int grow = (rl >> 12) * LT + CTX + (rl & 4095);
        hgrn_readout_row(p, B, grow, hd, lane);
      }
    } break;
    case 13: {
      EpiArgs ea{}; ea.outf = B.Y1_();
      TileIter ti(256, 8);
      for (int rt, nt; ti.next(rt, nt);) {
        gemm_tile<EPI_F32, false>(smem, p, B, B.MIX1_(), 1024, lat_rowbase(rt), 0, M, B.wt_out_() + 1024 * 1024, 1024,
                                  nt * 128, ea);
      }
    } break;
    case 14: case 17: {
      const bool first = (ph == 14);
      for (int it = bid; it < NB * SEQ / 32; it += nb) {
        for (int rr = 0; rr < 8; ++rr) {
          int rl = it * 32 + rr * 4 + wid;
          int bb = rl >> 12, row = bb * LT + CTX + (rl & 4095);
          float* xd = p.out + (size_t)rl * 1024;
          const float* md1 = B.mod_() + (size_t)(1 * 9 + bb) * 6144;
          const float* ng = p.in[6] + 4 * 1024;
          if (first)
            resid_row<true>((const u16*)B.Y1_() + (size_t)row * 1024, xd, xd, md1 + 2 * 1024, ng + 1 * 1024, ng + 2 * 1024,
                            md1 + 3 * 1024, md1 + 4 * 1024, B.H_() + (size_t)row * 1024, lane);
          else
            resid_row<false>((const u16*)B.Y1_() + (size_t)row * 1024, xd, xd, md1 + 5 * 1024, ng + 3 * 1024, nullptr, nullptr, nullptr,
                             nullptr, lane);
        }
      }
    } break;
    case 15: {
      const int n = 264 * 44;
      TileIter ti(264, 44);
      for (int rtile, nt; ti.next(rtile, nt);) {
        int b = rtile / 33, j = rtile - b * 33;
        EpiArgs ea{}; ea.layer = 1; ea.seg_lo = b * LT + CTX; ea.seg_hi = (b + 1) * LT;
        gemm_tile<EPI_FFN1, false>(smem, p, B, B.H_(), 1024, ea.seg_lo + 126 * j - 1, ea.seg_lo, ea.seg_hi, B.wt_f1_(), 1024,
                                   nt * 128, ea);
      }
    } break;
    case 16: {
      EpiArgs ea{}; ea.outf = B.Y1_();
      TileIter ti(256, 8);
      for (int rt, nt; ti.next(rt, nt);) {
        gemm_tile<EPI_F32, false>(smem, p, B, B.G1_(), DFF, lat_rowbase(rt), 0, M, B.wt_f2_(), DFF, nt * 128, ea);
      }
    } break;
    default: break;
  }
}

#define XB_TMO      128
#define XB_XCNT(j)  (256  + 64 * (j))
#define XB_XSUB(j)  (1280 + 64 * (j))
#define XB_XGEN(j)  (2304 + 64 * (j))
#define XB_TOP      3328
#define XB_TOPGEN   3392
#define XCD_BAR_WORDS 3456
#define XB_SPIN_CAP (1u << 18)
#define LAS __attribute__((address_space(3)))
DI unsigned xb_ld(unsigned* p) { return __hip_atomic_load(p, __ATOMIC_RELAXED, __HIP_MEMORY_SCOPE_AGENT); }
DI unsigned xb_add(unsigned* p, unsigned v) { return __hip_atomic_fetch_add(p, v, __ATOMIC_RELAXED, __HIP_MEMORY_SCOPE_AGENT); }
DI unsigned xb_xcc_id() { return (unsigned)__builtin_amdgcn_s_getreg((3 << 11) | 20) & 0xFu; }
#define XB_SPIN(cond, bar) do { unsigned _sp = 0; while (cond) { __builtin_amdgcn_s_sleep(1); \
    if ((++_sp & 255u) == 0u) { if (xb_ld(&(bar)[XB_TMO])) break; if (_sp > XB_SPIN_CAP) { atomicAdd(&(bar)[XB_TMO], 1u); break; } } } } while (0)
struct XcdBarrier { unsigned* bar; unsigned x; volatile LAS unsigned* st; };
DI XcdBarrier xcd_barrier_post(unsigned* bar, volatile LAS unsigned* st) {
  XcdBarrier b; b.bar = bar; b.x = xb_xcc_id(); b.st = st;
  if (threadIdx.x == 0) (void)xb_add(&bar[XB_XCNT(b.x)], 1u);
  return b;
}
DI void xcd_barrier_complete(unsigned* bar, unsigned x, unsigned& nloc, unsigned& nx) {
  const unsigned G = gridDim.x * gridDim.y * gridDim.z;
  unsigned sum, cnt, mine, sp = 0u;
  for (;;) {
    sum = 0u; cnt = 0u; mine = 0u;
#pragma unroll
    for (unsigned j = 0; j < 16; ++j) { const unsigned c = xb_ld(&bar[XB_XCNT(j)]); sum += c; cnt += (c > 0u) ? 1u : 0u; mine = (j == x) ? c : mine; }
    if (sum == G) break;
    __builtin_amdgcn_s_sleep(1);
    if ((++sp & 255u) == 0u) { if (xb_ld(&bar[XB_TMO])) break; if (sp > XB_SPIN_CAP) { atomicAdd(&bar[XB_TMO], 1u); break; } }
  }
  nloc = mine > 0u ? mine : 1u; nx = cnt > 0u ? cnt : 1u;
}
DI void xcd_barrier(const XcdBarrier& b) {
  asm volatile("s_waitcnt vmcnt(0)" ::: "memory");
  __syncthreads();
  if (threadIdx.x == 0) {
    unsigned* bar = b.bar;
    __builtin_amdgcn_s_waitcnt(0);
    unsigned nloc = b.st[0], nx = b.st[1];
    if (nloc == 0u) { xcd_barrier_complete(bar, b.x, nloc, nx); b.st[0] = nloc; b.st[1] = nx; }
    const unsigned old = xb_add(&bar[XB_XSUB(b.x)], 1u);
    const unsigned gen = old / nloc;
    if (old + 1u == (gen + 1u) * nloc) {
      __builtin_amdgcn_fence(__ATOMIC_RELEASE, "agent");
      asm volatile("s_waitcnt vmcnt(0)" ::: "memory");
      const unsigned og = xb_add(&bar[XB_TOP], 1u);
      const unsigned tg = og / nx;
      if (og + 1u == (tg + 1u) * nx) xb_add(&bar[XB_TOPGEN], 1u);
      else XB_SPIN(xb_ld(&bar[XB_TOPGEN]) == tg, bar);
      __builtin_amdgcn_fence(__ATOMIC_ACQUIRE, "agent");
      xb_add(&bar[XB_XGEN(b.x)], 1u);
      asm volatile("s_waitcnt vmcnt(0)" ::: "memory");
    } else {
      XB_SPIN(xb_ld(&bar[XB_XGEN(b.x)]) == gen, bar);
      __builtin_amdgcn_fence(__ATOMIC_ACQUIRE, "agent");
      asm volatile("s_waitcnt vmcnt(0)" ::: "memory");
    }
  }
  __syncthreads();
}
#define RUNPH(k)                                                                       \
  if (p.ph_lo <= (k) && (k) < p.ph_hi) {                                               \
    run_phase((k), p, B, smem);                                                        \
    if ((k) + 1 < p.ph_hi) {                                                           \
      if ((k) == 0) cg::this_grid().sync();                                            \
      else xcd_barrier(xb);                                                            \
    }                                                                                  \
  }
__global__ void __launch_bounds__(NTHR, 2) fwd_megakernel(Params p) {
  extern __shared__ __attribute__((aligned(16))) char smem[];
  const Bufs B = make_bufs(p.ws);
  volatile LAS unsigned* xst = (volatile LAS unsigned*)(smem + SMEM_MAIN);
  if (threadIdx.x == 0) { xst[0] = 0u; xst[1] = 0u; xst[2] = 0u; xst[3] = 0u; }
  __syncthreads();
  const XcdBarrier xb = xcd_barrier_post((unsigned*)(p.ws + OFF_LAM + 256), xst);
  RUNPH(0) RUNPH(1) RUNPH(2) RUNPH(3) RUNPH(4) RUNPH(5) RUNPH(6) RUNPH(7) RUNPH(8)
  RUNPH(9) RUNPH(10) RUNPH(11) RUNPH(12) RUNPH(13) RUNPH(14) RUNPH(15) RUNPH(16) RUNPH(17)
}

constexpr bool ONE_LAUNCH = true;

extern "C" void kernel_launch(void* const* d_in, const int* in_sizes, int n_in, void* d_out, int out_size, void* d_ws,
                              size_t ws_size, hipStream_t stream) {
  static int grid_blocks = 0;
  if (!grid_blocks) {
    int dev = 0, cus = 0, per_cu = 0;
    hipGetDevice(&dev);
    hipDeviceGetAttribute(&cus, hipDeviceAttributeMultiprocessorCount, dev);
    hipFuncSetAttribute((const void*)fwd_megakernel, hipFuncAttributeMaxDynamicSharedMemorySize, SMEM_BYTES);
    hipOccupancyMaxActiveBlocksPerMultiprocessor(&per_cu, fwd_megakernel, NTHR, SMEM_BYTES);
    if (per_cu < 1) per_cu = 1;
    if (per_cu > 2) per_cu = 2;
    grid_blocks = cus * per_cu;
  }
  if (ws_size < WS_NEEDED) {
    fprintf(stderr, "workspace too small: %zu < %zu\n", ws_size, (size_t)WS_NEEDED);
    return;
  }
  Params p{};
  for (int i = 0; i < 25; ++i) p.in[i] = (const float*)d_in[i];
  p.out = (float*)d_out;
  p.ws = (char*)d_ws;
  if (ONE_LAUNCH) {
    p.ph_lo = 0; p.ph_hi = NPHASE;
    hipMemsetAsync((char*)d_ws + OFF_LAM + 256, 0, XCD_BAR_WORDS * 4, stream);
    void* args[] = {&p};
    hipError_t e = hipLaunchCooperativeKernel((const void*)fwd_megakernel, dim3(grid_blocks), dim3(NTHR), args,
                                              SMEM_BYTES, stream);
    if (e != hipSuccess) fprintf(stderr, "cooperative launch failed: %s (grid %d)\n", hipGetErrorString(e), grid_blocks);
  } else {
    for (int ph = 0; ph < NPHASE; ++ph) {
      p.ph_lo = ph; p.ph_hi = ph + 1;
      hipLaunchKernelGGL(fwd_megakernel, dim3(grid_blocks), dim3(NTHR), SMEM_BYTES, stream, p);
    }
  }
}
```

```cpp
#include <hip/hip_runtime.h>
#include <hip/hip_fp16.h>
#include <hip/hip_cooperative_groups.h>
#include <cstdio>
#include <cstdint>
namespace cg = cooperative_groups;

#define DI __device__ __forceinline__
typedef unsigned short u16;
typedef __attribute__((ext_vector_type(8))) short bf16x8;
typedef __attribute__((ext_vector_type(16))) float f32x16;
typedef __attribute__((ext_vector_type(4))) unsigned u32x4;
typedef __attribute__((ext_vector_type(2))) unsigned u32x2;

constexpr int D = 1024, NB = 8, SEQ = 4096, CTX = 256, LT = 4352, M = NB * LT, DFF = 2816;
constexpr float EPS = 1e-6f;
constexpr float LOG2E = 1.4426950408889634f;
constexpr float QS_DIFF = 0.125f * LOG2E;
constexpr float QS_MLA = 0.07216878364870323f * LOG2E;
constexpr int NTHR = 256;

constexpr size_t SZ_WT_OUT = 2ull * 1024 * 1024 * 2;
constexpr size_t SZ_WT_F1 = 5632ull * 1024 * 2;
constexpr size_t SZ_WT_F2 = 1024ull * 2816 * 2;
constexpr size_t SZ_WT_EV = 2048ull * 1024 * 2;
constexpr size_t SZ_WT_OD = 3456ull * 1024 * 2;
constexpr size_t SZ_WT_UQ = 768ull * 512 * 2;
constexpr size_t SZ_WT_UKV = 1024ull * 256 * 2;
constexpr size_t SZ_WT_POOL = 4ull * 128 * 128 * 2;
constexpr size_t SZ_MOD = 2ull * 9 * 6144 * 4;
constexpr size_t SZ_ROPE = 2ull * 1024 * 4;
constexpr size_t SZ_LB = 1024 * 4;
constexpr size_t SZ_LAM = 256 + 16384;
constexpr size_t SZ_XC = 2048ull * 1024 * 4;
constexpr size_t SZ_H = (size_t)M * 1024 * 2;
constexpr size_t SZ_M512 = (size_t)M * 512 * 2;

constexpr size_t OFF_WT_OUT = 0;
constexpr size_t OFF_WT_F1 = OFF_WT_OUT + SZ_WT_OUT;
constexpr size_t OFF_WT_F2 = OFF_WT_F1 + SZ_WT_F1;
constexpr size_t OFF_WT_EV = OFF_WT_F2 + SZ_WT_F2;
constexpr size_t OFF_WT_OD = OFF_WT_EV + SZ_WT_EV;
constexpr size_t OFF_WT_UQ = OFF_WT_OD + SZ_WT_OD;
constexpr size_t OFF_WT_UKV = OFF_WT_UQ + SZ_WT_UQ;
constexpr size_t OFF_WT_POOL = OFF_WT_UKV + SZ_WT_UKV;
constexpr size_t OFF_MOD = OFF_WT_POOL + SZ_WT_POOL;
constexpr size_t OFF_ROPE = OFF_MOD + SZ_MOD;
constexpr size_t OFF_LB = OFF_ROPE + SZ_ROPE;
constexpr size_t OFF_LAM = OFF_LB + SZ_LB;
constexpr size_t OFF_XC = OFF_LAM + SZ_LAM;
constexpr size_t OFF_H = OFF_XC + SZ_XC;
constexpr size_t OFF_R = OFF_H + SZ_H;
constexpr size_t R_U = 0;
constexpr size_t R_Q0 = R_U + SZ_M512;
constexpr size_t R_K0 = R_Q0 + SZ_M512;
constexpr size_t R_VT0 = R_K0 + SZ_M512;
constexpr size_t R_MIX0 = R_VT0 + SZ_M512;
constexpr size_t R_Y0 = R_MIX0 + SZ_H;
constexpr size_t R_G0 = 0;
constexpr size_t R_MIX1 = 0;
constexpr size_t R_CQ = 0;
constexpr size_t R_CKV = SZ_M512;
constexpr size_t R_KF = SZ_H;
constexpr size_t SZ_KF = 8ull * 4 * LT * 192 * 2;
constexpr size_t R_VT1 = R_KF + SZ_KF;
constexpr size_t R_HQ = R_VT1 + SZ_M512;
constexpr size_t R_LF = R_HQ + SZ_M512;
constexpr size_t R_HI = R_LF + 2 * SZ_M512;
constexpr size_t R_HG = R_HI + SZ_M512;
constexpr size_t R_OH = R_HG + SZ_M512;
constexpr size_t R_END1 = R_OH + 2 * SZ_M512;
constexpr size_t R_Y1 = R_KF;
constexpr size_t SZ_Y = (size_t)M * 1024 * 4;
constexpr size_t R_G1 = R_Y1 + SZ_Y;
constexpr size_t SZ_G = (size_t)M * DFF * 2;
constexpr size_t R_SIZE = (R_G1 + SZ_G > R_END1) ? (R_G1 + SZ_G) : R_END1;
constexpr size_t WS_NEEDED = OFF_R + R_SIZE;
static_assert(R_Y0 + SZ_Y <= R_SIZE, "layer0 region");
static_assert(R_G0 + SZ_G <= R_Y0, "G0 overlap");
static_assert(WS_NEEDED <= 536870912ull, "ws too big");

struct Params {
  const float* in[25];
  float* out;
  char* ws;
  int ph_lo, ph_hi;
};

constexpr int SMEM_MAIN = 73728;
constexpr int SMEM_BYTES = SMEM_MAIN + 16;
constexpr int LDT = 72;
constexpr int CLD = 132;

DI int otid() { int t = threadIdx.x; asm volatile("" : "+v"(t)); return t; }
DI u16 f2bf(float x) { return __builtin_bit_cast(u16, (__bf16)x); }
DI unsigned pk2(float a, float b) { return (unsigned)f2bf(a) | ((unsigned)f2bf(b) << 16); }
DI float bflo(unsigned u) { return __uint_as_float(u << 16); }
DI float bfhi(unsigned u) { return __uint_as_float(u & 0xffff0000u); }
DI float bf2f(u16 v) { return __uint_as_float(((unsigned)v) << 16); }
DI float h2f(u16 v) { return __half2float(__ushort_as_half(v)); }
DI u16 f2h(float x) { return __half_as_ushort(__float2half(x)); }
DI float siluf(float x) { return x / (1.f + __expf(-x)); }
DI float wave_sum(float v) {
#pragma unroll
  for (int o = 32; o > 0; o >>= 1) v += __shfl_xor(v, o);
  return v;
}
DI u32x4 pack8(const float* v) {
  u32x4 o;
  o[0] = pk2(v[0], v[1]); o[1] = pk2(v[2], v[3]); o[2] = pk2(v[4], v[5]); o[3] = pk2(v[6], v[7]);
  return o;
}
DI int crow(int reg, int h) { return (reg & 3) + 8 * (reg >> 2) + 4 * h; }
#define MFMA32(a, b, c) __builtin_amdgcn_mfma_f32_32x32x16_bf16((a), (b), (c), 0, 0, 0)

struct Bufs {
  char* ws;
#define BUFP(T, name, off) DI T* name##_() const { return (T*)(ws + (off)); }
  BUFP(u16, wt_out, OFF_WT_OUT) BUFP(u16, wt_f1, OFF_WT_F1) BUFP(u16, wt_f2, OFF_WT_F2) BUFP(u16, wt_ev, OFF_WT_EV)
  BUFP(u16, wt_od, OFF_WT_OD) BUFP(u16, wt_uq, OFF_WT_UQ) BUFP(u16, wt_ukv, OFF_WT_UKV) BUFP(u16, wt_pool, OFF_WT_POOL)
  BUFP(float, mod, OFF_MOD) BUFP(float, ropec, OFF_ROPE) BUFP(float, ropes, OFF_ROPE + 4096) BUFP(float, lb, OFF_LB)
  BUFP(float, lam, OFF_LAM) BUFP(float, xc, OFF_XC) BUFP(u16, H, OFF_H)
  BUFP(u16, U, OFF_R + R_U) BUFP(u16, Q0, OFF_R + R_Q0) BUFP(u16, K0, OFF_R + R_K0) BUFP(u16, VT0, OFF_R + R_VT0)
  BUFP(u16, MIX0, OFF_R + R_MIX0) BUFP(float, Y0, OFF_R + R_Y0) BUFP(u16, G0, OFF_R + R_G0)
  BUFP(u16, CQ, OFF_R + R_CQ) BUFP(u16, CKV, OFF_R + R_CKV) BUFP(u16, MIX1, OFF_R + R_MIX1) BUFP(u16, KF, OFF_R + R_KF)
  BUFP(u16, VT1, OFF_R + R_VT1) BUFP(u16, HQ, OFF_R + R_HQ) BUFP(u16, LF, OFF_R + R_LF) BUFP(u16, HI, OFF_R + R_HI)
  BUFP(u16, HG, OFF_R + R_HG) BUFP(u16, OH, OFF_R + R_OH) BUFP(u16, QF, OFF_H) BUFP(float, Y1, OFF_R + R_Y1)
  BUFP(u16, G1, OFF_R + R_G1)
};
DI Bufs make_bufs(char* ws) { Bufs b; b.ws = ws; return b; }

DI void wt_tile(char* smem, const float* __restrict__ src, int ld, int kt, int ncol0, u16* __restrict__ dst, int K,
                int dst_row0, const float* __restrict__ scale) {
  float* t = (float*)smem;
  const int tid = otid(), col = tid & 63, r0 = tid >> 6;
#pragma unroll 4
  for (int i = 0; i < 16; ++i) {
    int row = i * 4 + r0;
    float v = src[(size_t)(kt * 64 + row) * ld + ncol0 + col];
    if (scale) v *= scale[kt * 64 + row];
    t[row * 65 + col] = v;
  }
  __syncthreads();
#pragma unroll
  for (int it = 0; it < 2; ++it) {
    int c = it * 256 + tid, j = c >> 3, kc = c & 7;
    u32x4 o;
#pragma unroll
    for (int q = 0; q < 4; ++q) o[q] = pk2(t[(kc * 8 + 2 * q) * 65 + j], t[(kc * 8 + 2 * q + 1) * 65 + j]);
    *(u32x4*)(dst + (size_t)(dst_row0 + j) * K + kt * 64 + kc * 8) = o;
  }
  __syncthreads();
}

#define WJOB(SRC, LDD, KK, NN, DST, TS, ROFF, SC)                                        \
  {                                                                                       \
    const int ntn = (NN) / 64, cnt = ((KK) / 64) * ntn;                                   \
    if (idx < cnt) {                                                                      \
      int kt = idx / ntn, nt = idx % ntn;                                                 \
      wt_tile(smem, (SRC), (LDD), kt, nt * 64, (DST), (KK), nt * (TS) + (ROFF), (SC));    \
      return;                                                                             \
    }                                                                                     \
    idx -= cnt;                                                                           \
  }

constexpr int NW_FFN = 704 * 3;
constexpr int NW_P0 = 256 + 256 + NW_FFN + 512 + 848 + 96 + 64 + 16;

DI void ffn_weight_item(char* smem, const Params& p, const Bufs& B, int layer, int idx) {
  WJOB(p.in[8] + (size_t)layer * 1024 * DFF, DFF, 1024, DFF, B.wt_f1_(), 128, 0, nullptr)
  WJOB(p.in[9] + (size_t)layer * 1024 * DFF, DFF, 1024, DFF, B.wt_f1_(), 128, 64, nullptr)
  WJOB(p.in[12] + (size_t)layer * DFF * 1024, 1024, DFF, 1024, B.wt_f2_(), 64, 0, nullptr)
}

DI void prep_weight_item(char* smem, const Params& p, const Bufs& B, int idx) {
  WJOB(p.in[7], 1024, 1024, 1024, B.wt_out_(), 64, 0, nullptr)
  WJOB(p.in[7] + 1024 * 1024, 1024, 1024, 1024, B.wt_out_() + 1024 * 1024, 64, 0, nullptr)
  if (idx < NW_FFN) { ffn_weight_item(smem, p, B, 0, idx); return; }
  idx -= NW_FFN;
  WJOB(p.in[13], 2048, 1024, 2048, B.wt_ev_(), 64, 0, nullptr)
  WJOB(p.in[18], 3392, 1024, 3392, B.wt_od_(), 64, 0, nullptr)
  WJOB(p.in[20], 768, 512, 768, B.wt_uq_(), 64, 0, p.in[19])
  WJOB(p.in[22], 1024, 256, 1024, B.wt_ukv_(), 64, 0, p.in[21])
  {
    int g = idx >> 2, t = idx & 3;
    wt_tile(smem, p.in[14] + g * 128 * 128, 128, t >> 1, (t & 1) * 64, B.wt_pool_() + g * 128 * 128, 128, (t & 1) * 64,
            nullptr);
  }
}

DI void mod_gemv_item(char* smem, const Params& p, const Bufs& B, int idx) {
  const int layer = idx / 96, c0 = (idx % 96) * 64, tid = otid();
  float* sc = (float*)smem;
  float* red = sc + 9 * 1024;
  for (int i = tid; i < 9 * 1024; i += NTHR) {
    int rr = i >> 10, k = i & 1023;
    float v = (rr < 8) ? p.in[1][rr * 1024 + k] : p.in[3][k];
    sc[i] = siluf(v);
  }
  __syncthreads();
  const int cq = tid & 15, kg = tid >> 4;
  float acc[9][4];
#pragma unroll
  for (int a = 0; a < 9; ++a)
#pragma unroll
    for (int e = 0; e < 4; ++e) acc[a][e] = 0.f;
  const float* W = p.in[4] + (size_t)layer * 1024 * 6144 + c0 + cq * 4;
#pragma unroll 4
  for (int kk = 0; kk < 64; ++kk) {
    int k = kg * 64 + kk;
    float4 w = *(const float4*)(W + (size_t)k * 6144);
#pragma unroll
    for (int a = 0; a < 9; ++a) {
      float s = sc[a * 1024 + k];
      acc[a][0] += s * w.x; acc[a][1] += s * w.y; acc[a][2] += s * w.z; acc[a][3] += s * w.w;
    }
  }
#pragma unroll
  for (int a = 0; a < 9; ++a)
#pragma unroll
    for (int e = 0; e < 4; ++e) red[(kg * 9 + a) * 64 + cq * 4 + e] = acc[a][e];
  __syncthreads();
  for (int i = tid; i < 9 * 64; i += NTHR) {
    int a = i >> 6, c = i & 63;
    float s = 0.f;
    for (int g = 0; g < 16; ++g) s += red[(g * 9 + a) * 64 + c];
    B.mod_()[(size_t)(layer * 9 + a) * 6144 + c0 + c] = s + p.in[5][layer * 6144 + c0 + c];
  }
  __syncthreads();
}

DI void tables_item(const Params& p, const Bufs& B) {
  const int tid = otid();
  for (int i = tid; i < 1024; i += NTHR) {
    int pos = i >> 4, f = i & 15;
    float inv = powf(10000.f, -(float)f / 16.f);
    float ang = (float)pos * inv;
    B.ropec_()[i] = cosf(ang);
    B.ropes_()[i] = sinf(ang);
    int dir = i >> 9, ch = i & 511;
    float a0 = p.in[24][(dir * 2 + 0) * 512 + ch], a1 = p.in[24][(dir * 2 + 1) * 512 + ch];
    B.lb_()[i] = 1.f / (1.f + expf(a0 - a1));
  }
  if (tid < 64) {
    const float* L = p.in[16];
    float s1 = wave_sum(L[tid] * L[64 + tid]);
    float s2 = wave_sum(L[128 + tid] * L[192 + tid]);
    if (tid == 0) B.lam_()[0] = expf(s1) - expf(s2) + 0.2f;
  }
  for (int i = tid; i < 64 * 1024 / 8; i += NTHR) {
    u32x4 z = {0u, 0u, 0u, 0u};
    *(u32x4*)(B.wt_od_() + (size_t)3392 * 1024 + i * 8) = z;
  }
}

struct RowInfo { int b, pos, mi; bool lat; };
DI RowInfo row_info(int r) {
  RowInfo ri;
  ri.b = r / LT; ri.pos = r - ri.b * LT; ri.lat = ri.pos >= CTX; ri.mi = ri.lat ? ri.b : 8;
  return ri;
}
DI size_t resid_off(const RowInfo& ri) {
  return ri.lat ? ((size_t)ri.b * SEQ + (ri.pos - CTX)) * 1024 : ((size_t)ri.b * CTX + ri.pos) * 1024;
}

DI void norm_mod_row(const float* __restrict__ x, const float* __restrict__ g, const float* __restrict__ sh,
                     const float* __restrict__ sc, u16* __restrict__ hrow, int lane) {
  float4 v[4];
  float ss = 0.f;
#pragma unroll
  for (int i = 0; i < 4; ++i) {
    v[i] = *(const float4*)(x + i * 256 + lane * 4);
    ss += v[i].x * v[i].x + v[i].y * v[i].y + v[i].z * v[i].z + v[i].w * v[i].w;
  }
  ss = wave_sum(ss);
  const float rstd = rsqrtf(ss * (1.f / 1024.f) + EPS);
#pragma unroll
  for (int i = 0; i < 4; ++i) {
    int c = i * 256 + lane * 4;
    float4 gg = *(const float4*)(g + c), s1 = *(const float4*)(sh + c), s2 = *(const float4*)(sc + c);
    u32x2 o;
    o[0] = pk2(v[i].x * rstd * gg.x * (1.f + s2.x) + s1.x, v[i].y * rstd * gg.y * (1.f + s2.y) + s1.y);
    o[1] = pk2(v[i].z * rstd * gg.z * (1.f + s2.z) + s1.z, v[i].w * rstd * gg.w * (1.f + s2.w) + s1.w);
    *(u32x2*)(hrow + c) = o;
  }
}

template <bool NEXT>
DI void resid_row(const u16* __restrict__ y, const float* xs, float* xd, const float* __restrict__ gate,
                  const float* __restrict__ ny, const float* __restrict__ nx, const float* __restrict__ sh,
                  const float* __restrict__ sc, u16* __restrict__ hrow, int lane) {
  float4 v[4];
  float ss = 0.f;
#pragma unroll
  for (int i = 0; i < 4; ++i) {
    u32x2 yy = *(const u32x2*)(y + i * 256 + lane * 4);
    v[i].x = bflo(yy[0]); v[i].y = bfhi(yy[0]); v[i].z = bflo(yy[1]); v[i].w = bfhi(yy[1]);
    ss += v[i].x * v[i].x + v[i].y * v[i].y + v[i].z * v[i].z + v[i].w * v[i].w;
  }
  ss = wave_sum(ss);
  const float rstd = rsqrtf(ss * (1.f / 1024.f) + EPS);
  float ss2 = 0.f;
#pragma unroll
  for (int i = 0; i < 4; ++i) {
    int c = i * 256 + lane * 4;
    float4 xv = *(const float4*)(xs + c), gt = *(const float4*)(gate + c), nn = *(const float4*)(ny + c);
    float4 o;
    o.x = xv.x + gt.x * (v[i].x * rstd * nn.x); o.y = xv.y + gt.y * (v[i].y * rstd * nn.y);
    o.z = xv.z + gt.z * (v[i].z * rstd * nn.z); o.w = xv.w + gt.w * (v[i].w * rstd * nn.w);
    *(float4*)(xd + c) = o;
    v[i] = o;
    ss2 += o.x * o.x + o.y * o.y + o.z * o.z + o.w * o.w;
  }
  if (NEXT) {
    ss2 = wave_sum(ss2);
    const float rstd2 = rsqrtf(ss2 * (1.f / 1024.f) + EPS);
#pragma unroll
    for (int i = 0; i < 4; ++i) {
      int c = i * 256 + lane * 4;
      float4 gg = *(const float4*)(nx + c), s1 = *(const float4*)(sh + c), s2 = *(const float4*)(sc + c);
      u32x2 o;
      o[0] = pk2(v[i].x * rstd2 * gg.x * (1.f + s2.x) + s1.x, v[i].y * rstd2 * gg.y * (1.f + s2.y) + s1.y);
      o[1] = pk2(v[i].z * rstd2 * gg.z * (1.f + s2.z) + s1.z, v[i].w * rstd2 * gg.w * (1.f + s2.w) + s1.w);
      *(u32x2*)(hrow + c) = o;
    }
  }
}

enum { EPI_F32 = 0, EPI_IN0, EPI_IN1, EPI_FFN1, EPI_UQ, EPI_UKV, EPI_POOL };

struct EpiArgs {
  float* outf;
  int layer;
  int seg_lo, seg_hi;
  int aux;
};

DI void mma_ktile(const u16* As, const u16* Bs, f32x16 (&acc)[2][2], int wm, int wn, int r, int h) {
  __builtin_amdgcn_s_setprio(1);
#pragma unroll
  for (int ks = 0; ks < 4; ++ks) {
    bf16x8 a[2], b[2];
#pragma unroll
    for (int i = 0; i < 2; ++i) a[i] = *(const bf16x8*)(As + (wm * 64 + i * 32 + r) * LDT + ks * 16 + h * 8);
#pragma unroll
    for (int j = 0; j < 2; ++j) b[j] = *(const bf16x8*)(Bs + (wn * 64 + j * 32 + r) * LDT + ks * 16 + h * 8);
#pragma unroll
    for (int i = 0; i < 2; ++i)
#pragma unroll
      for (int j = 0; j < 2; ++j) acc[i][j] = MFMA32(a[i], b[j], acc[i][j]);
  }
  __builtin_amdgcn_s_setprio(0);
}

DI void acc_to_lds(float* Ct, f32x16 (&acc)[2][2], int wm, int wn, int r, int h) {
#pragma unroll
  for (int i = 0; i < 2; ++i)
#pragma unroll
    for (int j = 0; j < 2; ++j)
#pragma unroll
      for (int g = 0; g < 16; ++g)
        Ct[(wm * 64 + i * 32 + crow(g, h)) * CLD + wn * 64 + j * 32 + r] = acc[i][j][g];
}

DI void rope8(float* v, const float* Ct_row, int cc8, int d, int n, const Bufs& B) {
  const int axis = d >> 5, pa = axis ? (n & 63) : (n >> 6), f0 = d & 15;
  const bool first = (d & 16) == 0;
  const int pc = first ? cc8 + 16 : cc8 - 16;
  const float4 c0 = *(const float4*)(B.ropec_() + pa * 16 + f0), c1 = *(const float4*)(B.ropec_() + pa * 16 + f0 + 4);
  const float4 s0 = *(const float4*)(B.ropes_() + pa * 16 + f0), s1 = *(const float4*)(B.ropes_() + pa * 16 + f0 + 4);
  const float4 x0 = *(const float4*)(Ct_row + pc), x1 = *(const float4*)(Ct_row + pc + 4);
  const float cs[8] = {c0.x, c0.y, c0.z, c0.w, c1.x, c1.y, c1.z, c1.w};
  const float sn[8] = {s0.x, s0.y, s0.z, s0.w, s1.x, s1.y, s1.z, s1.w};
  const float xp[8] = {x0.x, x0.y, x0.z, x0.w, x1.x, x1.y, x1.z, x1.w};
#pragma unroll
  for (int e = 0; e < 8; ++e) v[e] = first ? v[e] * cs[e] - xp[e] * sn[e] : v[e] * cs[e] + xp[e] * sn[e];
}

DI void ld8(float* v, const float* src) {
  const float4 a = *(const float4*)src, b = *(const float4*)(src + 4);
  v[0] = a.x; v[1] = a.y; v[2] = a.z; v[3] = a.w; v[4] = b.x; v[5] = b.y; v[6] = b.z; v[7] = b.w;
}

template <int EPI>
DI void epilogue(const Params& p, const Bufs& B, const float* Ct, const float* rowss, int rowbase, int n0,
                 const EpiArgs& ea) {
  const int tid = otid();
  if (EPI == EPI_F32) {
#pragma unroll 1
    for (int it = 0; it < 8; ++it) {
      int id = it * 256 + tid, i = id >> 4, cc = id & 15;
      float v[8];
      ld8(v, Ct + i * CLD + cc * 8);
      *(u32x4*)((u16*)ea.outf + (size_t)(rowbase + i) * 1024 + n0 + cc * 8) = pack8(v);
    }
  } else if (EPI == EPI_POOL) {
#pragma unroll 1
    for (int it = 0; it < 8; ++it) {
      int id = it * 256 + tid, i = id >> 4, cc = id & 15;
      float v[8];
#pragma unroll
      for (int e = 0; e < 8; ++e) v[e] = Ct[i * CLD + cc * 8 + e] * p.in[15][ea.aux * 128 + cc * 8 + e];
      *(u32x4*)(B.MIX0_() + (size_t)(rowbase + i) * 1024 + ea.aux * 128 + cc * 8) = pack8(v);
    }
  } else if (EPI == EPI_IN0) {
    const int seg = n0 >> 9, b = rowbase / LT, pos0 = rowbase - b * LT;
    if (seg == 3) {
#pragma unroll 1
      for (int it = 0; it < 8; ++it) {
        int id = it * 256 + tid, c = id & 127, rc = id >> 7;
        float v[8];
#pragma unroll
        for (int e = 0; e < 8; ++e) v[e] = Ct[(rc * 8 + e) * CLD + c];
        int hc = n0 - 1536 + c, vh = hc >> 7, dv = hc & 127;
        *(u32x4*)(B.VT0_() + ((size_t)(b * 4 + vh) * 128 + dv) * LT + pos0 + rc * 8) = pack8(v);
      }
    } else {
#pragma unroll 1
      for (int it = 0; it < 8; ++it) {
        int id = it * 256 + tid, i = id >> 4, cc = id & 15;
        float v[8];
        ld8(v, Ct + i * CLD + cc * 8);
        if (seg == 0) {
          *(u32x4*)(B.U_() + (size_t)(rowbase + i) * 512 + n0 + cc * 8) = pack8(v);
        } else {
          int hc = n0 - 512 * seg + cc * 8, head = hc >> 6, d = hc & 63, pos = pos0 + i;
          if (pos >= CTX) rope8(v, Ct + i * CLD, cc * 8, d, pos - CTX, B);
          if (seg == 1) {
#pragma unroll
            for (int e = 0; e < 8; ++e) v[e] *= QS_DIFF;
          }
          u16* dst = (seg == 1 ? B.Q0_() : B.K0_()) + ((size_t)(b * 8 + head) * LT + pos) * 64 + d;
          *(u32x4*)dst = pack8(v);
        }
      }
    }
  } else if (EPI == EPI_IN1) {
    const int b = rowbase / LT, pos0 = rowbase - b * LT;
#pragma unroll 1
    for (int it = 0; it < 8; ++it) {
      int id = it * 256 + tid, i = id >> 4, cc = id & 15;
      int gc = n0 + cc * 8, pos = pos0 + i;
      size_t grow = (size_t)(rowbase + i);
      float v[8];
      ld8(v, Ct + i * CLD + cc * 8);
      if (gc < 512) {
        *(u32x4*)(B.CQ_() + grow * 512 + gc) = pack8(v);
      } else if (gc < 768) {
        *(u32x4*)(B.CKV_() + grow * 256 + (gc - 512)) = pack8(v);
      } else if (gc < 832) {
        int d = gc - 768;
        if (pos >= CTX) rope8(v, Ct + i * CLD, cc * 8, d, pos - CTX, B);
        u32x4 o = pack8(v);
#pragma unroll
        for (int hh = 0; hh < 4; ++hh) *(u32x4*)(B.KF_() + ((size_t)(b * 4 + hh) * LT + pos) * 192 + 128 + d) = o;
      } else if (gc < 1344) {
#pragma unroll
        for (int e = 0; e < 8; ++e) v[e] = siluf(v[e]);
        *(u32x4*)(B.HQ_() + grow * 512 + (gc - 832)) = pack8(v);
      } else if (gc < 2368) {
        int dir = gc >= 1856, ch = gc - (dir ? 1856 : 1344);
        u32x4 o;
        float lf[8];
        float lb8[8];
        ld8(lb8, B.lb_() + dir * 512 + ch);
#pragma unroll
        for (int e = 0; e < 8; ++e) {
          float lbv = lb8[e];
          float f = lbv + (1.f - lbv) / (1.f + __expf(-v[e]));
          lf[e] = logf(f);
        }
#pragma unroll
        for (int q = 0; q < 4; ++q) o[q] = (unsigned)f2h(lf[2 * q]) | ((unsigned)f2h(lf[2 * q + 1]) << 16);
        *(u32x4*)(B.LF_() + (size_t)dir * M * 512 + grow * 512 + ch) = o;
      } else if (gc < 2880) {
        *(u32x4*)(B.HI_() + grow * 512 + (gc - 2368)) = pack8(v);
      } else if (gc < 3392) {
        *(u32x4*)(B.HG_() + grow * 512 + (gc - 2880)) = pack8(v);
      }
    }
  } else if (EPI == EPI_UQ) {
    const int b = rowbase / LT, nl0 = rowbase - b * LT - CTX;
#pragma unroll 1
    for (int it = 0; it < 8; ++it) {
      int id = it * 256 + tid, i = id >> 4, cc = id & 15;
      int gc = n0 + cc * 8, head = gc / 192, dd = gc - head * 192, n = nl0 + i;
      float v[8];
      ld8(v, Ct + i * CLD + cc * 8);
      if (dd >= 128) rope8(v, Ct + i * CLD, cc * 8, dd - 128, n, B);
      const float s = rsqrtf(rowss[i] * (1.f / 512.f) + EPS) * QS_MLA;
#pragma unroll
      for (int e = 0; e < 8; ++e) v[e] *= s;
      *(u32x4*)(B.QF_() + ((size_t)(b * 4 + head) * SEQ + n) * 192 + dd) = pack8(v);
    }
  } else if (EPI == EPI_UKV) {
    const int b = rowbase / LT, pos0 = rowbase - b * LT, head = n0 >> 8;
    if ((n0 & 128) == 0) {
#pragma unroll 1
      for (int it = 0; it < 8; ++it) {
        int id = it * 256 + tid, i = id >> 4, cc = id & 15;
        const float s = rsqrtf(rowss[i] * (1.f / 256.f) + EPS);
        float v[8];
#pragma unroll
        for (int e = 0; e < 8; ++e) v[e] = Ct[i * CLD + cc * 8 + e] * s;
        *(u32x4*)(B.KF_() + ((size_t)(b * 4 + head) * LT + pos0 + i) * 192 + cc * 8) = pack8(v);
      }
    } else {
#pragma unroll 1
      for (int it = 0; it < 8; ++it) {
        int id = it * 256 + tid, c = id & 127, rc = id >> 7;
        float v[8];
#pragma unroll
        for (int e = 0; e < 8; ++e)
          v[e] = Ct[(rc * 8 + e) * CLD + c] * rsqrtf(rowss[rc * 8 + e] * (1.f / 256.f) + EPS);
        *(u32x4*)(B.VT1_() + ((size_t)(b * 4 + head) * 128 + c) * LT + pos0 + rc * 8) = pack8(v);
      }
    }
  } else if (EPI == EPI_FFN1) {
    const int nt = n0 >> 7;
    const float* cw = p.in[10] + (size_t)ea.layer * 3 * DFF;
    const float* cb = p.in[11] + (size_t)ea.layer * DFF;
    u16* G = ea.layer ? B.G1_() : B.G0_();
#pragma unroll 1
    for (int it = 0; it < 4; ++it) {
      int id = it * 256 + tid, i = id >> 3, cc = id & 7;
      int grow = rowbase + i;
      if (i >= 1 && i <= 126 && grow < ea.seg_hi) {
        const bool hp = (grow - 1 >= ea.seg_lo), hn = (grow + 1 < ea.seg_hi);
        float a[8], ap[8], an[8], u[8], w0[8], w1[8], w2[8], bb[8], v[8];
        const int fc0 = nt * 64 + cc * 8;
        ld8(a, Ct + i * CLD + cc * 8); ld8(ap, Ct + (i - 1) * CLD + cc * 8); ld8(an, Ct + (i + 1) * CLD + cc * 8);
        ld8(u, Ct + i * CLD + 64 + cc * 8);
        ld8(w0, cw + fc0); ld8(w1, cw + DFF + fc0); ld8(w2, cw + 2 * DFF + fc0); ld8(bb, cb + fc0);
#pragma unroll
        for (int e = 0; e < 8; ++e) {
          float av = (hp ? ap[e] : 0.f) * w0[e] + a[e] * w1[e] + (hn ? an[e] : 0.f) * w2[e] + bb[e];
          v[e] = siluf(av) * u[e];
        }
        *(u32x4*)(G + (size_t)grow * DFF + nt * 64 + cc * 8) = pack8(v);
      }
    }
  }
}

template <int EPI, bool SUMSQ>
DI void gemm_tile(char* smem, const Params& p, const Bufs& B, const u16* __restrict__ A, int lda, int rowbase,
                  int rlo, int rhi, const u16* __restrict__ Bt, int K, int n0, const EpiArgs& ea) {
  u16* As = (u16*)smem;
  u16* Bs = As + 2 * 128 * LDT;
  float* Ct = (float*)smem;
  float* rowss = Ct + 128 * CLD;
  const int tid = otid(), lane = tid & 63, wid = tid >> 6, wm = wid >> 1, wn = wid & 1, r = lane & 31,
            h = lane >> 5;
  const int lrow = tid >> 3, lkc = tid & 7;
  int aoff[4], boff[4];
#pragma unroll
  for (int it = 0; it < 4; ++it) {
    int gr = rowbase + it * 32 + lrow;
    gr = gr < rlo ? rlo : (gr > rhi - 1 ? rhi - 1 : gr);
    aoff[it] = gr * lda + lkc * 8;
    boff[it] = (n0 + it * 32 + lrow) * K + lkc * 8;
  }
  u32x4 ra0[4], rb0[4], ra1[4], rb1[4];
  float ssq[4] = {0.f, 0.f, 0.f, 0.f};
  f32x16 acc[2][2];
#pragma unroll
  for (int i = 0; i < 2; ++i)
#pragma unroll
    for (int j = 0; j < 2; ++j)
#pragma unroll
      for (int g = 0; g < 16; ++g) acc[i][j][g] = 0.f;
  const int nk = K >> 6;
#pragma unroll
  for (int it = 0; it < 4; ++it) {
    ra0[it] = *(const u32x4*)(A + aoff[it]);
    rb0[it] = *(const u32x4*)(Bt + boff[it]);
  }
#pragma unroll
  for (int it = 0; it < 4; ++it) {
    ra1[it] = *(const u32x4*)(A + aoff[it] + 64);
    rb1[it] = *(const u32x4*)(Bt + boff[it] + 64);
  }
#define GEMM_STEP(RA, RB, BUF, TNEXT)                                                  \
  {                                                                                    \
    u16* Aw = As + (BUF) * 128 * LDT;                                                  \
    u16* Bw = Bs + (BUF) * 128 * LDT;                                                  \
    _Pragma("unroll") for (int it = 0; it < 4; ++it) {                                 \
      *(u32x4*)(Aw + (it * 32 + lrow) * LDT + lkc * 8) = RA[it];                       \
      *(u32x4*)(Bw + (it * 32 + lrow) * LDT + lkc * 8) = RB[it];                       \
      if (SUMSQ) {                                                                     \
        _Pragma("unroll") for (int q = 0; q < 4; ++q) {                                \
          float lo = bflo(RA[it][q]), hi = bfhi(RA[it][q]);                            \
          ssq[it] += lo * lo + hi * hi;                                                \
        }                                                                              \
      }                                                                                \
    }                                                                                  \
    __syncthreads();                                                                   \
    if ((TNEXT) < nk) {                                                                \
      _Pragma("unroll") for (int it = 0; it < 4; ++it) {                               \
        RA[it] = *(const u32x4*)(A + aoff[it] + (TNEXT) * 64);                         \
        RB[it] = *(const u32x4*)(Bt + boff[it] + (TNEXT) * 64);                        \
      }                                                                                \
    }                                                                                  \
    mma_ktile(Aw, Bw, acc, wm, wn, r, h);                                              \
  }
  for (int t = 0; t < nk; t += 2) {
    GEMM_STEP(ra0, rb0, 0, t + 2)
    GEMM_STEP(ra1, rb1, 1, t + 3)
  }
#undef GEMM_STEP
  __syncthreads();
  acc_to_lds(Ct, acc, wm, wn, r, h);
  if (SUMSQ) {
#pragma unroll
    for (int it = 0; it < 4; ++it) {
      float s = ssq[it];
      s += __shfl_xor(s, 1); s += __shfl_xor(s, 2); s += __shfl_xor(s, 4);
      if (lkc == 0) rowss[it * 32 + lrow] = s;
    }
  }
  __syncthreads();
  epilogue<EPI>(p, B, Ct, rowss, rowbase, n0, ea);
  __syncthreads();
}

DI void pool_tile(char* smem, const Params& p, const Bufs& B, int rt, int g) {
  u16* As = (u16*)smem;
  u16* Bs = As + 2 * 128 * LDT;
  float* Ct = (float*)smem;
  const int tid = otid(), lane = tid & 63, wid = tid >> 6, wm = wid >> 1, wn = wid & 1, r = lane & 31,
            h = lane >> 5;
  const int rowbase = rt * 128;
  const int b = rowbase / LT, pos0 = rowbase - b * LT;
  const int seg_lo = (pos0 < CTX) ? b * LT : b * LT + CTX;
  const int seg_hi = (pos0 < CTX) ? b * LT + CTX : (b + 1) * LT;
#pragma unroll
  for (int it = 0; it < 8; ++it) {
    int c = it * 256 + tid, n = c >> 4, kc = c & 15;
    u32x4 v = *(const u32x4*)(B.wt_pool_() + (size_t)g * 128 * 128 + n * 128 + kc * 8);
    *(u32x4*)(Bs + (kc >> 3) * 128 * LDT + n * LDT + (kc & 7) * 8) = v;
  }
  {
    const int ch = tid & 127, rh = tid >> 7, hw = 1 << g;
    const u16* Ucol = B.U_() + g * 128 + ch;
    const int t0 = rowbase + rh * 64;
    int lo = max(t0 - hw, seg_lo), hi = min(t0 + hw, seg_hi);
    float sum = 0.f;
    for (int s = lo; s < hi; ++s) sum += bf2f(Ucol[(size_t)s * 512]);
    u16* Ad = As + (ch >> 6) * 128 * LDT + (ch & 63);
    for (int i = 0; i < 64; ++i) {
      int t = t0 + i;
      float cnt = (float)(hi - lo);
      float d = sum / cnt - bf2f(Ucol[(size_t)t * 512]);
      Ad[(rh * 64 + i) * LDT] = f2bf(d);
      if (t + hw < seg_hi) { sum += bf2f(Ucol[(size_t)(t + hw) * 512]); hi = t + hw + 1; }
      if (t - hw >= seg_lo) { sum -= bf2f(Ucol[(size_t)(t - hw) * 512]); lo = t - hw + 1; }
    }
  }
  __syncthreads();
  f32x16 acc[2][2];
#pragma unroll
  for (int i = 0; i < 2; ++i)
#pragma unroll
    for (int j = 0; j < 2; ++j)
#pragma unroll
      for (int q = 0; q < 16; ++q) acc[i][j][q] = 0.f;
  mma_ktile(As, Bs, acc, wm, wn, r, h);
  mma_ktile(As + 128 * LDT, Bs + 128 * LDT, acc, wm, wn, r, h);
  __syncthreads();
  acc_to_lds(Ct, acc, wm, wn, r, h);
  __syncthreads();
  EpiArgs ea{}; ea.aux = g;
  epilogue<EPI_POOL>(p, B, Ct, nullptr, rowbase, 0, ea);
  __syncthreads();
}

template <int DQK, int KT>
DI void attn_pass_sb(char* smem, const u16* __restrict__ Qg, const u16* __restrict__ Kg, const u16* __restrict__ VTg,
                  int nk, f32x16 (&O)[4], float& l_out) {
  constexpr int KLD = DQK + 8, NKS = DQK / 16, KCH = DQK / 8, KPT = KT * KCH / 256, VLD = KT + 8, VPT = KT / 16,
                KB = KT / 32, VCH = KT / 8;
  u16* Ks = (u16*)smem;
  u16* Vs = Ks + KT * KLD;
  const int tid = otid(), lane = tid & 63, wid = tid >> 6, r = lane & 31, h = lane >> 5;
  bf16x8 qf[NKS];
#pragma unroll
  for (int ks = 0; ks < NKS; ++ks) qf[ks] = *(const bf16x8*)(Qg + (size_t)(wid * 32 + r) * DQK + ks * 16 + h * 8);
  u32x4 rk[KPT], rv[VPT];
#pragma unroll
  for (int dvb = 0; dvb < 4; ++dvb)
#pragma unroll
    for (int g = 0; g < 16; ++g) O[dvb][g] = 0.f;
  float m = -1e30f, l = 0.f;
  const int nt = nk / KT;
  int kgo[KPT], klo[KPT], vgo[VPT], vlo[VPT];
#pragma unroll
  for (int it = 0; it < KPT; ++it) {
    int c = it * 256 + tid, key = c / KCH, kc = c - key * KCH;
    int rho = (key & ~12) | ((key & 4) << 1) | ((key & 8) >> 1);
    kgo[it] = key * DQK + kc * 8;
    klo[it] = rho * KLD + kc * 8;
  }
#pragma unroll
  for (int it = 0; it < VPT; ++it) {
    int c = it * 256 + tid, dv = c / VCH, kc = c - dv * VCH;
    vgo[it] = dv * LT + kc * 8;
    vlo[it] = dv * VLD + kc * 8;
  }
#pragma unroll
  for (int it = 0; it < KPT; ++it) rk[it] = *(const u32x4*)(Kg + kgo[it]);
#pragma unroll
  for (int it = 0; it < VPT; ++it) rv[it] = *(const u32x4*)(VTg + vgo[it]);
  for (int t = 0; t < nt; ++t) {
    __syncthreads();
#pragma unroll
    for (int it = 0; it < KPT; ++it) *(u32x4*)(Ks + klo[it]) = rk[it];
#pragma unroll
    for (int it = 0; it < VPT; ++it) *(u32x4*)(Vs + vlo[it]) = rv[it];
    __syncthreads();
    if (t + 1 < nt) {
      const u16* Kn = Kg + (size_t)(t + 1) * KT * DQK;
      const u16* Vn = VTg + (t + 1) * KT;
#pragma unroll
      for (int it = 0; it < KPT; ++it) rk[it] = *(const u32x4*)(Kn + kgo[it]);
#pragma unroll
      for (int it = 0; it < VPT; ++it) rv[it] = *(const u32x4*)(Vn + vgo[it]);
    }
    f32x16 S[KB];
#pragma unroll
    for (int kb = 0; kb < KB; ++kb) {
#pragma unroll
      for (int g = 0; g < 16; ++g) S[kb][g] = 0.f;
#pragma unroll
      for (int ks = 0; ks < NKS; ++ks) {
        bf16x8 a = *(const bf16x8*)(Ks + (kb * 32 + r) * KLD + ks * 16 + h * 8);
        S[kb] = MFMA32(a, qf[ks], S[kb]);
      }
    }
    float mx = -1e30f;
#pragma unroll
    for (int kb = 0; kb < KB; ++kb)
#pragma unroll
      for (int g = 0; g < 16; ++g) mx = fmaxf(mx, S[kb][g]);
    mx = fmaxf(mx, __shfl_xor(mx, 32));
    const float mn = fmaxf(m, mx);
    const float alpha = __builtin_amdgcn_exp2f(m - mn);
    const bool chg = __any(mn > m);
    m = mn;
    float ps = 0.f;
#pragma unroll
    for (int kb = 0; kb < KB; ++kb)
#pragma unroll
      for (int g = 0; g < 16; ++g) {
        float pv = __builtin_amdgcn_exp2f(S[kb][g] - mn);
        S[kb][g] = pv;
        ps += pv;
      }
    l = l * alpha + ps;
    if (chg) {
#pragma unroll
      for (int dvb = 0; dvb < 4; ++dvb)
#pragma unroll
        for (int g = 0; g < 16; ++g) O[dvb][g] *= alpha;
    }
    bf16x8 pf[KB][2];
#pragma unroll
    for (int kb = 0; kb < KB; ++kb)
#pragma unroll
      for (int s = 0; s < 2; ++s) {
        u32x4 o;
#pragma unroll
        for (int q = 0; q < 4; ++q) o[q] = pk2(S[kb][8 * s + 2 * q], S[kb][8 * s + 2 * q + 1]);
        pf[kb][s] = __builtin_bit_cast(bf16x8, o);
      }
#pragma unroll
    for (int dvb = 0; dvb < 4; ++dvb) {
#pragma unroll
      for (int kb = 0; kb < KB; ++kb)
#pragma unroll
        for (int s = 0; s < 2; ++s) {
          bf16x8 a = *(const bf16x8*)(Vs + (dvb * 32 + r) * VLD + kb * 32 + s * 16 + h * 8);
          O[dvb] = MFMA32(a, pf[kb][s], O[dvb]);
        }
      if (dvb & 1) asm volatile("" ::: "memory");
    }
  }
  l_out = l + __shfl_xor(l, 32);
}

template <int DQK, int KT>
DI void attn_pass(char* smem, const u16* __restrict__ Qg, const u16* __restrict__ Kg, const u16* __restrict__ VTg,
                  int nk, f32x16 (&O)[4], float& l_out) {
  constexpr int KLD = DQK + 8, NKS = DQK / 16, KCH = DQK / 8, KPT = KT * KCH / 256, VLD = KT + 8, VPT = KT / 16,
                KB = KT / 32, VCH = KT / 8, STAGE = KT * KLD + 128 * VLD;
  u16* base = (u16*)smem;
  const int tid = otid(), lane = tid & 63, wid = tid >> 6, r = lane & 31, h = lane >> 5;
  bf16x8 qf[NKS];
#pragma unroll
  for (int ks = 0; ks < NKS; ++ks) qf[ks] = *(const bf16x8*)(Qg + (size_t)(wid * 32 + r) * DQK + ks * 16 + h * 8);
  u32x4 rk[KPT], rv[VPT];
#pragma unroll
  for (int dvb = 0; dvb < 4; ++dvb)
#pragma unroll
    for (int g = 0; g < 16; ++g) O[dvb][g] = 0.f;
  float m = -1e30f, l = 0.f;
  const int nt = nk / KT;
#define KGO(it, T) ({ int c_ = (it) * 256 + (T), key_ = c_ / KCH; key_ * DQK + (c_ - key_ * KCH) * 8; })
#define KLO(it, T) ({ int c_ = (it) * 256 + (T), key_ = c_ / KCH, kc_ = c_ - key_ * KCH; \
                      int rho_ = (key_ & ~12) | ((key_ & 4) << 1) | ((key_ & 8) >> 1); rho_ * KLD + kc_ * 8; })
#define VGO(it, T) ({ int c_ = (it) * 256 + (T), dv_ = c_ / VCH; dv_ * LT + (c_ - dv_ * VCH) * 8; })
#define VLO(it, T) ({ int c_ = (it) * 256 + (T), dv_ = c_ / VCH; KT * KLD + dv_ * VLD + (c_ - dv_ * VCH) * 8; })
  { const int tq = otid();
#pragma unroll
  for (int it = 0; it < KPT; ++it) rk[it] = *(const u32x4*)(Kg + KGO(it, tq));
#pragma unroll
  for (int it = 0; it < VPT; ++it) rv[it] = *(const u32x4*)(VTg + VGO(it, tq));
  __syncthreads();
#pragma unroll
  for (int it = 0; it < KPT; ++it) *(u32x4*)(base + KLO(it, tq)) = rk[it];
#pragma unroll
  for (int it = 0; it < VPT; ++it) *(u32x4*)(base + VLO(it, tq)) = rv[it];
  if (nt > 1) {
#pragma unroll
    for (int it = 0; it < KPT; ++it) rk[it] = *(const u32x4*)(Kg + (size_t)KT * DQK + KGO(it, tq));
#pragma unroll
    for (int it = 0; it < VPT; ++it) rv[it] = *(const u32x4*)(VTg + KT + VGO(it, tq));
  }
  }
  __syncthreads();
  for (int t = 0; t < nt; ++t) {
    const u16* Ks = base + (t & 1) * STAGE;
    const u16* Vs = Ks + KT * KLD;
    f32x16 S[KB];
#pragma unroll
    for (int kb = 0; kb < KB; ++kb) {
#pragma unroll
      for (int g = 0; g < 16; ++g) S[kb][g] = 0.f;
#pragma unroll
      for (int ks = 0; ks < NKS; ++ks) {
        bf16x8 a = *(const bf16x8*)(Ks + (kb * 32 + r) * KLD + ks * 16 + h * 8);
        S[kb] = MFMA32(a, qf[ks], S[kb]);
      }
    }
    if (t + 1 < nt) {
      const int tq = otid();
      u16* nb_ = base + ((t + 1) & 1) * STAGE;
#pragma unroll
      for (int it = 0; it < KPT; ++it) *(u32x4*)(nb_ + KLO(it, tq)) = rk[it];
#pragma unroll
      for (int it = 0; it < VPT; ++it) *(u32x4*)(nb_ + VLO(it, tq)) = rv[it];
      if (t + 2 < nt) {
        const u16* Kn = Kg + (size_t)(t + 2) * KT * DQK;
        const u16* Vn = VTg + (t + 2) * KT;
#pragma unroll
        for (int it = 0; it < KPT; ++it) rk[it] = *(const u32x4*)(Kn + KGO(it, tq));
#pragma unroll
        for (int it = 0; it < VPT; ++it) rv[it] = *(const u32x4*)(Vn + VGO(it, tq));
      }
    }
    float mx = -1e30f;
#pragma unroll
    for (int kb = 0; kb < KB; ++kb)
#pragma unroll
      for (int g = 0; g < 16; ++g) mx = fmaxf(mx, S[kb][g]);
    mx = fmaxf(mx, __shfl_xor(mx, 32));
    const float mn = fmaxf(m, mx);
    const float alpha = __builtin_amdgcn_exp2f(m - mn);
    const bool chg = __any(mn > m);
    m = mn;
    float ps = 0.f;
#pragma unroll
    for (int kb = 0; kb < KB; ++kb)
#pragma unroll
      for (int g = 0; g < 16; ++g) {
        float pv = __builtin_amdgcn_exp2f(S[kb][g] - mn);
        S[kb][g] = pv;
        ps += pv;
      }
    l = l * alpha + ps;
    if (chg) {
#pragma unroll
      for (int dvb = 0; dvb < 4; ++dvb)
#pragma unroll
        for (int g = 0; g < 16; ++g) O[dvb][g] *= alpha;
    }
    bf16x8 pf[KB][2];
#pragma unroll
    for (int kb = 0; kb < KB; ++kb)
#pragma unroll
      for (int s = 0; s < 2; ++s) {
        u32x4 o;
#pragma unroll
        for (int q = 0; q < 4; ++q) o[q] = pk2(S[kb][8 * s + 2 * q], S[kb][8 * s + 2 * q + 1]);
        pf[kb][s] = __builtin_bit_cast(bf16x8, o);
      }
#pragma unroll
    for (int dvb = 0; dvb < 4; ++dvb) {
#pragma unroll
      for (int kb = 0; kb < KB; ++kb)
#pragma unroll
        for (int s = 0; s < 2; ++s) {
          bf16x8 a = *(const bf16x8*)(Vs + (dvb * 32 + r) * VLD + kb * 32 + s * 16 + h * 8);
          O[dvb] = MFMA32(a, pf[kb][s], O[dvb]);
        }
    }
    __syncthreads();
  }
  l_out = l + __shfl_xor(l, 32);
#undef KGO
#undef KLO
#undef VGO
#undef VLO
}

DI void diff_attn_item(char* smem, const Params& p, const Bufs& B, int b, int vh, int pos0, int nk) {
  const int tid = otid(), lane = tid & 63, wid = tid >> 6, r = lane & 31, h = lane >> 5;
  f32x16 O[4];
  unsigned* Okl = (unsigned*)(smem + 40960);
  const float lam = B.lam_()[0];
  const u16* VT = B.VT0_() + (size_t)(b * 4 + vh) * 128 * LT;
  float ss = 0.f;
#pragma unroll
  for (int e = 0; e < 2; ++e) {
    const int head = 2 * vh + e;
    const u16* Q = B.Q0_() + ((size_t)(b * 8 + head) * LT + pos0) * 64;
    const u16* K = B.K0_() + (size_t)(b * 8 + head) * LT * 64;
    float l;
    attn_pass_sb<64, 64>(smem, Q, K, VT, nk, O, l);
    const float inv = 1.f / l;
    if (e == 0) {
#pragma unroll
      for (int dvb = 0; dvb < 4; ++dvb)
#pragma unroll
        for (int q = 0; q < 8; ++q) Okl[(dvb * 8 + q) * 256 + tid] = pk2(O[dvb][2 * q] * inv, O[dvb][2 * q + 1] * inv);
    } else {
#pragma unroll
      for (int dvb = 0; dvb < 4; ++dvb)
#pragma unroll
        for (int q = 0; q < 8; ++q) {
          unsigned o0 = Okl[(dvb * 8 + q) * 256 + tid];
          float a0 = bflo(o0) - lam * (O[dvb][2 * q] * inv), a1 = bfhi(o0) - lam * (O[dvb][2 * q + 1] * inv);
          O[dvb][2 * q] = a0; O[dvb][2 * q + 1] = a1;
          ss += a0 * a0 + a1 * a1;
        }
    }
  }
  ss += __shfl_xor(ss, 32);
  const float rstd = rsqrtf(ss * (1.f / 128.f) + EPS) * 0.8f;
  const float* sub = p.in[17];
  u16* orow = B.MIX0_() + (size_t)(b * LT + pos0 + wid * 32 + r) * 1024 + 512 + vh * 128;
#pragma unroll
  for (int dvb = 0; dvb < 4; ++dvb)
#pragma unroll
    for (int g = 0; g < 4; ++g) {
      int dv0 = dvb * 32 + 8 * g + 4 * h;
      u32x2 o;
      o[0] = pk2(O[dvb][4 * g] * rstd * sub[dv0], O[dvb][4 * g + 1] * rstd * sub[dv0 + 1]);
      o[1] = pk2(O[dvb][4 * g + 2] * rstd * sub[dv0 + 2], O[dvb][4 * g + 3] * rstd * sub[dv0 + 3]);
      *(u32x2*)(orow + dv0) = o;
    }
}

DI void mla_attn_item(char* smem, const Bufs& B, int b, int hd, int qt) {
  const int lane = otid() & 63, wid = otid() >> 6, r = lane & 31, h = lane >> 5;
  f32x16 O[4];
  float l;
  const u16* Q = B.QF_() + ((size_t)(b * 4 + hd) * SEQ + qt * 128) * 192;
  const u16* K = B.KF_() + (size_t)(b * 4 + hd) * LT * 192;
  const u16* VT = B.VT1_() + (size_t)(b * 4 + hd) * 128 * LT;
  attn_pass<192, 32>(smem, Q, K, VT, LT, O, l);
  const float inv = 1.f / l;
  u16* orow = B.MIX1_() + (size_t)(b * LT + CTX + qt * 128 + wid * 32 + r) * 1024 + hd * 128;
#pragma unroll
  for (int dvb = 0; dvb < 4; ++dvb)
#pragma unroll
    for (int g = 0; g < 4; ++g) {
      int dv0 = dvb * 32 + 8 * g + 4 * h;
      u32x2 o;
      o[0] = pk2(O[dvb][4 * g] * inv, O[dvb][4 * g + 1] * inv);
      o[1] = pk2(O[dvb][4 * g + 2] * inv, O[dvb][4 * g + 3] * inv);
      *(u32x2*)(orow + dv0) = o;
    }
}

constexpr int HLD = 136;
DI void hgrn_item(char* smem, const Bufs& B, int b, int hd, int dir) {
  u16* Qs = (u16*)smem;
  u16* Ksm = Qs + 64 * HLD;
  u16* KsT = Ksm + 64 * HLD;
  u16* VsT = KsT + 128 * LDT;
  float* emid = (float*)(VsT + 128 * LDT);
  float* ecm = emid + 128;
  const int tid = otid(), lane = tid & 63, w = tid >> 6, r = lane & 31, h = lane >> 5;
  f32x16 S[4];
#pragma unroll
  for (int kb = 0; kb < 4; ++kb)
#pragma unroll
    for (int g = 0; g < 16; ++g) S[kb][g] = 0.f;
  const u16* LFd = B.LF_() + (size_t)dir * M * 512;
  u16* OHd = B.OH_() + (size_t)dir * M * 512;
  for (int ci = 0; ci < 68; ++ci) {
    const int c = dir ? (ci < 4 ? 3 - ci : 71 - ci) : ci;
    const int rowc = b * LT + c * 64;
#pragma unroll
    for (int it = 0; it < 4; ++it) {
      int cid = it * 256 + tid, pp = cid >> 4, cc = cid & 15;
      size_t grow = (size_t)(rowc + (dir ? 63 - pp : pp));
      u32x4 qv = *(const u32x4*)(B.HQ_() + grow * 512 + hd * 128 + cc * 8);
      u32x4 lv = *(const u32x4*)(LFd + grow * 512 + hd * 128 + cc * 8);
      *(u32x4*)(Qs + pp * HLD + cc * 8) = qv;
      *(u32x4*)(Ksm + pp * HLD + cc * 8) = lv;
    }
#pragma unroll
    for (int it = 0; it < 4; ++it) {
      const int cc = it * 4 + w, pp = lane;
      size_t grow = (size_t)(rowc + (dir ? 63 - pp : pp));
      u32x4 vv = *(const u32x4*)(B.HI_() + grow * 512 + hd * 128 + cc * 8);
#pragma unroll
      for (int q = 0; q < 4; ++q) {
        VsT[(cc * 8 + 2 * q) * LDT + pp] = (u16)(vv[q] & 0xffffu);
        VsT[(cc * 8 + 2 * q + 1) * LDT + pp] = (u16)(vv[q] >> 16);
      }
    }
    __syncthreads();
    {
      const int ch = tid & 127, half = tid >> 7;
      float tot0 = 0.f;
      for (int pp = 0; pp < 32; ++pp) tot0 += h2f(Ksm[pp * HLD + ch]);
      __syncthreads();
      float run = half ? 0.f : -tot0;
#pragma unroll
      for (int p8 = 0; p8 < 4; ++p8) {
        float kt[8];
#pragma unroll
        for (int e = 0; e < 8; ++e) {
          int pp = half * 32 + p8 * 8 + e;
          float lf = h2f(Ksm[pp * HLD + ch]);
          run += lf;
          float q = bf2f(Qs[pp * HLD + ch]);
          float er = __expf(run);
          Qs[pp * HLD + ch] = f2bf(q * er);
          kt[e] = (1.f - __expf(lf)) / er;
          Ksm[pp * HLD + ch] = f2bf(kt[e]);
        }
        *(u32x4*)(KsT + ch * LDT + half * 32 + p8 * 8) = pack8(kt);
      }
      if (half == 0) emid[ch] = __expf(tot0); else ecm[ch] = __expf(run);
    }
    __syncthreads();
    bf16x8 xa[4][2];
#pragma unroll
    for (int kb = 0; kb < 4; ++kb) {
#pragma unroll
      for (int g = 0; g < 16; ++g) S[kb][g] *= emid[kb * 32 + crow(g, h)];
#pragma unroll
      for (int s = 0; s < 2; ++s) {
        u32x4 o;
#pragma unroll
        for (int q = 0; q < 4; ++q) o[q] = pk2(S[kb][8 * s + 2 * q], S[kb][8 * s + 2 * q + 1]);
        xa[kb][s] = __builtin_bit_cast(bf16x8, o);
      }
    }
#pragma unroll
    for (int tb = 0; tb < 2; ++tb) {
      f32x16 oT;
#pragma unroll
      for (int g = 0; g < 16; ++g) oT[g] = 0.f;
#pragma unroll
      for (int kb = 0; kb < 4; ++kb)
#pragma unroll
        for (int s = 0; s < 2; ++s) {
          const u16* qp = Qs + (tb * 32 + r) * HLD + kb * 32 + s * 16 + 4 * h;
          u32x2 lo = *(const u32x2*)qp, hi = *(const u32x2*)(qp + 8);
          u32x4 bq = {lo[0], lo[1], hi[0], hi[1]};
          oT = MFMA32(xa[kb][s], __builtin_bit_cast(bf16x8, bq), oT);
        }
#pragma unroll
      for (int sb = 0; sb <= tb; ++sb) {
        f32x16 P;
#pragma unroll
        for (int g = 0; g < 16; ++g) P[g] = 0.f;
#pragma unroll
        for (int ks = 0; ks < 8; ++ks) {
          bf16x8 a = *(const bf16x8*)(Ksm + (sb * 32 + r) * HLD + ks * 16 + h * 8);
          bf16x8 bb = *(const bf16x8*)(Qs + (tb * 32 + r) * HLD + ks * 16 + h * 8);
          P = MFMA32(a, bb, P);
        }
        if (sb == tb) {
#pragma unroll
          for (int g = 0; g < 16; ++g) P[g] = (crow(g, h) <= r) ? P[g] : 0.f;
        }
#pragma unroll
        for (int s = 0; s < 2; ++s) {
          u32x4 o;
#pragma unroll
          for (int q = 0; q < 4; ++q) o[q] = pk2(P[8 * s + 2 * q], P[8 * s + 2 * q + 1]);
          const u16* vp = VsT + (w * 32 + r) * LDT + sb * 32 + s * 16 + 4 * h;
          u32x2 lo = *(const u32x2*)vp, hi = *(const u32x2*)(vp + 8);
          u32x4 av = {lo[0], lo[1], hi[0], hi[1]};
          oT = MFMA32(__builtin_bit_cast(bf16x8, av), __builtin_bit_cast(bf16x8, o), oT);
        }
      }
      {
        int pp = tb * 32 + r;
        size_t grow = (size_t)(rowc + (dir ? 63 - pp : pp));
        u16* op = OHd + grow * 512 + hd * 128 + w * 32;
#pragma unroll
        for (int g4 = 0; g4 < 4; ++g4) {
          u32x2 o;
          o[0] = pk2(oT[4 * g4], oT[4 * g4 + 1]);
          o[1] = pk2(oT[4 * g4 + 2], oT[4 * g4 + 3]);
          *(u32x2*)(op + 8 * g4 + 4 * h) = o;
        }
      }
    }
#pragma unroll
    for (int kb = 0; kb < 4; ++kb) {
#pragma unroll
      for (int ts = 0; ts < 4; ++ts) {
        bf16x8 a = *(const bf16x8*)(KsT + (kb * 32 + r) * LDT + ts * 16 + h * 8);
        bf16x8 bb = *(const bf16x8*)(VsT + (w * 32 + r) * LDT + ts * 16 + h * 8);
        S[kb] = MFMA32(a, bb, S[kb]);
      }
#pragma unroll
      for (int g = 0; g < 16; ++g) S[kb][g] *= ecm[kb * 32 + crow(g, h)];
    }
    __syncthreads();
  }
}

DI void hgrn_readout_row(const Params& p, const Bufs& B, int grow, int hd, int lane) {
  const size_t o = (size_t)grow * 512 + hd * 128 + lane * 2;
  unsigned a = *(const unsigned*)(B.OH_() + o), bq = *(const unsigned*)(B.OH_() + (size_t)M * 512 + o);
  unsigned gq = *(const unsigned*)(B.HG_() + o);
  float v0 = bflo(a) + bflo(bq), v1 = bfhi(a) + bfhi(bq);
  float ss = wave_sum(v0 * v0 + v1 * v1);
  float rstd = rsqrtf(ss * (1.f / 128.f) + EPS);
  const float* hn = p.in[23];
  float g0 = bflo(gq), g1 = bfhi(gq);
  unsigned out = pk2(v0 * rstd * hn[lane * 2] * siluf(g0), v1 * rstd * hn[lane * 2 + 1] * siluf(g1));
  *(unsigned*)(B.MIX1_() + (size_t)grow * 1024 + 512 + hd * 128 + lane * 2) = out;
}

constexpr int NPHASE = 18;


struct TileIter {
  int qg, step, ntn, nloc, total, xcd;
  DI TileIter(int nrt, int ntn_) {
    xcd = blockIdx.x & 7; qg = blockIdx.x >> 3; step = gridDim.x >> 3; ntn = ntn_;
    nloc = (nrt - xcd + 7) >> 3;
    total = ((nloc + 7) >> 3) * 8 * ntn;
  }
  DI bool next(int& rt, int& nt) {
    const int per = 8 * ntn, full = ntn >> 3, wrem = ntn & 7;
    while (qg < total) {
      int grp = qg / per, q = qg - grp * per, r, c;
      qg += step;
      if (q < full * 64) { int ch = q >> 6, qq = q & 63; r = qq >> 3; c = ch * 8 + (qq & 7); }
      else { int qq = q - full * 64; r = qq / wrem; c = full * 8 + (qq - r * wrem); }
      int rl = grp * 8 + r;
      if (rl < nloc) { rt = rl * 8 + xcd; nt = c; return true; }
    }
    return false;
  }
};

DI int lat_rowbase(int rt) { return (rt >> 5) * LT + CTX + (rt & 31) * 128; }

DI void run_phase(int ph, const Params& p, const Bufs& B, char* smem) {
  const int bid = blockIdx.x, nb = gridDim.x, tid = otid(), lane = tid & 63, wid = tid >> 6;
  switch (ph) {
    case 0: {
      const int n = NW_P0 + 192 + 1;
      for (int it = bid; it < n; it += nb) {
        if (it < NW_P0) prep_weight_item(smem, p, B, it);
        else if (it < NW_P0 + 192) mod_gemv_item(smem, p, B, it - NW_P0);
        else tables_item(p, B);
      }
    } break;
    case 1: {
      for (int it = bid; it < M / 32; it += nb) {
        for (int rr = 0; rr < 8; ++rr) {
          int row = it * 32 + rr * 4 + wid;
          RowInfo ri = row_info(row);
          const float* x = (ri.lat ? p.in[0] : p.in[2]) + resid_off(ri);
          const float* md = B.mod_() + (size_t)(0 * 9 + ri.mi) * 6144;
          norm_mod_row(x, p.in[6] + 0, md, md + 1024, B.H_() + (size_t)row * 1024, lane);
        }
      }
    } break;
    case 2: {
      const int n = 272 * 16;
      EpiArgs ea{};
      TileIter ti(272, 16);
      for (int rt, nt; ti.next(rt, nt);) {
        gemm_tile<EPI_IN0, false>(smem, p, B, B.H_(), 1024, rt * 128, 0, M, B.wt_ev_(), 1024, nt * 128, ea);
      }
    } break;
    case 3: {
      const int n_lat = 8 * 4 * 32, n_ctx = 8 * 4 * 2, n_pool = 272 * 4;
      for (int it = bid; it < n_lat; it += nb) {
        int b = it >> 7, vh = (it >> 5) & 3, qt = it & 31;
        diff_attn_item(smem, p, B, b, vh, CTX + qt * 128, LT);
      }
      for (int it = nb - 1 - bid; it < n_ctx; it += nb) {
        int b = it >> 3, vh = (it >> 1) & 3, qt = it & 1;
        diff_attn_item(smem, p, B, b, vh, qt * 128, CTX);
      }
      for (int it = nb - 1 - bid; it < n_pool; it += nb) pool_tile(smem, p, B, it >> 2, it & 3);
    } break;
    case 4: {
      EpiArgs ea{}; ea.outf = B.Y0_();
      TileIter ti(272, 8);
      for (int rt, nt; ti.next(rt, nt);) {
        gemm_tile<EPI_F32, false>(smem, p, B, B.MIX0_(), 1024, rt * 128, 0, M, B.wt_out_(), 1024, nt * 128, ea);
      }
    } break;
    case 5: case 8: {
      const bool first = (ph == 5);
      const u16* Yb = (const u16*)B.Y0_();
      for (int it = bid; it < M / 32; it += nb) {
        for (int rr = 0; rr < 8; ++rr) {
          int row = it * 32 + rr * 4 + wid;
          RowInfo ri = row_info(row);
          size_t ro = resid_off(ri);
          const float* md0 = B.mod_() + (size_t)(0 * 9 + ri.mi) * 6144;
          const float* md1 = B.mod_() + (size_t)(1 * 9 + ri.mi) * 6144;
          float* xd = (ri.lat ? p.out : B.xc_()) + ro;
          if (first) {
            const float* xs = (ri.lat ? p.in[0] : p.in[2]) + ro;
            resid_row<true>(Yb + (size_t)row * 1024, xs, xd, md0 + 2 * 1024, p.in[6] + 1 * 1024, p.in[6] + 2 * 1024,
                            md0 + 3 * 1024, md0 + 4 * 1024, B.H_() + (size_t)row * 1024, lane);
          } else {
            resid_row<true>(Yb + (size_t)row * 1024, xd, xd, md0 + 5 * 1024, p.in[6] + 3 * 1024,
                            p.in[6] + 4 * 1024 + 0, md1, md1 + 1024, B.H_() + (size_t)row * 1024, lane);
          }
        }
      }
    } break;
    case 6: {
      const int n = 288 * 44;
      TileIter ti(288, 44);
      for (int rtile, nt; ti.next(rtile, nt);) {
        int b = rtile / 36, jj = rtile - b * 36;
        EpiArgs ea{}; ea.layer = 0;
        int j;
        if (jj < 3) { ea.seg_lo = b * LT; ea.seg_hi = b * LT + CTX; j = jj; }
        else { ea.seg_lo = b * LT + CTX; ea.seg_hi = (b + 1) * LT; j = jj - 3; }
        gemm_tile<EPI_FFN1, false>(smem, p, B, B.H_(), 1024, ea.seg_lo + 126 * j - 1, ea.seg_lo, ea.seg_hi, B.wt_f1_(), 1024,
                                   nt * 128, ea);
      }
    } break;
    case 7: {
      EpiArgs ea{}; ea.outf = B.Y0_();
      TileIter ti(272, 8);
      for (int rt, nt; ti.next(rt, nt);) {
        gemm_tile<EPI_F32, false>(smem, p, B, B.G0_(), DFF, rt * 128, 0, M, B.wt_f2_(), DFF, nt * 128, ea);
      }
    } break;
    case 9: {
      const int n = 272 * 27;
      EpiArgs ea{};
      TileIter ti(272, 27);
      for (int rt, nt; ti.next(rt, nt);) {
        gemm_tile<EPI_IN1, false>(smem, p, B, B.H_(), 1024, rt * 128, 0, M, B.wt_od_(), 1024, nt * 128, ea);
      }
    } break;
    case 10: {
      const int n_q = 256 * 6, n_kv = 272 * 8;
      EpiArgs ea{};
      TileIter tq(256, 6);
      for (int rt, nt; tq.next(rt, nt);) {
        gemm_tile<EPI_UQ, true>(smem, p, B, B.CQ_(), 512, lat_rowbase(rt), 0, M, B.wt_uq_(), 512, nt * 128, ea);
      }
      TileIter tk(272, 8);
      for (int rt, nt; tk.next(rt, nt);) {
        gemm_tile<EPI_UKV, true>(smem, p, B, B.CKV_(), 256, rt * 128, 0, M, B.wt_ukv_(), 256, nt * 128, ea);
      }
      for (int it = nb - 1 - bid; it < NW_FFN; it += nb) ffn_weight_item(smem, p, B, 1, it);
    } break;
    case 11: {
      const int n_h = 64, n_a = 8 * 4 * 32;
      unsigned* qctr = (unsigned*)(p.ws + OFF_LAM + 256) + 64;
      volatile int* sitem = (volatile int*)(smem + SMEM_MAIN + 8);
      for (;;) {
        __syncthreads();
        if (otid() == 0) *sitem = (int)atomicAdd(qctr, 1u);
        __syncthreads();
        const int it = *sitem;
        if (it >= n_h) break;
        hgrn_item(smem, B, it >> 3, (it >> 1) & 3, it & 1);
      }
      for (;;) {
        __syncthreads();
        if (otid() == 0) *sitem = (int)atomicAdd(qctr + 1, 1u);
        __syncthreads();
        const int it = *sitem;
        if (it >= n_a) break;
        mla_attn_item(smem, B, it >> 7, (it >> 5) & 3, it & 31);
      }
    } break;
    case 12: {
      const int n = NB * SEQ * 4 / 4;
      for (int it = bid; it < n; it += nb) {
        int j = it * 4 + wid, rl = j >> 2, hd = j & 3;
        int grow = (rl >> 12) * LT + CTX + (rl & 4095);
        hgrn_readout_row(p, B, grow, hd, lane);
      }
    } break;
    case 13: {
      EpiArgs ea{}; ea.outf = B.Y1_();
      TileIter ti(256, 8);
      for (int rt, nt; ti.next(rt, nt);) {
        gemm_tile<EPI_F32, false>(smem, p, B, B.MIX1_(), 1024, lat_rowbase(rt), 0, M, B.wt_out_() + 1024 * 1024, 1024,
                                  nt * 128, ea);
      }
    } break;
    case 14: case 17: {
      const bool first = (ph == 14);
      for (int it = bid; it < NB * SEQ / 32; it += nb) {
        for (int rr = 0; rr < 8; ++rr) {
          int rl = it * 32 + rr * 4 + wid;
          int bb = rl >> 12, row = bb * LT + CTX + (rl & 4095);
          float* xd = p.out + (size_t)rl * 1024;
          const float* md1 = B.mod_() + (size_t)(1 * 9 + bb) * 6144;
          const float* ng = p.in[6] + 4 * 1024;
          if (first)
            resid_row<true>((const u16*)B.Y1_() + (size_t)row * 1024, xd, xd, md1 + 2 * 1024, ng + 1 * 1024, ng + 2 * 1024,
                            md1 + 3 * 1024, md1 + 4 * 1024, B.H_() + (size_t)row * 1024, lane);
          else
            resid_row<false>((const u16*)B.Y1_() + (size_t)row * 1024, xd, xd, md1 + 5 * 1024, ng + 3 * 1024, nullptr, nullptr, nullptr,
                             nullptr, lane);
        }
      }
    } break;
    case 15: {
      const int n = 264 * 44;
      TileIter ti(264, 44);
      for (int rtile, nt; ti.next(rtile, nt);) {
        int b = rtile / 33, j = rtile - b * 33;
        EpiArgs ea{}; ea.layer = 1; ea.seg_lo = b * LT + CTX; ea.seg_hi = (b + 1) * LT;
        gemm_tile<EPI_FFN1, false>(smem, p, B, B.H_(), 1024, ea.seg_lo + 126 * j - 1, ea.seg_lo, ea.seg_hi, B.wt_f1_(), 1024,
                                   nt * 128, ea);
      }
    } break;
    case 16: {
      EpiArgs ea{}; ea.outf = B.Y1_();
      TileIter ti(256, 8);
      for (int rt, nt; ti.next(rt, nt);) {
        gemm_tile<EPI_F32, false>(smem, p, B, B.G1_(), DFF, lat_rowbase(rt), 0, M, B.wt_f2_(), DFF, nt * 128, ea);
      }
    } break;
    default: break;
  }
}

#define XB_TMO      128
#define XB_XCNT(j)  (256  + 64 * (j))
#define XB_XSUB(j)  (1280 + 64 * (j))
#define XB_XGEN(j)  (2304 + 64 * (j))
#define XB_TOP      3328
#define XB_TOPGEN   3392
#define XCD_BAR_WORDS 3456
#define XB_SPIN_CAP (1u << 18)
#define LAS __attribute__((address_space(3)))
DI unsigned xb_ld(unsigned* p) { return __hip_atomic_load(p, __ATOMIC_RELAXED, __HIP_MEMORY_SCOPE_AGENT); }
DI unsigned xb_add(unsigned* p, unsigned v) { return __hip_atomic_fetch_add(p, v, __ATOMIC_RELAXED, __HIP_MEMORY_SCOPE_AGENT); }
DI unsigned xb_xcc_id() { return (unsigned)__builtin_amdgcn_s_getreg((3 << 11) | 20) & 0xFu; }
#define XB_SPIN(cond, bar) do { unsigned _sp = 0; while (cond) { __builtin_amdgcn_s_sleep(1); \
    if ((++_sp & 255u) == 0u) { if (xb_ld(&(bar)[XB_TMO])) break; if (_sp > XB_SPIN_CAP) { atomicAdd(&(bar)[XB_TMO], 1u); break; } } } } while (0)
struct XcdBarrier { unsigned* bar; unsigned x; volatile LAS unsigned* st; };
DI XcdBarrier xcd_barrier_post(unsigned* bar, volatile LAS unsigned* st) {
  XcdBarrier b; b.bar = bar; b.x = xb_xcc_id(); b.st = st;
  if (threadIdx.x == 0) (void)xb_add(&bar[XB_XCNT(b.x)], 1u);
  return b;
}
DI void xcd_barrier_complete(unsigned* bar, unsigned x, unsigned& nloc, unsigned& nx) {
  const unsigned G = gridDim.x * gridDim.y * gridDim.z;
  unsigned sum, cnt, mine, sp = 0u;
  for (;;) {
    sum = 0u; cnt = 0u; mine = 0u;
#pragma unroll
    for (unsigned j = 0; j < 16; ++j) { const unsigned c = xb_ld(&bar[XB_XCNT(j)]); sum += c; cnt += (c > 0u) ? 1u : 0u; mine = (j == x) ? c : mine; }
    if (sum == G) break;
    __builtin_amdgcn_s_sleep(1);
    if ((++sp & 255u) == 0u) { if (xb_ld(&bar[XB_TMO])) break; if (sp > XB_SPIN_CAP) { atomicAdd(&bar[XB_TMO], 1u); break; } }
  }
  nloc = mine > 0u ? mine : 1u; nx = cnt > 0u ? cnt : 1u;
}
DI void xcd_barrier(const XcdBarrier& b) {
  asm volatile("s_waitcnt vmcnt(0)" ::: "memory");
  __syncthreads();
  if (threadIdx.x == 0) {
    unsigned* bar = b.bar;
    __builtin_amdgcn_s_waitcnt(0);
    unsigned nloc = b.st[0], nx = b.st[1];
    if (nloc == 0u) { xcd_barrier_complete(bar, b.x, nloc, nx); b.st[0] = nloc; b.st[1] = nx; }
    const unsigned old = xb_add(&bar[XB_XSUB(b.x)], 1u);
    const unsigned gen = old / nloc;
    if (old + 1u == (gen + 1u) * nloc) {
      __builtin_amdgcn_fence(__ATOMIC_RELEASE, "agent");
      asm volatile("s_waitcnt vmcnt(0)" ::: "memory");
      const unsigned og = xb_add(&bar[XB_TOP], 1u);
      const unsigned tg = og / nx;
      if (og + 1u == (tg + 1u) * nx) xb_add(&bar[XB_TOPGEN], 1u);
      else XB_SPIN(xb_ld(&bar[XB_TOPGEN]) == tg, bar);
      __builtin_amdgcn_fence(__ATOMIC_ACQUIRE, "agent");
      xb_add(&bar[XB_XGEN(b.x)], 1u);
      asm volatile("s_waitcnt vmcnt(0)" ::: "memory");
    } else {
      XB_SPIN(xb_ld(&bar[XB_XGEN(b.x)]) == gen, bar);
      __builtin_amdgcn_fence(__ATOMIC_ACQUIRE, "agent");
      asm volatile("s_waitcnt vmcnt(0)" ::: "memory");
    }
  }
  __syncthreads();
}
#define RUNPH(k)                                                                       \
  if (p.ph_lo <= (k) && (k) < p.ph_hi) {                                               \
    run_phase((k), p, B, smem);                                                        \
    if ((k) + 1 < p.ph_hi) {                                                           \
      if ((k) == 0) cg::this_grid().sync();                                            \
      else xcd_barrier(xb);                                                            \
    }                                                                                  \
  }
__global__ void __launch_bounds__(NTHR, 2) fwd_megakernel(Params p) {
  extern __shared__ __attribute__((aligned(16))) char smem[];
  const Bufs B = make_bufs(p.ws);
  volatile LAS unsigned* xst = (volatile LAS unsigned*)(smem + SMEM_MAIN);
  if (threadIdx.x == 0) { xst[0] = 0u; xst[1] = 0u; xst[2] = 0u; xst[3] = 0u; }
  __syncthreads();
  const XcdBarrier xb = xcd_barrier_post((unsigned*)(p.ws + OFF_LAM + 256), xst);
  RUNPH(0) RUNPH(1) RUNPH(2) RUNPH(3) RUNPH(4) RUNPH(5) RUNPH(6) RUNPH(7) RUNPH(8)
  RUNPH(9) RUNPH(10) RUNPH(11) RUNPH(12) RUNPH(13) RUNPH(14) RUNPH(15) RUNPH(16) RUNPH(17)
}

constexpr bool ONE_LAUNCH = true;

extern "C" void kernel_launch(void* const* d_in, const int* in_sizes, int n_in, void* d_out, int out_size, void* d_ws,
                              size_t ws_size, hipStream_t stream) {
  static int grid_blocks = 0;
  if (!grid_blocks) {
    int dev = 0, cus = 0, per_cu = 0;
    hipGetDevice(&dev);
    hipDeviceGetAttribute(&cus, hipDeviceAttributeMultiprocessorCount, dev);
    hipFuncSetAttribute((const void*)fwd_megakernel, hipFuncAttributeMaxDynamicSharedMemorySize, SMEM_BYTES);
    hipOccupancyMaxActiveBlocksPerMultiprocessor(&per_cu, fwd_megakernel, NTHR, SMEM_BYTES);
    if (per_cu < 1) per_cu = 1;
    if (per_cu > 2) per_cu = 2;
    grid_blocks = cus * per_cu;
  }
  if (ws_size < WS_NEEDED) {
    fprintf(stderr, "workspace too small: %zu < %zu\n", ws_size, (size_t)WS_NEEDED);
    return;
  }
  Params p{};
  for (int i = 0; i < 25; ++i) p.in[i] = (const float*)d_in[i];
  p.out = (float*)d_out;
  p.ws = (char*)d_ws;
  hipMemsetAsync((char*)d_ws + OFF_LAM + 256, 0, XCD_BAR_WORDS * 4, stream);
  if (ONE_LAUNCH) {
    p.ph_lo = 0; p.ph_hi = NPHASE;

    void* args[] = {&p};
    hipError_t e = hipLaunchCooperativeKernel((const void*)fwd_megakernel, dim3(grid_blocks), dim3(NTHR), args,
                                              SMEM_BYTES, stream);
    if (e != hipSuccess) fprintf(stderr, "cooperative launch failed: %s (grid %d)\n", hipGetErrorString(e), grid_blocks);
  } else {
    for (int ph = 0; ph < NPHASE; ++ph) {
      p.ph_lo = ph; p.ph_hi = ph + 1;
      hipLaunchKernelGGL(fwd_megakernel, dim3(grid_blocks), dim3(NTHR), SMEM_BYTES, stream, p);
    }
  }
}
```

```cpp
#include <hip/hip_runtime.h>
#include <hip/hip_fp16.h>
#include <hip/hip_cooperative_groups.h>
#include <cstdio>
#include <cstdint>
namespace cg = cooperative_groups;

#define DI __device__ __forceinline__
typedef unsigned short u16;
typedef __attribute__((ext_vector_type(8))) short bf16x8;
typedef __attribute__((ext_vector_type(16))) float f32x16;
typedef __attribute__((ext_vector_type(4))) unsigned u32x4;
typedef __attribute__((ext_vector_type(2))) unsigned u32x2;

constexpr int D = 1024, NB = 8, SEQ = 4096, CTX = 256, LT = 4352, M = NB * LT, DFF = 2816;
constexpr float EPS = 1e-6f;
constexpr float LOG2E = 1.4426950408889634f;
constexpr float QS_DIFF = 0.125f * LOG2E;
constexpr float QS_MLA = 0.07216878364870323f * LOG2E;
constexpr int NTHR = 256;

constexpr size_t SZ_WT_OUT = 2ull * 1024 * 1024 * 2;
constexpr size_t SZ_WT_F1 = 5632ull * 1024 * 2;
constexpr size_t SZ_WT_F2 = 1024ull * 2816 * 2;
constexpr size_t SZ_WT_EV = 2048ull * 1024 * 2;
constexpr size_t SZ_WT_OD = 3456ull * 1024 * 2;
constexpr size_t SZ_WT_UQ = 768ull * 512 * 2;
constexpr size_t SZ_WT_UKV = 1024ull * 256 * 2;
constexpr size_t SZ_WT_POOL = 4ull * 128 * 128 * 2;
constexpr size_t SZ_MOD = 2ull * 9 * 6144 * 4;
constexpr size_t SZ_ROPE = 2ull * 1024 * 4;
constexpr size_t SZ_LB = 1024 * 4;
constexpr size_t SZ_LAM = 256 + 16384;
constexpr size_t SZ_XC = 2048ull * 1024 * 4;
constexpr size_t SZ_H = (size_t)M * 1024 * 2;
constexpr size_t SZ_M512 = (size_t)M * 512 * 2;

constexpr size_t OFF_WT_OUT = 0;
constexpr size_t OFF_WT_F1 = OFF_WT_OUT + SZ_WT_OUT;
constexpr size_t OFF_WT_F2 = OFF_WT_F1 + SZ_WT_F1;
constexpr size_t OFF_WT_EV = OFF_WT_F2 + SZ_WT_F2;
constexpr size_t OFF_WT_OD = OFF_WT_EV + SZ_WT_EV;
constexpr size_t OFF_WT_UQ = OFF_WT_OD + SZ_WT_OD;
constexpr size_t OFF_WT_UKV = OFF_WT_UQ + SZ_WT_UQ;
constexpr size_t OFF_WT_POOL = OFF_WT_UKV + SZ_WT_UKV;
constexpr size_t OFF_MOD = OFF_WT_POOL + SZ_WT_POOL;
constexpr size_t OFF_ROPE = OFF_MOD + SZ_MOD;
constexpr size_t OFF_LB = OFF_ROPE + SZ_ROPE;
constexpr size_t OFF_LAM = OFF_LB + SZ_LB;
constexpr size_t OFF_XC = OFF_LAM + SZ_LAM;
constexpr size_t OFF_H = OFF_XC + SZ_XC;
constexpr size_t OFF_R = OFF_H + SZ_H;
constexpr size_t R_U = 0;
constexpr size_t R_Q0 = R_U + SZ_M512;
constexpr size_t R_K0 = R_Q0 + SZ_M512;
constexpr size_t R_VT0 = R_K0 + SZ_M512;
constexpr size_t R_MIX0 = R_VT0 + SZ_M512;
constexpr size_t R_Y0 = R_MIX0 + SZ_H;
constexpr size_t R_G0 = 0;
constexpr size_t R_MIX1 = 0;
constexpr size_t R_CQ = 0;
constexpr size_t R_CKV = SZ_M512;
constexpr size_t R_KF = SZ_H;
constexpr size_t SZ_KF = 8ull * 4 * LT * 192 * 2;
constexpr size_t R_VT1 = R_KF + SZ_KF;
constexpr size_t R_HQ = R_VT1 + SZ_M512;
constexpr size_t R_LF = R_HQ + SZ_M512;
constexpr size_t R_HI = R_LF + 2 * SZ_M512;
constexpr size_t R_HG = R_HI + SZ_M512;
constexpr size_t R_OH = R_HG + SZ_M512;
constexpr size_t R_END1 = R_OH + 2 * SZ_M512;
constexpr size_t R_Y1 = R_KF;
constexpr size_t SZ_Y = (size_t)M * 1024 * 4;
constexpr size_t R_G1 = R_Y1 + SZ_Y;
constexpr size_t SZ_G = (size_t)M * DFF * 2;
constexpr size_t R_SIZE = (R_G1 + SZ_G > R_END1) ? (R_G1 + SZ_G) : R_END1;
constexpr size_t WS_NEEDED = OFF_R + R_SIZE;
static_assert(R_Y0 + SZ_Y <= R_SIZE, "layer0 region");
static_assert(R_G0 + SZ_G <= R_Y0, "G0 overlap");
static_assert(WS_NEEDED <= 536870912ull, "ws too big");

struct Params {
  const float* in[25];
  float* out;
  char* ws;
  int ph_lo, ph_hi;
};

constexpr int SMEM_MAIN = 73728;
constexpr int SMEM_BYTES = SMEM_MAIN + 16;
constexpr int LDT = 72;
constexpr int CLD = 132;

DI int otid() { int t = threadIdx.x; asm volatile("" : "+v"(t)); return t; }
DI u16 f2bf(float x) { return __builtin_bit_cast(u16, (__bf16)x); }
DI unsigned pk2(float a, float b) { return (unsigned)f2bf(a) | ((unsigned)f2bf(b) << 16); }
DI float bflo(unsigned u) { return __uint_as_float(u << 16); }
DI float bfhi(unsigned u) { return __uint_as_float(u & 0xffff0000u); }
DI float bf2f(u16 v) { return __uint_as_float(((unsigned)v) << 16); }
DI float h2f(u16 v) { return __half2float(__ushort_as_half(v)); }
DI u16 f2h(float x) { return __half_as_ushort(__float2half(x)); }
DI float siluf(float x) { return x / (1.f + __expf(-x)); }
DI float wave_sum(float v) {
#pragma unroll
  for (int o = 32; o > 0; o >>= 1) v += __shfl_xor(v, o);
  return v;
}
DI u32x4 pack8(const float* v) {
  u32x4 o;
  o[0] = pk2(v[0], v[1]); o[1] = pk2(v[2], v[3]); o[2] = pk2(v[4], v[5]); o[3] = pk2(v[6], v[7]);
  return o;
}
DI int crow(int reg, int h) { return (reg & 3) + 8 * (reg >> 2) + 4 * h; }
#define MFMA32(a, b, c) __builtin_amdgcn_mfma_f32_32x32x16_bf16((a), (b), (c), 0, 0, 0)

struct Bufs {
  char* ws;
#define BUFP(T, name, off) DI T* name##_() const { return (T*)(ws + (off)); }
  BUFP(u16, wt_out, OFF_WT_OUT) BUFP(u16, wt_f1, OFF_WT_F1) BUFP(u16, wt_f2, OFF_WT_F2) BUFP(u16, wt_ev, OFF_WT_EV)
  BUFP(u16, wt_od, OFF_WT_OD) BUFP(u16, wt_uq, OFF_WT_UQ) BUFP(u16, wt_ukv, OFF_WT_UKV) BUFP(u16, wt_pool, OFF_WT_POOL)
  BUFP(float, mod, OFF_MOD) BUFP(float, ropec, OFF_ROPE) BUFP(float, ropes, OFF_ROPE + 4096) BUFP(float, lb, OFF_LB)
  BUFP(float, lam, OFF_LAM) BUFP(float, xc, OFF_XC) BUFP(u16, H, OFF_H)
  BUFP(u16, U, OFF_R + R_U) BUFP(u16, Q0, OFF_R + R_Q0) BUFP(u16, K0, OFF_R + R_K0) BUFP(u16, VT0, OFF_R + R_VT0)
  BUFP(u16, MIX0, OFF_R + R_MIX0) BUFP(float, Y0, OFF_R + R_Y0) BUFP(u16, G0, OFF_R + R_G0)
  BUFP(u16, CQ, OFF_R + R_CQ) BUFP(u16, CKV, OFF_R + R_CKV) BUFP(u16, MIX1, OFF_R + R_MIX1) BUFP(u16, KF, OFF_R + R_KF)
  BUFP(u16, VT1, OFF_R + R_VT1) BUFP(u16, HQ, OFF_R + R_HQ) BUFP(u16, LF, OFF_R + R_LF) BUFP(u16, HI, OFF_R + R_HI)
  BUFP(u16, HG, OFF_R + R_HG) BUFP(u16, OH, OFF_R + R_OH) BUFP(u16, QF, OFF_H) BUFP(float, Y1, OFF_R + R_Y1)
  BUFP(u16, G1, OFF_R + R_G1)
};
DI Bufs make_bufs(char* ws) { Bufs b; b.ws = ws; return b; }

DI void wt_tile(char* smem, const float* __restrict__ src, int ld, int kt, int ncol0, u16* __restrict__ dst, int K,
                int dst_row0, const float* __restrict__ scale) {
  float* t = (float*)smem;
  const int tid = otid(), col = tid & 63, r0 = tid >> 6;
#pragma unroll 4
  for (int i = 0; i < 16; ++i) {
    int row = i * 4 + r0;
    float v = src[(size_t)(kt * 64 + row) * ld + ncol0 + col];
    if (scale) v *= scale[kt * 64 + row];
    t[row * 65 + col] = v;
  }
  __syncthreads();
#pragma unroll
  for (int it = 0; it < 2; ++it) {
    int c = it * 256 + tid, j = c >> 3, kc = c & 7;
    u32x4 o;
#pragma unroll
    for (int q = 0; q < 4; ++q) o[q] = pk2(t[(kc * 8 + 2 * q) * 65 + j], t[(kc * 8 + 2 * q + 1) * 65 + j]);
    *(u32x4*)(dst + (size_t)(dst_row0 + j) * K + kt * 64 + kc * 8) = o;
  }
  __syncthreads();
}

#define WJOB(SRC, LDD, KK, NN, DST, TS, ROFF, SC)                                        \
  {                                                                                       \
    const int ntn = (NN) / 64, cnt = ((KK) / 64) * ntn;                                   \
    if (idx < cnt) {                                                                      \
      int kt = idx / ntn, nt = idx % ntn;                                                 \
      wt_tile(smem, (SRC), (LDD), kt, nt * 64, (DST), (KK), nt * (TS) + (ROFF), (SC));    \
      return;                                                                             \
    }                                                                                     \
    idx -= cnt;                                                                           \
  }

constexpr int NW_FFN = 704 * 3;
constexpr int NW_P0 = 256 + 256 + NW_FFN + 512 + 848 + 96 + 64 + 16;

DI void ffn_weight_item(char* smem, const Params& p, const Bufs& B, int layer, int idx) {
  WJOB(p.in[8] + (size_t)layer * 1024 * DFF, DFF, 1024, DFF, B.wt_f1_(), 128, 0, nullptr)
  WJOB(p.in[9] + (size_t)layer * 1024 * DFF, DFF, 1024, DFF, B.wt_f1_(), 128, 64, nullptr)
  WJOB(p.in[12] + (size_t)layer * DFF * 1024, 1024, DFF, 1024, B.wt_f2_(), 64, 0, nullptr)
}

DI void prep_weight_item(char* smem, const Params& p, const Bufs& B, int idx) {
  WJOB(p.in[7], 1024, 1024, 1024, B.wt_out_(), 64, 0, nullptr)
  WJOB(p.in[7] + 1024 * 1024, 1024, 1024, 1024, B.wt_out_() + 1024 * 1024, 64, 0, nullptr)
  if (idx < NW_FFN) { ffn_weight_item(smem, p, B, 0, idx); return; }
  idx -= NW_FFN;
  WJOB(p.in[13], 2048, 1024, 2048, B.wt_ev_(), 64, 0, nullptr)
  WJOB(p.in[18], 3392, 1024, 3392, B.wt_od_(), 64, 0, nullptr)
  WJOB(p.in[20], 768, 512, 768, B.wt_uq_(), 64, 0, p.in[19])
  WJOB(p.in[22], 1024, 256, 1024, B.wt_ukv_(), 64, 0, p.in[21])
  {
    int g = idx >> 2, t = idx & 3;
    wt_tile(smem, p.in[14] + g * 128 * 128, 128, t >> 1, (t & 1) * 64, B.wt_pool_() + g * 128 * 128, 128, (t & 1) * 64,
            nullptr);
  }
}

DI void mod_gemv_item(char* smem, const Params& p, const Bufs& B, int idx) {
  const int layer = idx / 96, c0 = (idx % 96) * 64, tid = otid();
  float* sc = (float*)smem;
  float* red = sc + 9 * 1024;
  for (int i = tid; i < 9 * 1024; i += NTHR) {
    int rr = i >> 10, k = i & 1023;
    float v = (rr < 8) ? p.in[1][rr * 1024 + k] : p.in[3][k];
    sc[i] = siluf(v);
  }
  __syncthreads();
  const int cq = tid & 15, kg = tid >> 4;
  float acc[9][4];
#pragma unroll
  for (int a = 0; a < 9; ++a)
#pragma unroll
    for (int e = 0; e < 4; ++e) acc[a][e] = 0.f;
  const float* W = p.in[4] + (size_t)layer * 1024 * 6144 + c0 + cq * 4;
#pragma unroll 4
  for (int kk = 0; kk < 64; ++kk) {
    int k = kg * 64 + kk;
    float4 w = *(const float4*)(W + (size_t)k * 6144);
#pragma unroll
    for (int a = 0; a < 9; ++a) {
      float s = sc[a * 1024 + k];
      acc[a][0] += s * w.x; acc[a][1] += s * w.y; acc[a][2] += s * w.z; acc[a][3] += s * w.w;
    }
  }
#pragma unroll
  for (int a = 0; a < 9; ++a)
#pragma unroll
    for (int e = 0; e < 4; ++e) red[(kg * 9 + a) * 64 + cq * 4 + e] = acc[a][e];
  __syncthreads();
  for (int i = tid; i < 9 * 64; i += NTHR) {
    int a = i >> 6, c = i & 63;
    float s = 0.f;
    for (int g = 0; g < 16; ++g) s += red[(g * 9 + a) * 64 + c];
    B.mod_()[(size_t)(layer * 9 + a) * 6144 + c0 + c] = s + p.in[5][layer * 6144 + c0 + c];
  }
  __syncthreads();
}

DI void tables_item(const Params& p, const Bufs& B) {
  const int tid = otid();
  for (int i = tid; i < 1024; i += NTHR) {
    int pos = i >> 4, f = i & 15;
    float inv = powf(10000.f, -(float)f / 16.f);
    float ang = (float)pos * inv;
    B.ropec_()[i] = cosf(ang);
    B.ropes_()[i] = sinf(ang);
    int dir = i >> 9, ch = i & 511;
    float a0 = p.in[24][(dir * 2 + 0) * 512 + ch], a1 = p.in[24][(dir * 2 + 1) * 512 + ch];
    B.lb_()[i] = 1.f / (1.f + expf(a0 - a1));
  }
  if (tid < 64) {
    const float* L = p.in[16];
    float s1 = wave_sum(L[tid] * L[64 + tid]);
    float s2 = wave_sum(L[128 + tid] * L[192 + tid]);
    if (tid == 0) B.lam_()[0] = expf(s1) - expf(s2) + 0.2f;
  }
  for (int i = tid; i < 64 * 1024 / 8; i += NTHR) {
    u32x4 z = {0u, 0u, 0u, 0u};
    *(u32x4*)(B.wt_od_() + (size_t)3392 * 1024 + i * 8) = z;
  }
}

struct RowInfo { int b, pos, mi; bool lat; };
DI RowInfo row_info(int r) {
  RowInfo ri;
  ri.b = r / LT; ri.pos = r - ri.b * LT; ri.lat = ri.pos >= CTX; ri.mi = ri.lat ? ri.b : 8;
  return ri;
}
DI size_t resid_off(const RowInfo& ri) {
  return ri.lat ? ((size_t)ri.b * SEQ + (ri.pos - CTX)) * 1024 : ((size_t)ri.b * CTX + ri.pos) * 1024;
}

DI void norm_mod_row(const float* __restrict__ x, const float* __restrict__ g, const float* __restrict__ sh,
                     const float* __restrict__ sc, u16* __restrict__ hrow, int lane) {
  float4 v[4];
  float ss = 0.f;
#pragma unroll
  for (int i = 0; i < 4; ++i) {
    v[i] = *(const float4*)(x + i * 256 + lane * 4);
    ss += v[i].x * v[i].x + v[i].y * v[i].y + v[i].z * v[i].z + v[i].w * v[i].w;
  }
  ss = wave_sum(ss);
  const float rstd = rsqrtf(ss * (1.f / 1024.f) + EPS);
#pragma unroll
  for (int i = 0; i < 4; ++i) {
    int c = i * 256 + lane * 4;
    float4 gg = *(const float4*)(g + c), s1 = *(const float4*)(sh + c), s2 = *(const float4*)(sc + c);
    u32x2 o;
    o[0] = pk2(v[i].x * rstd * gg.x * (1.f + s2.x) + s1.x, v[i].y * rstd * gg.y * (1.f + s2.y) + s1.y);
    o[1] = pk2(v[i].z * rstd * gg.z * (1.f + s2.z) + s1.z, v[i].w * rstd * gg.w * (1.f + s2.w) + s1.w);
    *(u32x2*)(hrow + c) = o;
  }
}

template <bool NEXT>
DI void resid_row(const u16* __restrict__ y, const float* xs, float* xd, const float* __restrict__ gate,
                  const float* __restrict__ ny, const float* __restrict__ nx, const float* __restrict__ sh,
                  const float* __restrict__ sc, u16* __restrict__ hrow, int lane) {
  float4 v[4];
  float ss = 0.f;
#pragma unroll
  for (int i = 0; i < 4; ++i) {
    u32x2 yy = *(const u32x2*)(y + i * 256 + lane * 4);
    v[i].x = bflo(yy[0]); v[i].y = bfhi(yy[0]); v[i].z = bflo(yy[1]); v[i].w = bfhi(yy[1]);
    ss += v[i].x * v[i].x + v[i].y * v[i].y + v[i].z * v[i].z + v[i].w * v[i].w;
  }
  ss = wave_sum(ss);
  const float rstd = rsqrtf(ss * (1.f / 1024.f) + EPS);
  float ss2 = 0.f;
#pragma unroll
  for (int i = 0; i < 4; ++i) {
    int c = i * 256 + lane * 4;
    float4 xv = *(const float4*)(xs + c), gt = *(const float4*)(gate + c), nn = *(const float4*)(ny + c);
    float4 o;
    o.x = xv.x + gt.x * (v[i].x * rstd * nn.x); o.y = xv.y + gt.y * (v[i].y * rstd * nn.y);
    o.z = xv.z + gt.z * (v[i].z * rstd * nn.z); o.w = xv.w + gt.w * (v[i].w * rstd * nn.w);
    *(float4*)(xd + c) = o;
    v[i] = o;
    ss2 += o.x * o.x + o.y * o.y + o.z * o.z + o.w * o.w;
  }
  if (NEXT) {
    ss2 = wave_sum(ss2);
    const float rstd2 = rsqrtf(ss2 * (1.f / 1024.f) + EPS);
#pragma unroll
    for (int i = 0; i < 4; ++i) {
      int c = i * 256 + lane * 4;
      float4 gg = *(const float4*)(nx + c), s1 = *(const float4*)(sh + c), s2 = *(const float4*)(sc + c);
      u32x2 o;
      o[0] = pk2(v[i].x * rstd2 * gg.x * (1.f + s2.x) + s1.x, v[i].y * rstd2 * gg.y * (1.f + s2.y) + s1.y);
      o[1] = pk2(v[i].z * rstd2 * gg.z * (1.f + s2.z) + s1.z, v[i].w * rstd2 * gg.w * (1.f + s2.w) + s1.w);
      *(u32x2*)(hrow + c) = o;
    }
  }
}

enum { EPI_F32 = 0, EPI_IN0, EPI_IN1, EPI_FFN1, EPI_UQ, EPI_UKV, EPI_POOL };

struct EpiArgs {
  float* outf;
  int layer;
  int seg_lo, seg_hi;
  int aux;
};

DI void mma_ktile(const u16* As, const u16* Bs, f32x16 (&acc)[2][2], int wm, int wn, int r, int h) {
  __builtin_amdgcn_s_setprio(1);
#pragma unroll
  for (int ks = 0; ks < 4; ++ks) {
    bf16x8 a[2], b[2];
#pragma unroll
    for (int i = 0; i < 2; ++i) a[i] = *(const bf16x8*)(As + (wm * 64 + i * 32 + r) * LDT + ks * 16 + h * 8);
#pragma unroll
    for (int j = 0; j < 2; ++j) b[j] = *(const bf16x8*)(Bs + (wn * 64 + j * 32 + r) * LDT + ks * 16 + h * 8);
#pragma unroll
    for (int i = 0; i < 2; ++i)
#pragma unroll
      for (int j = 0; j < 2; ++j) acc[i][j] = MFMA32(a[i], b[j], acc[i][j]);
  }
  __builtin_amdgcn_s_setprio(0);
}

DI void acc_to_lds(float* Ct, f32x16 (&acc)[2][2], int wm, int wn, int r, int h) {
#pragma unroll
  for (int i = 0; i < 2; ++i)
#pragma unroll
    for (int j = 0; j < 2; ++j)
#pragma unroll
      for (int g = 0; g < 16; ++g)
        Ct[(wm * 64 + i * 32 + crow(g, h)) * CLD + wn * 64 + j * 32 + r] = acc[i][j][g];
}

DI void rope8(float* v, const float* Ct_row, int cc8, int d, int n, const Bufs& B) {
  const int axis = d >> 5, pa = axis ? (n & 63) : (n >> 6), f0 = d & 15;
  const bool first = (d & 16) == 0;
  const int pc = first ? cc8 + 16 : cc8 - 16;
  const float4 c0 = *(const float4*)(B.ropec_() + pa * 16 + f0), c1 = *(const float4*)(B.ropec_() + pa * 16 + f0 + 4);
  const float4 s0 = *(const float4*)(B.ropes_() + pa * 16 + f0), s1 = *(const float4*)(B.ropes_() + pa * 16 + f0 + 4);
  const float4 x0 = *(const float4*)(Ct_row + pc), x1 = *(const float4*)(Ct_row + pc + 4);
  const float cs[8] = {c0.x, c0.y, c0.z, c0.w, c1.x, c1.y, c1.z, c1.w};
  const float sn[8] = {s0.x, s0.y, s0.z, s0.w, s1.x, s1.y, s1.z, s1.w};
  const float xp[8] = {x0.x, x0.y, x0.z, x0.w, x1.x, x1.y, x1.z, x1.w};
#pragma unroll
  for (int e = 0; e < 8; ++e) v[e] = first ? v[e] * cs[e] - xp[e] * sn[e] : v[e] * cs[e] + xp[e] * sn[e];
}

DI void ld8(float* v, const float* src) {
  const float4 a = *(const float4*)src, b = *(const float4*)(src + 4);
  v[0] = a.x; v[1] = a.y; v[2] = a.z; v[3] = a.w; v[4] = b.x; v[5] = b.y; v[6] = b.z; v[7] = b.w;
}

template <int EPI>
DI void epilogue(const Params& p, const Bufs& B, const float* Ct, const float* rowss, int rowbase, int n0,
                 const EpiArgs& ea) {
  const int tid = otid();
  if (EPI == EPI_F32) {
#pragma unroll 1
    for (int it = 0; it < 8; ++it) {
      int id = it * 256 + tid, i = id >> 4, cc = id & 15;
      float v[8];
      ld8(v, Ct + i * CLD + cc * 8);
      *(u32x4*)((u16*)ea.outf + (size_t)(rowbase + i) * 1024 + n0 + cc * 8) = pack8(v);
    }
  } else if (EPI == EPI_POOL) {
#pragma unroll 1
    for (int it = 0; it < 8; ++it) {
      int id = it * 256 + tid, i = id >> 4, cc = id & 15;
      float v[8];
#pragma unroll
      for (int e = 0; e < 8; ++e) v[e] = Ct[i * CLD + cc * 8 + e] * p.in[15][ea.aux * 128 + cc * 8 + e];
      *(u32x4*)(B.MIX0_() + (size_t)(rowbase + i) * 1024 + ea.aux * 128 + cc * 8) = pack8(v);
    }
  } else if (EPI == EPI_IN0) {
    const int seg = n0 >> 9, b = rowbase / LT, pos0 = rowbase - b * LT;
    if (seg == 3) {
#pragma unroll 1
      for (int it = 0; it < 8; ++it) {
        int id = it * 256 + tid, c = id & 127, rc = id >> 7;
        float v[8];
#pragma unroll
        for (int e = 0; e < 8; ++e) v[e] = Ct[(rc * 8 + e) * CLD + c];
        int hc = n0 - 1536 + c, vh = hc >> 7, dv = hc & 127;
        *(u32x4*)(B.VT0_() + ((size_t)(b * 4 + vh) * 128 + dv) * LT + pos0 + rc * 8) = pack8(v);
      }
    } else {
#pragma unroll 1
      for (int it = 0; it < 8; ++it) {
        int id = it * 256 + tid, i = id >> 4, cc = id & 15;
        float v[8];
        ld8(v, Ct + i * CLD + cc * 8);
        if (seg == 0) {
          *(u32x4*)(B.U_() + (size_t)(rowbase + i) * 512 + n0 + cc * 8) = pack8(v);
        } else {
          int hc = n0 - 512 * seg + cc * 8, head = hc >> 6, d = hc & 63, pos = pos0 + i;
          if (pos >= CTX) rope8(v, Ct + i * CLD, cc * 8, d, pos - CTX, B);
          if (seg == 1) {
#pragma unroll
            for (int e = 0; e < 8; ++e) v[e] *= QS_DIFF;
          }
          u16* dst = (seg == 1 ? B.Q0_() : B.K0_()) + ((size_t)(b * 8 + head) * LT + pos) * 64 + d;
          *(u32x4*)dst = pack8(v);
        }
      }
    }
  } else if (EPI == EPI_IN1) {
    const int b = rowbase / LT, pos0 = rowbase - b * LT;
#pragma unroll 1
    for (int it = 0; it < 8; ++it) {
      int id = it * 256 + tid, i = id >> 4, cc = id & 15;
      int gc = n0 + cc * 8, pos = pos0 + i;
      size_t grow = (size_t)(rowbase + i);
      float v[8];
      ld8(v, Ct + i * CLD + cc * 8);
      if (gc < 512) {
        *(u32x4*)(B.CQ_() + grow * 512 + gc) = pack8(v);
      } else if (gc < 768) {
        *(u32x4*)(B.CKV_() + grow * 256 + (gc - 512)) = pack8(v);
      } else if (gc < 832) {
        int d = gc - 768;
        if (pos >= CTX) rope8(v, Ct + i * CLD, cc * 8, d, pos - CTX, B);
        u32x4 o = pack8(v);
#pragma unroll
        for (int hh = 0; hh < 4; ++hh) *(u32x4*)(B.KF_() + ((size_t)(b * 4 + hh) * LT + pos) * 192 + 128 + d) = o;
      } else if (gc < 1344) {
#pragma unroll
        for (int e = 0; e < 8; ++e) v[e] = siluf(v[e]);
        *(u32x4*)(B.HQ_() + grow * 512 + (gc - 832)) = pack8(v);
      } else if (gc < 2368) {
        int dir = gc >= 1856, ch = gc - (dir ? 1856 : 1344);
        u32x4 o;
        float lf[8];
        float lb8[8];
        ld8(lb8, B.lb_() + dir * 512 + ch);
#pragma unroll
        for (int e = 0; e < 8; ++e) {
          float lbv = lb8[e];
          float f = lbv + (1.f - lbv) / (1.f + __expf(-v[e]));
          lf[e] = logf(f);
        }
#pragma unroll
        for (int q = 0; q < 4; ++q) o[q] = (unsigned)f2h(lf[2 * q]) | ((unsigned)f2h(lf[2 * q + 1]) << 16);
        *(u32x4*)(B.LF_() + (size_t)dir * M * 512 + grow * 512 + ch) = o;
      } else if (gc < 2880) {
        *(u32x4*)(B.HI_() + grow * 512 + (gc - 2368)) = pack8(v);
      } else if (gc < 3392) {
        *(u32x4*)(B.HG_() + grow * 512 + (gc - 2880)) = pack8(v);
      }
    }
  } else if (EPI == EPI_UQ) {
    const int b = rowbase / LT, nl0 = rowbase - b * LT - CTX;
#pragma unroll 1
    for (int it = 0; it < 8; ++it) {
      int id = it * 256 + tid, i = id >> 4, cc = id & 15;
      int gc = n0 + cc * 8, head = gc / 192, dd = gc - head * 192, n = nl0 + i;
      float v[8];
      ld8(v, Ct + i * CLD + cc * 8);
      if (dd >= 128) rope8(v, Ct + i * CLD, cc * 8, dd - 128, n, B);
      const float s = rsqrtf(rowss[i] * (1.f / 512.f) + EPS) * QS_MLA;
#pragma unroll
      for (int e = 0; e < 8; ++e) v[e] *= s;
      *(u32x4*)(B.QF_() + ((size_t)(b * 4 + head) * SEQ + n) * 192 + dd) = pack8(v);
    }
  } else if (EPI == EPI_UKV) {
    const int b = rowbase / LT, pos0 = rowbase - b * LT, head = n0 >> 8;
    if ((n0 & 128) == 0) {
#pragma unroll 1
      for (int it = 0; it < 8; ++it) {
        int id = it * 256 + tid, i = id >> 4, cc = id & 15;
        const float s = rsqrtf(rowss[i] * (1.f / 256.f) + EPS);
        float v[8];
#pragma unroll
        for (int e = 0; e < 8; ++e) v[e] = Ct[i * CLD + cc * 8 + e] * s;
        *(u32x4*)(B.KF_() + ((size_t)(b * 4 + head) * LT + pos0 + i) * 192 + cc * 8) = pack8(v);
      }
    } else {
#pragma unroll 1
      for (int it = 0; it < 8; ++it) {
        int id = it * 256 + tid, c = id & 127, rc = id >> 7;
        float v[8];
#pragma unroll
        for (int e = 0; e < 8; ++e)
          v[e] = Ct[(rc * 8 + e) * CLD + c] * rsqrtf(rowss[rc * 8 + e] * (1.f / 256.f) + EPS);
        *(u32x4*)(B.VT1_() + ((size_t)(b * 4 + head) * 128 + c) * LT + pos0 + rc * 8) = pack8(v);
      }
    }
  } else if (EPI == EPI_FFN1) {
    const int nt = n0 >> 7;
    const float* cw = p.in[10] + (size_t)ea.layer * 3 * DFF;
    const float* cb = p.in[11] + (size_t)ea.layer * DFF;
    u16* G = ea.layer ? B.G1_() : B.G0_();
#pragma unroll 1
    for (int it = 0; it < 4; ++it) {
      int id = it * 256 + tid, i = id >> 3, cc = id & 7;
      int grow = rowbase + i;
      if (i >= 1 && i <= 126 && grow < ea.seg_hi) {
        const bool hp = (grow - 1 >= ea.seg_lo), hn = (grow + 1 < ea.seg_hi);
        float a[8], ap[8], an[8], u[8], w0[8], w1[8], w2[8], bb[8], v[8];
        const int fc0 = nt * 64 + cc * 8;
        ld8(a, Ct + i * CLD + cc * 8); ld8(ap, Ct + (i - 1) * CLD + cc * 8); ld8(an, Ct + (i + 1) * CLD + cc * 8);
        ld8(u, Ct + i * CLD + 64 + cc * 8);
        ld8(w0, cw + fc0); ld8(w1, cw + DFF + fc0); ld8(w2, cw + 2 * DFF + fc0); ld8(bb, cb + fc0);
#pragma unroll
        for (int e = 0; e < 8; ++e) {
          float av = (hp ? ap[e] : 0.f) * w0[e] + a[e] * w1[e] + (hn ? an[e] : 0.f) * w2[e] + bb[e];
          v[e] = siluf(av) * u[e];
        }
        *(u32x4*)(G + (size_t)grow * DFF + nt * 64 + cc * 8) = pack8(v);
      }
    }
  }
}

template <int EPI, bool SUMSQ>
DI void gemm_tile(char* smem, const Params& p, const Bufs& B, const u16* __restrict__ A, int lda, int rowbase,
                  int rlo, int rhi, const u16* __restrict__ Bt, int K, int n0, const EpiArgs& ea) {
  u16* As = (u16*)smem;
  u16* Bs = As + 2 * 128 * LDT;
  float* Ct = (float*)smem;
  float* rowss = Ct + 128 * CLD;
  const int tid = otid(), lane = tid & 63, wid = tid >> 6, wm = wid >> 1, wn = wid & 1, r = lane & 31,
            h = lane >> 5;
  const int lrow = tid >> 3, lkc = tid & 7;
  int aoff[4], boff[4];
#pragma unroll
  for (int it = 0; it < 4; ++it) {
    int gr = rowbase + it * 32 + lrow;
    gr = gr < rlo ? rlo : (gr > rhi - 1 ? rhi - 1 : gr);
    aoff[it] = gr * lda + lkc * 8;
    boff[it] = (n0 + it * 32 + lrow) * K + lkc * 8;
  }
  u32x4 ra0[4], rb0[4], ra1[4], rb1[4];
  float ssq[4] = {0.f, 0.f, 0.f, 0.f};
  f32x16 acc[2][2];
#pragma unroll
  for (int i = 0; i < 2; ++i)
#pragma unroll
    for (int j = 0; j < 2; ++j)
#pragma unroll
      for (int g = 0; g < 16; ++g) acc[i][j][g] = 0.f;
  const int nk = K >> 6;
#pragma unroll
  for (int it = 0; it < 4; ++it) {
    ra0[it] = *(const u32x4*)(A + aoff[it]);
    rb0[it] = *(const u32x4*)(Bt + boff[it]);
  }
#pragma unroll
  for (int it = 0; it < 4; ++it) {
    ra1[it] = *(const u32x4*)(A + aoff[it] + 64);
    rb1[it] = *(const u32x4*)(Bt + boff[it] + 64);
  }
#define GEMM_STEP(RA, RB, BUF, TNEXT)                                                  \
  {                                                                                    \
    u16* Aw = As + (BUF) * 128 * LDT;                                                  \
    u16* Bw = Bs + (BUF) * 128 * LDT;                                                  \
    _Pragma("unroll") for (int it = 0; it < 4; ++it) {                                 \
      *(u32x4*)(Aw + (it * 32 + lrow) * LDT + lkc * 8) = RA[it];                       \
      *(u32x4*)(Bw + (it * 32 + lrow) * LDT + lkc * 8) = RB[it];                       \
      if (SUMSQ) {                                                                     \
        _Pragma("unroll") for (int q = 0; q < 4; ++q) {                                \
          float lo = bflo(RA[it][q]), hi = bfhi(RA[it][q]);                            \
          ssq[it] += lo * lo + hi * hi;                                                \
        }                                                                              \
      }                                                                                \
    }                                                                                  \
    __syncthreads();                                                                   \
    if ((TNEXT) < nk) {                                                                \
      _Pragma("unroll") for (int it = 0; it < 4; ++it) {                               \
        RA[it] = *(const u32x4*)(A + aoff[it] + (TNEXT) * 64);                         \
        RB[it] = *(const u32x4*)(Bt + boff[it] + (TNEXT) * 64);                        \
      }                                                                                \
    }                                                                                  \
    mma_ktile(Aw, Bw, acc, wm, wn, r, h);                                              \
  }
  for (int t = 0; t < nk; t += 2) {
    GEMM_STEP(ra0, rb0, 0, t + 2)
    GEMM_STEP(ra1, rb1, 1, t + 3)
  }
#undef GEMM_STEP
  __syncthreads();
  acc_to_lds(Ct, acc, wm, wn, r, h);
  if (SUMSQ) {
#pragma unroll
    for (int it = 0; it < 4; ++it) {
      float s = ssq[it];
      s += __shfl_xor(s, 1); s += __shfl_xor(s, 2); s += __shfl_xor(s, 4);
      if (lkc == 0) rowss[it * 32 + lrow] = s;
    }
  }
  __syncthreads();
  epilogue<EPI>(p, B, Ct, rowss, rowbase, n0, ea);
  __syncthreads();
}

DI void pool_tile(char* smem, const Params& p, const Bufs& B, int rt, int g) {
  u16* As = (u16*)smem;
  u16* Bs = As + 2 * 128 * LDT;
  float* Ct = (float*)smem;
  const int tid = otid(), lane = tid & 63, wid = tid >> 6, wm = wid >> 1, wn = wid & 1, r = lane & 31,
            h = lane >> 5;
  const int rowbase = rt * 128;
  const int b = rowbase / LT, pos0 = rowbase - b * LT;
  const int seg_lo = (pos0 < CTX) ? b * LT : b * LT + CTX;
  const int seg_hi = (pos0 < CTX) ? b * LT + CTX : (b + 1) * LT;
  u16* Ust = Bs;
#pragma unroll 1
  for (int it = 0; it < 9; ++it) {
    int c = it * 256 + tid, rr = c >> 4, kc = c & 15;
    int grow = rowbase - 8 + rr;
    if (grow >= seg_lo && grow < seg_hi)
      *(u32x4*)(Ust + rr * 128 + kc * 8) = *(const u32x4*)(B.U_() + (size_t)grow * 512 + g * 128 + kc * 8);
  }
  __syncthreads();
  {
    const int ch = tid & 127, rh = tid >> 7, hw = 1 << g;
    const u16* Uc = Ust + ch;
    const int bl = 8 - rowbase;
    const int t0 = rowbase + rh * 64;
    int lo = max(t0 - hw, seg_lo), hi = min(t0 + hw, seg_hi);
    float sum = 0.f;
    for (int s2 = lo; s2 < hi; ++s2) sum += bf2f(Uc[(s2 + bl) * 128]);
    u16* Ad = As + (ch >> 6) * 128 * LDT + (ch & 63);
    for (int i = 0; i < 64; ++i) {
      int t = t0 + i;
      float cnt = (float)(hi - lo);
      float d = sum / cnt - bf2f(Uc[(t + bl) * 128]);
      Ad[(rh * 64 + i) * LDT] = f2bf(d);
      if (t + hw < seg_hi) { sum += bf2f(Uc[(t + hw + bl) * 128]); hi = t + hw + 1; }
      if (t - hw >= seg_lo) { sum -= bf2f(Uc[(t - hw + bl) * 128]); lo = t - hw + 1; }
    }
  }
  __syncthreads();
#pragma unroll
  for (int it = 0; it < 8; ++it) {
    int c = it * 256 + tid, n = c >> 4, kc = c & 15;
    u32x4 v = *(const u32x4*)(B.wt_pool_() + (size_t)g * 128 * 128 + n * 128 + kc * 8);
    *(u32x4*)(Bs + (kc >> 3) * 128 * LDT + n * LDT + (kc & 7) * 8) = v;
  }
  __syncthreads();
  f32x16 acc[2][2];
#pragma unroll
  for (int i = 0; i < 2; ++i)
#pragma unroll
    for (int j = 0; j < 2; ++j)
#pragma unroll
      for (int q = 0; q < 16; ++q) acc[i][j][q] = 0.f;
  mma_ktile(As, Bs, acc, wm, wn, r, h);
  mma_ktile(As + 128 * LDT, Bs + 128 * LDT, acc, wm, wn, r, h);
  __syncthreads();
  acc_to_lds(Ct, acc, wm, wn, r, h);
  __syncthreads();
  EpiArgs ea{}; ea.aux = g;
  epilogue<EPI_POOL>(p, B, Ct, nullptr, rowbase, 0, ea);
  __syncthreads();
}

template <int DQK, int KT>
DI void attn_pass_sb(char* smem, const u16* __restrict__ Qg, const u16* __restrict__ Kg, const u16* __restrict__ VTg,
                  int nk, f32x16 (&O)[4], float& l_out) {
  constexpr int KLD = DQK + 8, NKS = DQK / 16, KCH = DQK / 8, KPT = KT * KCH / 256, VLD = KT + 8, VPT = KT / 16,
                KB = KT / 32, VCH = KT / 8;
  u16* Ks = (u16*)smem;
  u16* Vs = Ks + KT * KLD;
  const int tid = otid(), lane = tid & 63, wid = tid >> 6, r = lane & 31, h = lane >> 5;
  bf16x8 qf[NKS];
#pragma unroll
  for (int ks = 0; ks < NKS; ++ks) qf[ks] = *(const bf16x8*)(Qg + (size_t)(wid * 32 + r) * DQK + ks * 16 + h * 8);
  u32x4 rk[KPT], rv[VPT];
#pragma unroll
  for (int dvb = 0; dvb < 4; ++dvb)
#pragma unroll
    for (int g = 0; g < 16; ++g) O[dvb][g] = 0.f;
  float m = -1e30f, l = 0.f;
  const int nt = nk / KT;
  int kgo[KPT], klo[KPT], vgo[VPT], vlo[VPT];
#pragma unroll
  for (int it = 0; it < KPT; ++it) {
    int c = it * 256 + tid, key = c / KCH, kc = c - key * KCH;
    int rho = (key & ~12) | ((key & 4) << 1) | ((key & 8) >> 1);
    kgo[it] = key * DQK + kc * 8;
    klo[it] = rho * KLD + kc * 8;
  }
#pragma unroll
  for (int it = 0; it < VPT; ++it) {
    int c = it * 256 + tid, dv = c / VCH, kc = c - dv * VCH;
    vgo[it] = dv * LT + kc * 8;
    vlo[it] = dv * VLD + kc * 8;
  }
#pragma unroll
  for (int it = 0; it < KPT; ++it) rk[it] = *(const u32x4*)(Kg + kgo[it]);
#pragma unroll
  for (int it = 0; it < VPT; ++it) rv[it] = *(const u32x4*)(VTg + vgo[it]);
  for (int t = 0; t < nt; ++t) {
    __syncthreads();
#pragma unroll
    for (int it = 0; it < KPT; ++it) *(u32x4*)(Ks + klo[it]) = rk[it];
#pragma unroll
    for (int it = 0; it < VPT; ++it) *(u32x4*)(Vs + vlo[it]) = rv[it];
    __syncthreads();
    if (t + 1 < nt) {
      const u16* Kn = Kg + (size_t)(t + 1) * KT * DQK;
      const u16* Vn = VTg + (t + 1) * KT;
#pragma unroll
      for (int it = 0; it < KPT; ++it) rk[it] = *(const u32x4*)(Kn + kgo[it]);
#pragma unroll
      for (int it = 0; it < VPT; ++it) rv[it] = *(const u32x4*)(Vn + vgo[it]);
    }
    f32x16 S[KB];
#pragma unroll
    for (int kb = 0; kb < KB; ++kb) {
#pragma unroll
      for (int g = 0; g < 16; ++g) S[kb][g] = 0.f;
#pragma unroll
      for (int ks = 0; ks < NKS; ++ks) {
        bf16x8 a = *(const bf16x8*)(Ks + (kb * 32 + r) * KLD + ks * 16 + h * 8);
        S[kb] = MFMA32(a, qf[ks], S[kb]);
      }
    }
    float mx = -1e30f;
#pragma unroll
    for (int kb = 0; kb < KB; ++kb)
#pragma unroll
      for (int g = 0; g < 16; ++g) mx = fmaxf(mx, S[kb][g]);
    mx = fmaxf(mx, __shfl_xor(mx, 32));
    const float mn = fmaxf(m, mx);
    const float alpha = __builtin_amdgcn_exp2f(m - mn);
    const bool chg = __any(mn > m);
    m = mn;
    float ps = 0.f;
#pragma unroll
    for (int kb = 0; kb < KB; ++kb)
#pragma unroll
      for (int g = 0; g < 16; ++g) {
        float pv = __builtin_amdgcn_exp2f(S[kb][g] - mn);
        S[kb][g] = pv;
        ps += pv;
      }
    l = l * alpha + ps;
    if (chg) {
#pragma unroll
      for (int dvb = 0; dvb < 4; ++dvb)
#pragma unroll
        for (int g = 0; g < 16; ++g) O[dvb][g] *= alpha;
    }
    bf16x8 pf[KB][2];
#pragma unroll
    for (int kb = 0; kb < KB; ++kb)
#pragma unroll
      for (int s = 0; s < 2; ++s) {
        u32x4 o;
#pragma unroll
        for (int q = 0; q < 4; ++q) o[q] = pk2(S[kb][8 * s + 2 * q], S[kb][8 * s + 2 * q + 1]);
        pf[kb][s] = __builtin_bit_cast(bf16x8, o);
      }
#pragma unroll
    for (int dvb = 0; dvb < 4; ++dvb) {
#pragma unroll
      for (int kb = 0; kb < KB; ++kb)
#pragma unroll
        for (int s = 0; s < 2; ++s) {
          bf16x8 a = *(const bf16x8*)(Vs + (dvb * 32 + r) * VLD + kb * 32 + s * 16 + h * 8);
          O[dvb] = MFMA32(a, pf[kb][s], O[dvb]);
        }
      if (dvb & 1) asm volatile("" ::: "memory");
    }
  }
  l_out = l + __shfl_xor(l, 32);
}

template <int DQK, int KT>
DI void attn_pass(char* smem, const u16* __restrict__ Qg, const u16* __restrict__ Kg, const u16* __restrict__ VTg,
                  int nk, f32x16 (&O)[4], float& l_out) {
  constexpr int KLD = DQK + 8, NKS = DQK / 16, KCH = DQK / 8, KPT = KT * KCH / 256, VLD = KT + 8, VPT = KT / 16,
                KB = KT / 32, VCH = KT / 8, STAGE = KT * KLD + 128 * VLD;
  u16* base = (u16*)smem;
  const int tid = otid(), lane = tid & 63, wid = tid >> 6, r = lane & 31, h = lane >> 5;
  bf16x8 qf[NKS];
#pragma unroll
  for (int ks = 0; ks < NKS; ++ks) qf[ks] = *(const bf16x8*)(Qg + (size_t)(wid * 32 + r) * DQK + ks * 16 + h * 8);
  u32x4 rk[KPT], rv[VPT];
#pragma unroll
  for (int dvb = 0; dvb < 4; ++dvb)
#pragma unroll
    for (int g = 0; g < 16; ++g) O[dvb][g] = 0.f;
  float m = -1e30f, l = 0.f;
  const int nt = nk / KT;
#define KGO(it, T) ({ int c_ = (it) * 256 + (T), key_ = c_ / KCH; key_ * DQK + (c_ - key_ * KCH) * 8; })
#define KLO(it, T) ({ int c_ = (it) * 256 + (T), key_ = c_ / KCH, kc_ = c_ - key_ * KCH; \
                      int rho_ = (key_ & ~12) | ((key_ & 4) << 1) | ((key_ & 8) >> 1); rho_ * KLD + kc_ * 8; })
#define VGO(it, T) ({ int c_ = (it) * 256 + (T), dv_ = c_ / VCH; dv_ * LT + (c_ - dv_ * VCH) * 8; })
#define VLO(it, T) ({ int c_ = (it) * 256 + (T), dv_ = c_ / VCH; KT * KLD + dv_ * VLD + (c_ - dv_ * VCH) * 8; })
  { const int tq = otid();
#pragma unroll
  for (int it = 0; it < KPT; ++it) rk[it] = *(const u32x4*)(Kg + KGO(it, tq));
#pragma unroll
  for (int it = 0; it < VPT; ++it) rv[it] = *(const u32x4*)(VTg + VGO(it, tq));
  __syncthreads();
#pragma unroll
  for (int it = 0; it < KPT; ++it) *(u32x4*)(base + KLO(it, tq)) = rk[it];
#pragma unroll
  for (int it = 0; it < VPT; ++it) *(u32x4*)(base + VLO(it, tq)) = rv[it];
  if (nt > 1) {
#pragma unroll
    for (int it = 0; it < KPT; ++it) rk[it] = *(const u32x4*)(Kg + (size_t)KT * DQK + KGO(it, tq));
#pragma unroll
    for (int it = 0; it < VPT; ++it) rv[it] = *(const u32x4*)(VTg + KT + VGO(it, tq));
  }
  }
  __syncthreads();
  for (int t = 0; t < nt; ++t) {
    const u16* Ks = base + (t & 1) * STAGE;
    const u16* Vs = Ks + KT * KLD;
    f32x16 S[KB];
#pragma unroll
    for (int kb = 0; kb < KB; ++kb) {
#pragma unroll
      for (int g = 0; g < 16; ++g) S[kb][g] = 0.f;
#pragma unroll
      for (int ks = 0; ks < NKS; ++ks) {
        bf16x8 a = *(const bf16x8*)(Ks + (kb * 32 + r) * KLD + ks * 16 + h * 8);
        S[kb] = MFMA32(a, qf[ks], S[kb]);
      }
    }
    if (t + 1 < nt) {
      const int tq = otid();
      u16* nb_ = base + ((t + 1) & 1) * STAGE;
#pragma unroll
      for (int it = 0; it < KPT; ++it) *(u32x4*)(nb_ + KLO(it, tq)) = rk[it];
#pragma unroll
      for (int it = 0; it < VPT; ++it) *(u32x4*)(nb_ + VLO(it, tq)) = rv[it];
      if (t + 2 < nt) {
        const u16* Kn = Kg + (size_t)(t + 2) * KT * DQK;
        const u16* Vn = VTg + (t + 2) * KT;
#pragma unroll
        for (int it = 0; it < KPT; ++it) rk[it] = *(const u32x4*)(Kn + KGO(it, tq));
#pragma unroll
        for (int it = 0; it < VPT; ++it) rv[it] = *(const u32x4*)(Vn + VGO(it, tq));
      }
    }
    float mx = -1e30f;
#pragma unroll
    for (int kb = 0; kb < KB; ++kb)
#pragma unroll
      for (int g = 0; g < 16; ++g) mx = fmaxf(mx, S[kb][g]);
    mx = fmaxf(mx, __shfl_xor(mx, 32));
    const float mn = fmaxf(m, mx);
    const float alpha = __builtin_amdgcn_exp2f(m - mn);
    const bool chg = __any(mn > m);
    m = mn;
    float ps = 0.f;
#pragma unroll
    for (int kb = 0; kb < KB; ++kb)
#pragma unroll
      for (int g = 0; g < 16; ++g) {
        float pv = __builtin_amdgcn_exp2f(S[kb][g] - mn);
        S[kb][g] = pv;
        ps += pv;
      }
    l = l * alpha + ps;
    if (chg) {
#pragma unroll
      for (int dvb = 0; dvb < 4; ++dvb)
#pragma unroll
        for (int g = 0; g < 16; ++g) O[dvb][g] *= alpha;
    }
    bf16x8 pf[KB][2];
#pragma unroll
    for (int kb = 0; kb < KB; ++kb)
#pragma unroll
      for (int s = 0; s < 2; ++s) {
        u32x4 o;
#pragma unroll
        for (int q = 0; q < 4; ++q) o[q] = pk2(S[kb][8 * s + 2 * q], S[kb][8 * s + 2 * q + 1]);
        pf[kb][s] = __builtin_bit_cast(bf16x8, o);
      }
#pragma unroll
    for (int dvb = 0; dvb < 4; ++dvb) {
#pragma unroll
      for (int kb = 0; kb < KB; ++kb)
#pragma unroll
        for (int s = 0; s < 2; ++s) {
          bf16x8 a = *(const bf16x8*)(Vs + (dvb * 32 + r) * VLD + kb * 32 + s * 16 + h * 8);
          O[dvb] = MFMA32(a, pf[kb][s], O[dvb]);
        }
    }
    __syncthreads();
  }
  l_out = l + __shfl_xor(l, 32);
#undef KGO
#undef KLO
#undef VGO
#undef VLO
}

DI void diff_attn_item(char* smem, const Params& p, const Bufs& B, int b, int vh, int pos0, int nk) {
  const int tid = otid(), lane = tid & 63, wid = tid >> 6, r = lane & 31, h = lane >> 5;
  f32x16 O[4];
  unsigned* Okl = (unsigned*)(smem + 40960);
  const float lam = B.lam_()[0];
  const u16* VT = B.VT0_() + (size_t)(b * 4 + vh) * 128 * LT;
  float ss = 0.f;
#pragma unroll
  for (int e = 0; e < 2; ++e) {
    const int head = 2 * vh + e;
    const u16* Q = B.Q0_() + ((size_t)(b * 8 + head) * LT + pos0) * 64;
    const u16* K = B.K0_() + (size_t)(b * 8 + head) * LT * 64;
    float l;
    attn_pass_sb<64, 64>(smem, Q, K, VT, nk, O, l);
    const float inv = 1.f / l;
    if (e == 0) {
#pragma unroll
      for (int dvb = 0; dvb < 4; ++dvb)
#pragma unroll
        for (int q = 0; q < 8; ++q) Okl[(dvb * 8 + q) * 256 + tid] = pk2(O[dvb][2 * q] * inv, O[dvb][2 * q + 1] * inv);
    } else {
#pragma unroll
      for (int dvb = 0; dvb < 4; ++dvb)
#pragma unroll
        for (int q = 0; q < 8; ++q) {
          unsigned o0 = Okl[(dvb * 8 + q) * 256 + tid];
          float a0 = bflo(o0) - lam * (O[dvb][2 * q] * inv), a1 = bfhi(o0) - lam * (O[dvb][2 * q + 1] * inv);
          O[dvb][2 * q] = a0; O[dvb][2 * q + 1] = a1;
          ss += a0 * a0 + a1 * a1;
        }
    }
  }
  ss += __shfl_xor(ss, 32);
  const float rstd = rsqrtf(ss * (1.f / 128.f) + EPS) * 0.8f;
  const float* sub = p.in[17];
  u16* orow = B.MIX0_() + (size_t)(b * LT + pos0 + wid * 32 + r) * 1024 + 512 + vh * 128;
#pragma unroll
  for (int dvb = 0; dvb < 4; ++dvb)
#pragma unroll
    for (int g = 0; g < 4; ++g) {
      int dv0 = dvb * 32 + 8 * g + 4 * h;
      u32x2 o;
      o[0] = pk2(O[dvb][4 * g] * rstd * sub[dv0], O[dvb][4 * g + 1] * rstd * sub[dv0 + 1]);
      o[1] = pk2(O[dvb][4 * g + 2] * rstd * sub[dv0 + 2], O[dvb][4 * g + 3] * rstd * sub[dv0 + 3]);
      *(u32x2*)(orow + dv0) = o;
    }
}

DI void mla_attn_item(char* smem, const Bufs& B, int b, int hd, int qt) {
  const int lane = otid() & 63, wid = otid() >> 6, r = lane & 31, h = lane >> 5;
  f32x16 O[4];
  float l;
  const u16* Q = B.QF_() + ((size_t)(b * 4 + hd) * SEQ + qt * 128) * 192;
  const u16* K = B.KF_() + (size_t)(b * 4 + hd) * LT * 192;
  const u16* VT = B.VT1_() + (size_t)(b * 4 + hd) * 128 * LT;
  attn_pass<192, 32>(smem, Q, K, VT, LT, O, l);
  const float inv = 1.f / l;
  u16* orow = B.MIX1_() + (size_t)(b * LT + CTX + qt * 128 + wid * 32 + r) * 1024 + hd * 128;
#pragma unroll
  for (int dvb = 0; dvb < 4; ++dvb)
#pragma unroll
    for (int g = 0; g < 4; ++g) {
      int dv0 = dvb * 32 + 8 * g + 4 * h;
      u32x2 o;
      o[0] = pk2(O[dvb][4 * g] * inv, O[dvb][4 * g + 1] * inv);
      o[1] = pk2(O[dvb][4 * g + 2] * inv, O[dvb][4 * g + 3] * inv);
      *(u32x2*)(orow + dv0) = o;
    }
}

constexpr int HLD = 136;
DI void hgrn_item(char* smem, const Bufs& B, int b, int hd, int dir) {
  u16* Qs = (u16*)smem;
  u16* Ksm = Qs + 64 * HLD;
  u16* KsT = Ksm + 64 * HLD;
  u16* VsT = KsT + 128 * LDT;
  float* emid = (float*)(VsT + 128 * LDT);
  float* ecm = emid + 128;
  const int tid = otid(), lane = tid & 63, w = tid >> 6, r = lane & 31, h = lane >> 5;
  f32x16 S[4];
#pragma unroll
  for (int kb = 0; kb < 4; ++kb)
#pragma unroll
    for (int g = 0; g < 16; ++g) S[kb][g] = 0.f;
  const u16* LFd = B.LF_() + (size_t)dir * M * 512;
  u16* OHd = B.OH_() + (size_t)dir * M * 512;
  for (int ci = 0; ci < 68; ++ci) {
    const int c = dir ? (ci < 4 ? 3 - ci : 71 - ci) : ci;
    const int rowc = b * LT + c * 64;
#pragma unroll
    for (int it = 0; it < 4; ++it) {
      int cid = it * 256 + tid, pp = cid >> 4, cc = cid & 15;
      size_t grow = (size_t)(rowc + (dir ? 63 - pp : pp));
      u32x4 qv = *(const u32x4*)(B.HQ_() + grow * 512 + hd * 128 + cc * 8);
      u32x4 lv = *(const u32x4*)(LFd + grow * 512 + hd * 128 + cc * 8);
      *(u32x4*)(Qs + pp * HLD + cc * 8) = qv;
      *(u32x4*)(Ksm + pp * HLD + cc * 8) = lv;
    }
#pragma unroll
    for (int it = 0; it < 4; ++it) {
      const int cc = it * 4 + w, pp = lane;
      size_t grow = (size_t)(rowc + (dir ? 63 - pp : pp));
      u32x4 vv = *(const u32x4*)(B.HI_() + grow * 512 + hd * 128 + cc * 8);
#pragma unroll
      for (int q = 0; q < 4; ++q) {
        VsT[(cc * 8 + 2 * q) * LDT + pp] = (u16)(vv[q] & 0xffffu);
        VsT[(cc * 8 + 2 * q + 1) * LDT + pp] = (u16)(vv[q] >> 16);
      }
    }
    __syncthreads();
    {
      const int ch = tid & 127, half = tid >> 7;
      float tot0 = 0.f;
      for (int pp = 0; pp < 32; ++pp) tot0 += h2f(Ksm[pp * HLD + ch]);
      __syncthreads();
      float run = half ? 0.f : -tot0;
#pragma unroll
      for (int p8 = 0; p8 < 4; ++p8) {
        float kt[8];
#pragma unroll
        for (int e = 0; e < 8; ++e) {
          int pp = half * 32 + p8 * 8 + e;
          float lf = h2f(Ksm[pp * HLD + ch]);
          run += lf;
          float q = bf2f(Qs[pp * HLD + ch]);
          float er = __expf(run);
          Qs[pp * HLD + ch] = f2bf(q * er);
          kt[e] = (1.f - __expf(lf)) / er;
          Ksm[pp * HLD + ch] = f2bf(kt[e]);
        }
        *(u32x4*)(KsT + ch * LDT + half * 32 + p8 * 8) = pack8(kt);
      }
      if (half == 0) emid[ch] = __expf(tot0); else ecm[ch] = __expf(run);
    }
    __syncthreads();
    bf16x8 xa[4][2];
#pragma unroll
    for (int kb = 0; kb < 4; ++kb) {
#pragma unroll
      for (int g = 0; g < 16; ++g) S[kb][g] *= emid[kb * 32 + crow(g, h)];
#pragma unroll
      for (int s = 0; s < 2; ++s) {
        u32x4 o;
#pragma unroll
        for (int q = 0; q < 4; ++q) o[q] = pk2(S[kb][8 * s + 2 * q], S[kb][8 * s + 2 * q + 1]);
        xa[kb][s] = __builtin_bit_cast(bf16x8, o);
      }
    }
#pragma unroll
    for (int tb = 0; tb < 2; ++tb) {
      f32x16 oT;
#pragma unroll
      for (int g = 0; g < 16; ++g) oT[g] = 0.f;
#pragma unroll
      for (int kb = 0; kb < 4; ++kb)
#pragma unroll
        for (int s = 0; s < 2; ++s) {
          const u16* qp = Qs + (tb * 32 + r) * HLD + kb * 32 + s * 16 + 4 * h;
          u32x2 lo = *(const u32x2*)qp, hi = *(const u32x2*)(qp + 8);
          u32x4 bq = {lo[0], lo[1], hi[0], hi[1]};
          oT = MFMA32(xa[kb][s], __builtin_bit_cast(bf16x8, bq), oT);
        }
#pragma unroll
      for (int sb = 0; sb <= tb; ++sb) {
        f32x16 P;
#pragma unroll
        for (int g = 0; g < 16; ++g) P[g] = 0.f;
#pragma unroll
        for (int ks = 0; ks < 8; ++ks) {
          bf16x8 a = *(const bf16x8*)(Ksm + (sb * 32 + r) * HLD + ks * 16 + h * 8);
          bf16x8 bb = *(const bf16x8*)(Qs + (tb * 32 + r) * HLD + ks * 16 + h * 8);
          P = MFMA32(a, bb, P);
        }
        if (sb == tb) {
#pragma unroll
          for (int g = 0; g < 16; ++g) P[g] = (crow(g, h) <= r) ? P[g] : 0.f;
        }
#pragma unroll
        for (int s = 0; s < 2; ++s) {
          u32x4 o;
#pragma unroll
          for (int q = 0; q < 4; ++q) o[q] = pk2(P[8 * s + 2 * q], P[8 * s + 2 * q + 1]);
          const u16* vp = VsT + (w * 32 + r) * LDT + sb * 32 + s * 16 + 4 * h;
          u32x2 lo = *(const u32x2*)vp, hi = *(const u32x2*)(vp + 8);
          u32x4 av = {lo[0], lo[1], hi[0], hi[1]};
          oT = MFMA32(__builtin_bit_cast(bf16x8, av), __builtin_bit_cast(bf16x8, o), oT);
        }
      }
      {
        int pp = tb * 32 + r;
        size_t grow = (size_t)(rowc + (dir ? 63 - pp : pp));
        u16* op = OHd + grow * 512 + hd * 128 + w * 32;
#pragma unroll
        for (int g4 = 0; g4 < 4; ++g4) {
          u32x2 o;
          o[0] = pk2(oT[4 * g4], oT[4 * g4 + 1]);
          o[1] = pk2(oT[4 * g4 + 2], oT[4 * g4 + 3]);
          *(u32x2*)(op + 8 * g4 + 4 * h) = o;
        }
      }
    }
#pragma unroll
    for (int kb = 0; kb < 4; ++kb) {
#pragma unroll
      for (int ts = 0; ts < 4; ++ts) {
        bf16x8 a = *(const bf16x8*)(KsT + (kb * 32 + r) * LDT + ts * 16 + h * 8);
        bf16x8 bb = *(const bf16x8*)(VsT + (w * 32 + r) * LDT + ts * 16 + h * 8);
        S[kb] = MFMA32(a, bb, S[kb]);
      }
#pragma unroll
      for (int g = 0; g < 16; ++g) S[kb][g] *= ecm[kb * 32 + crow(g, h)];
    }
    __syncthreads();
  }
}

DI void hgrn_readout_row(const Params& p, const Bufs& B, int grow, int hd, int lane) {
  const size_t o = (size_t)grow * 512 + hd * 128 + lane * 2;
  unsigned a = *(const unsigned*)(B.OH_() + o), bq = *(const unsigned*)(B.OH_() + (size_t)M * 512 + o);
  unsigned gq = *(const unsigned*)(B.HG_() + o);
  float v0 = bflo(a) + bflo(bq), v1 = bfhi(a) + bfhi(bq);
  float ss = wave_sum(v0 * v0 + v1 * v1);
  float rstd = rsqrtf(ss * (1.f / 128.f) + EPS);
  const float* hn = p.in[23];
  float g0 = bflo(gq), g1 = bfhi(gq);
  unsigned out = pk2(v0 * rstd * hn[lane * 2] * siluf(g0), v1 * rstd * hn[lane * 2 + 1] * siluf(g1));
  *(unsigned*)(B.MIX1_() + (size_t)grow * 1024 + 512 + hd * 128 + lane * 2) = out;
}

constexpr int NPHASE = 18;


struct TileIter {
  int qg, step, ntn, nloc, total, xcd;
  DI TileIter(int nrt, int ntn_) {
    xcd = blockIdx.x & 7; qg = blockIdx.x >> 3; step = gridDim.x >> 3; ntn = ntn_;
    nloc = (nrt - xcd + 7) >> 3;
    total = ((nloc + 7) >> 3) * 8 * ntn;
  }
  DI bool next(int& rt, int& nt) {
    const int per = 8 * ntn, full = ntn >> 3, wrem = ntn & 7;
    while (qg < total) {
      int grp = qg / per, q = qg - grp * per, r, c;
      qg += step;
      if (q < full * 64) { int ch = q >> 6, qq = q & 63; r = qq >> 3; c = ch * 8 + (qq & 7); }
      else { int qq = q - full * 64; r = qq / wrem; c = full * 8 + (qq - r * wrem); }
      int rl = grp * 8 + r;
      if (rl < nloc) { rt = rl * 8 + xcd; nt = c; return true; }
    }
    return false;
  }
};

DI int lat_rowbase(int rt) { return (rt >> 5) * LT + CTX + (rt & 31) * 128; }

DI void run_phase(int ph, const Params& p, const Bufs& B, char* smem) {
  const int bid = blockIdx.x, nb = gridDim.x, tid = otid(), lane = tid & 63, wid = tid >> 6;
  switch (ph) {
    case 0: {
      const int n = NW_P0 + 192 + 1;
      for (int it = bid; it < n; it += nb) {
        if (it < NW_P0) prep_weight_item(smem, p, B, it);
        else if (it < NW_P0 + 192) mod_gemv_item(smem, p, B, it - NW_P0);
        else tables_item(p, B);
      }
    } break;
    case 1: {
      for (int it = bid; it < M / 32; it += nb) {
        for (int rr = 0; rr < 8; ++rr) {
          int row = it * 32 + rr * 4 + wid;
          RowInfo ri = row_info(row);
          const float* x = (ri.lat ? p.in[0] : p.in[2]) + resid_off(ri);
          const float* md = B.mod_() + (size_t)(0 * 9 + ri.mi) * 6144;
          norm_mod_row(x, p.in[6] + 0, md, md + 1024, B.H_() + (size_t)row * 1024, lane);
        }
      }
    } break;
    case 2: {
      const int n = 272 * 16;
      EpiArgs ea{};
      TileIter ti(272, 16);
      for (int rt, nt; ti.next(rt, nt);) {
        gemm_tile<EPI_IN0, false>(smem, p, B, B.H_(), 1024, rt * 128, 0, M, B.wt_ev_(), 1024, nt * 128, ea);
      }
    } break;
    case 3: {
      const int n_lat = 8 * 4 * 32, n_ctx = 8 * 4 * 2, n_pool = 272 * 4;
      for (int it = bid; it < n_lat; it += nb) {
        int b = it >> 7, vh = (it >> 5) & 3, qt = it & 31;
        diff_attn_item(smem, p, B, b, vh, CTX + qt * 128, LT);
      }
      for (int it = nb - 1 - bid; it < n_ctx; it += nb) {
        int b = it >> 3, vh = (it >> 1) & 3, qt = it & 1;
        diff_attn_item(smem, p, B, b, vh, qt * 128, CTX);
      }
      for (int it = nb - 1 - bid; it < n_pool; it += nb) pool_tile(smem, p, B, it >> 2, it & 3);
    } break;
    case 4: {
      EpiArgs ea{}; ea.outf = B.Y0_();
      TileIter ti(272, 8);
      for (int rt, nt; ti.next(rt, nt);) {
        gemm_tile<EPI_F32, false>(smem, p, B, B.MIX0_(), 1024, rt * 128, 0, M, B.wt_out_(), 1024, nt * 128, ea);
      }
    } break;
    case 5: case 8: {
      const bool first = (ph == 5);
      const u16* Yb = (const u16*)B.Y0_();
      for (int it = bid; it < M / 32; it += nb) {
        for (int rr = 0; rr < 8; ++rr) {
          int row = it * 32 + rr * 4 + wid;
          RowInfo ri = row_info(row);
          size_t ro = resid_off(ri);
          const float* md0 = B.mod_() + (size_t)(0 * 9 + ri.mi) * 6144;
          const float* md1 = B.mod_() + (size_t)(1 * 9 + ri.mi) * 6144;
          float* xd = (ri.lat ? p.out : B.xc_()) + ro;
          if (first) {
            const float* xs = (ri.lat ? p.in[0] : p.in[2]) + ro;
            resid_row<true>(Yb + (size_t)row * 1024, xs, xd, md0 + 2 * 1024, p.in[6] + 1 * 1024, p.in[6] + 2 * 1024,
                            md0 + 3 * 1024, md0 + 4 * 1024, B.H_() + (size_t)row * 1024, lane);
          } else {
            resid_row<true>(Yb + (size_t)row * 1024, xd, xd, md0 + 5 * 1024, p.in[6] + 3 * 1024,
                            p.in[6] + 4 * 1024 + 0, md1, md1 + 1024, B.H_() + (size_t)row * 1024, lane);
          }
        }
      }
    } break;
    case 6: {
      const int n = 288 * 44;
      TileIter ti(288, 44);
      for (int rtile, nt; ti.next(rtile, nt);) {
        int b = rtile / 36, jj = rtile - b * 36;
        EpiArgs ea{}; ea.layer = 0;
        int j;
        if (jj < 3) { ea.seg_lo = b * LT; ea.seg_hi = b * LT + CTX; j = jj; }
        else { ea.seg_lo = b * LT + CTX; ea.seg_hi = (b + 1) * LT; j = jj - 3; }
        gemm_tile<EPI_FFN1, false>(smem, p, B, B.H_(), 1024, ea.seg_lo + 126 * j - 1, ea.seg_lo, ea.seg_hi, B.wt_f1_(), 1024,
                                   nt * 128, ea);
      }
    } break;
    case 7: {
      EpiArgs ea{}; ea.outf = B.Y0_();
      TileIter ti(272, 8);
      for (int rt, nt; ti.next(rt, nt);) {
        gemm_tile<EPI_F32, false>(smem, p, B, B.G0_(), DFF, rt * 128, 0, M, B.wt_f2_(), DFF, nt * 128, ea);
      }
    } break;
    case 9: {
      const int n = 272 * 27;
      EpiArgs ea{};
      TileIter ti(272, 27);
      for (int rt, nt; ti.next(rt, nt);) {
        gemm_tile<EPI_IN1, false>(smem, p, B, B.H_(), 1024, rt * 128, 0, M, B.wt_od_(), 1024, nt * 128, ea);
      }
    } break;
    case 10: {
      const int n_q = 256 * 6, n_kv = 272 * 8;
      EpiArgs ea{};
      TileIter tq(256, 6);
      for (int rt, nt; tq.next(rt, nt);) {
        gemm_tile<EPI_UQ, true>(smem, p, B, B.CQ_(), 512, lat_rowbase(rt), 0, M, B.wt_uq_(), 512, nt * 128, ea);
      }
      TileIter tk(272, 8);
      for (int rt, nt; tk.next(rt, nt);) {
        gemm_tile<EPI_UKV, true>(smem, p, B, B.CKV_(), 256, rt * 128, 0, M, B.wt_ukv_(), 256, nt * 128, ea);
      }
      for (int it = nb - 1 - bid; it < NW_FFN; it += nb) ffn_weight_item(smem, p, B, 1, it);
    } break;
    case 11: {
      const int n_h = 64, n_a = 8 * 4 * 32;
      unsigned* qctr = (unsigned*)(p.ws + OFF_LAM + 256) + 64;
      volatile int* sitem = (volatile int*)(smem + SMEM_MAIN + 8);
      for (;;) {
        __syncthreads();
        if (otid() == 0) *sitem = (int)atomicAdd(qctr, 1u);
        __syncthreads();
        const int it = *sitem;
        if (it >= n_h) break;
        hgrn_item(smem, B, it >> 3, (it >> 1) & 3, it & 1);
      }
      for (;;) {
        __syncthreads();
        if (otid() == 0) *sitem = (int)atomicAdd(qctr + 1, 1u);
        __syncthreads();
        const int it = *sitem;
        if (it >= n_a) break;
        mla_attn_item(smem, B, it >> 7, (it >> 5) & 3, it & 31);
      }
    } break;
    case 12: {
      const int n = NB * SEQ * 4 / 4;
      for (int it = bid; it < n; it += nb) {
        int j = it * 4 + wid, rl = j >> 2, hd = j & 3;
        int grow = (rl >> 12) * LT + CTX + (rl & 4095);
        hgrn_readout_row(p, B, grow, hd, lane);
      }
    } break;
    case 13: {
      EpiArgs ea{}; ea.outf = B.Y1_();
      TileIter ti(256, 8);
      for (int rt, nt; ti.next(rt, nt);) {
        gemm_tile<EPI_F32, false>(smem, p, B, B.MIX1_(), 1024, lat_rowbase(rt), 0, M, B.wt_out_() + 1024 * 1024, 1024,
                                  nt * 128, ea);
      }
    } break;
    case 14: case 17: {
      const bool first = (ph == 14);
      for (int it = bid; it < NB * SEQ / 32; it += nb) {
        for (int rr = 0; rr < 8; ++rr) {
          int rl = it * 32 + rr * 4 + wid;
          int bb = rl >> 12, row = bb * LT + CTX + (rl & 4095);
          float* xd = p.out + (size_t)rl * 1024;
          const float* md1 = B.mod_() + (size_t)(1 * 9 + bb) * 6144;
          const float* ng = p.in[6] + 4 * 1024;
          if (first)
            resid_row<true>((const u16*)B.Y1_() + (size_t)row * 1024, xd, xd, md1 + 2 * 1024, ng + 1 * 1024, ng + 2 * 1024,
                            md1 + 3 * 1024, md1 + 4 * 1024, B.H_() + (size_t)row * 1024, lane);
          else
            resid_row<false>((const u16*)B.Y1_() + (size_t)row * 1024, xd, xd, md1 + 5 * 1024, ng + 3 * 1024, nullptr, nullptr, nullptr,
                             nullptr, lane);
        }
      }
    } break;
    case 15: {
      const int n = 264 * 44;
      TileIter ti(264, 44);
      for (int rtile, nt; ti.next(rtile, nt);) {
        int b = rtile / 33, j = rtile - b * 33;
        EpiArgs ea{}; ea.layer = 1; ea.seg_lo = b * LT + CTX; ea.seg_hi = (b + 1) * LT;
        gemm_tile<EPI_FFN1, false>(smem, p, B, B.H_(), 1024, ea.seg_lo + 126 * j - 1, ea.seg_lo, ea.seg_hi, B.wt_f1_(), 1024,
                                   nt * 128, ea);
      }
    } break;
    case 16: {
      EpiArgs ea{}; ea.outf = B.Y1_();
      TileIter ti(256, 8);
      for (int rt, nt; ti.next(rt, nt);) {
        gemm_tile<EPI_F32, false>(smem, p, B, B.G1_(), DFF, lat_rowbase(rt), 0, M, B.wt_f2_(), DFF, nt * 128, ea);
      }
    } break;
    default: break;
  }
}

#define XB_TMO      128
#define XB_XCNT(j)  (256  + 64 * (j))
#define XB_XSUB(j)  (1280 + 64 * (j))
#define XB_XGEN(j)  (2304 + 64 * (j))
#define XB_TOP      3328
#define XB_TOPGEN   3392
#define XCD_BAR_WORDS 3456
#define XB_SPIN_CAP (1u << 18)
#define LAS __attribute__((address_space(3)))
DI unsigned xb_ld(unsigned* p) { return __hip_atomic_load(p, __ATOMIC_RELAXED, __HIP_MEMORY_SCOPE_AGENT); }
DI unsigned xb_add(unsigned* p, unsigned v) { return __hip_atomic_fetch_add(p, v, __ATOMIC_RELAXED, __HIP_MEMORY_SCOPE_AGENT); }
DI unsigned xb_xcc_id() { return (unsigned)__builtin_amdgcn_s_getreg((3 << 11) | 20) & 0xFu; }
#define XB_SPIN(cond, bar) do { unsigned _sp = 0; while (cond) { __builtin_amdgcn_s_sleep(1); \
    if ((++_sp & 255u) == 0u) { if (xb_ld(&(bar)[XB_TMO])) break; if (_sp > XB_SPIN_CAP) { atomicAdd(&(bar)[XB_TMO], 1u); break; } } } } while (0)
struct XcdBarrier { unsigned* bar; unsigned x; volatile LAS unsigned* st; };
DI XcdBarrier xcd_barrier_post(unsigned* bar, volatile LAS unsigned* st) {
  XcdBarrier b; b.bar = bar; b.x = xb_xcc_id(); b.st = st;
  if (threadIdx.x == 0) (void)xb_add(&bar[XB_XCNT(b.x)], 1u);
  return b;
}
DI void xcd_barrier_complete(unsigned* bar, unsigned x, unsigned& nloc, unsigned& nx) {
  const unsigned G = gridDim.x * gridDim.y * gridDim.z;
  unsigned sum, cnt, mine, sp = 0u;
  for (;;) {
    sum = 0u; cnt = 0u; mine = 0u;
#pragma unroll
    for (unsigned j = 0; j < 16; ++j) { const unsigned c = xb_ld(&bar[XB_XCNT(j)]); sum += c; cnt += (c > 0u) ? 1u : 0u; mine = (j == x) ? c : mine; }
    if (sum == G) break;
    __builtin_amdgcn_s_sleep(1);
    if ((++sp & 255u) == 0u) { if (xb_ld(&bar[XB_TMO])) break; if (sp > XB_SPIN_CAP) { atomicAdd(&bar[XB_TMO], 1u); break; } }
  }
  nloc = mine > 0u ? mine : 1u; nx = cnt > 0u ? cnt : 1u;
}
DI void xcd_barrier(const XcdBarrier& b) {
  asm volatile("s_waitcnt vmcnt(0)" ::: "memory");
  __syncthreads();
  if (threadIdx.x == 0) {
    unsigned* bar = b.bar;
    __builtin_amdgcn_s_waitcnt(0);
    unsigned nloc = b.st[0], nx = b.st[1];
    if (nloc == 0u) { xcd_barrier_complete(bar, b.x, nloc, nx); b.st[0] = nloc; b.st[1] = nx; }
    const unsigned old = xb_add(&bar[XB_XSUB(b.x)], 1u);
    const unsigned gen = old / nloc;
    if (old + 1u == (gen + 1u) * nloc) {
      __builtin_amdgcn_fence(__ATOMIC_RELEASE, "agent");
      asm volatile("s_waitcnt vmcnt(0)" ::: "memory");
      const unsigned og = xb_add(&bar[XB_TOP], 1u);
      const unsigned tg = og / nx;
      if (og + 1u == (tg + 1u) * nx) xb_add(&bar[XB_TOPGEN], 1u);
      else XB_SPIN(xb_ld(&bar[XB_TOPGEN]) == tg, bar);
      __builtin_amdgcn_fence(__ATOMIC_ACQUIRE, "agent");
      xb_add(&bar[XB_XGEN(b.x)], 1u);
      asm volatile("s_waitcnt vmcnt(0)" ::: "memory");
    } else {
      XB_SPIN(xb_ld(&bar[XB_XGEN(b.x)]) == gen, bar);
      __builtin_amdgcn_fence(__ATOMIC_ACQUIRE, "agent");
      asm volatile("s_waitcnt vmcnt(0)" ::: "memory");
    }
  }
  __syncthreads();
}
#define RUNPH(k)                                                                       \
  if (p.ph_lo <= (k) && (k) < p.ph_hi) {                                               \
    run_phase((k), p, B, smem);                                                        \
    if ((k) + 1 < p.ph_hi) {                                                           \
      if ((k) == 0) cg::this_grid().sync();                                            \
      else xcd_barrier(xb);                                                            \
    }                                                                                  \
  }
__global__ void __launch_bounds__(NTHR, 2) fwd_megakernel(Params p) {
  extern __shared__ __attribute__((aligned(16))) char smem[];
  const Bufs B = make_bufs(p.ws);
  volatile LAS unsigned* xst = (volatile LAS unsigned*)(smem + SMEM_MAIN);
  if (threadIdx.x == 0) { xst[0] = 0u; xst[1] = 0u; xst[2] = 0u; xst[3] = 0u; }
  __syncthreads();
  const XcdBarrier xb = xcd_barrier_post((unsigned*)(p.ws + OFF_LAM + 256), xst);
  RUNPH(0) RUNPH(1) RUNPH(2) RUNPH(3) RUNPH(4) RUNPH(5) RUNPH(6) RUNPH(7) RUNPH(8)
  RUNPH(9) RUNPH(10) RUNPH(11) RUNPH(12) RUNPH(13) RUNPH(14) RUNPH(15) RUNPH(16) RUNPH(17)
}

constexpr bool ONE_LAUNCH = true;

extern "C" void kernel_launch(void* const* d_in, const int* in_sizes, int n_in, void* d_out, int out_size, void* d_ws,
                              size_t ws_size, hipStream_t stream) {
  static int grid_blocks = 0;
  if (!grid_blocks) {
    int dev = 0, cus = 0, per_cu = 0;
    hipGetDevice(&dev);
    hipDeviceGetAttribute(&cus, hipDeviceAttributeMultiprocessorCount, dev);
    hipFuncSetAttribute((const void*)fwd_megakernel, hipFuncAttributeMaxDynamicSharedMemorySize, SMEM_BYTES);
    hipOccupancyMaxActiveBlocksPerMultiprocessor(&per_cu, fwd_megakernel, NTHR, SMEM_BYTES);
    if (per_cu < 1) per_cu = 1;
    if (per_cu > 2) per_cu = 2;
    grid_blocks = cus * per_cu;
  }
  if (ws_size < WS_NEEDED) {
    fprintf(stderr, "workspace too small: %zu < %zu\n", ws_size, (size_t)WS_NEEDED);
    return;
  }
  Params p{};
  for (int i = 0; i < 25; ++i) p.in[i] = (const float*)d_in[i];
  p.out = (float*)d_out;
  p.ws = (char*)d_ws;
  hipMemsetAsync((char*)d_ws + OFF_LAM + 256, 0, XCD_BAR_WORDS * 4, stream);
  if (ONE_LAUNCH) {
    p.ph_lo = 0; p.ph_hi = NPHASE;

    void* args[] = {&p};
    hipError_t e = hipLaunchCooperativeKernel((const void*)fwd_megakernel, dim3(grid_blocks), dim3(NTHR), args,
                                              SMEM_BYTES, stream);
    if (e != hipSuccess) fprintf(stderr, "cooperative launch failed: %s (grid %d)\n", hipGetErrorString(e), grid_blocks);
  } else {
    for (int ph = 0; ph < NPHASE; ++ph) {
      p.ph_lo = ph; p.ph_hi = ph + 1;
      hipLaunchKernelGGL(fwd_megakernel, dim3(grid_blocks), dim3(NTHR), SMEM_BYTES, stream, p);
    }
  }
}
```

```cpp
#include <hip/hip_runtime.h>
#include <hip/hip_fp16.h>
#include <hip/hip_cooperative_groups.h>
#include <cstdio>
#include <cstdint>
namespace cg = cooperative_groups;

#define DI __device__ __forceinline__
typedef unsigned short u16;
typedef __attribute__((ext_vector_type(8))) short bf16x8;
typedef __attribute__((ext_vector_type(16))) float f32x16;
typedef __attribute__((ext_vector_type(4))) unsigned u32x4;
typedef __attribute__((ext_vector_type(2))) unsigned u32x2;

constexpr int D = 1024, NB = 8, SEQ = 4096, CTX = 256, LT = 4352, M = NB * LT, DFF = 2816;
constexpr float EPS = 1e-6f;
constexpr float LOG2E = 1.4426950408889634f;
constexpr float QS_DIFF = 0.125f * LOG2E;
constexpr float QS_MLA = 0.07216878364870323f * LOG2E;
constexpr int NTHR = 512;
constexpr int VTHR = 256;

constexpr size_t SZ_WT_OUT = 2ull * 1024 * 1024 * 2;
constexpr size_t SZ_WT_F1 = 5632ull * 1024 * 2;
constexpr size_t SZ_WT_F2 = 1024ull * 2816 * 2;
constexpr size_t SZ_WT_EV = 2048ull * 1024 * 2;
constexpr size_t SZ_WT_OD = 3584ull * 1024 * 2;
constexpr size_t SZ_WT_UQ = 768ull * 512 * 2;
constexpr size_t SZ_WT_UKV = 1024ull * 256 * 2;
constexpr size_t SZ_WT_POOL = 4ull * 128 * 128 * 2;
constexpr size_t SZ_MOD = 2ull * 9 * 6144 * 4;
constexpr size_t SZ_ROPE = 2ull * 1024 * 4;
constexpr size_t SZ_LB = 1024 * 4;
constexpr size_t SZ_RS = (size_t)M * 24 * 4;
constexpr size_t SZ_LAM = 256 + 16384 + SZ_RS;
constexpr size_t SZ_XC = 2048ull * 1024 * 4;
constexpr size_t SZ_H = (size_t)M * 1024 * 2;
constexpr size_t SZ_M512 = (size_t)M * 512 * 2;

constexpr size_t OFF_WT_OUT = 0;
constexpr size_t OFF_WT_F1 = OFF_WT_OUT + SZ_WT_OUT;
constexpr size_t OFF_WT_F2 = OFF_WT_F1 + SZ_WT_F1;
constexpr size_t OFF_WT_EV = OFF_WT_F2 + SZ_WT_F2;
constexpr size_t OFF_WT_OD = OFF_WT_EV + SZ_WT_EV;
constexpr size_t OFF_WT_UQ = OFF_WT_OD + SZ_WT_OD;
constexpr size_t OFF_WT_UKV = OFF_WT_UQ + SZ_WT_UQ;
constexpr size_t OFF_WT_POOL = OFF_WT_UKV + SZ_WT_UKV;
constexpr size_t OFF_MOD = OFF_WT_POOL + SZ_WT_POOL;
constexpr size_t OFF_ROPE = OFF_MOD + SZ_MOD;
constexpr size_t OFF_LB = OFF_ROPE + SZ_ROPE;
constexpr size_t OFF_LAM = OFF_LB + SZ_LB;
constexpr size_t OFF_XC = OFF_LAM + SZ_LAM;
constexpr size_t OFF_H = OFF_XC + SZ_XC;
constexpr size_t OFF_R = OFF_H + SZ_H;
constexpr size_t R_U = 0;
constexpr size_t R_Q0 = R_U + SZ_M512;
constexpr size_t R_K0 = R_Q0 + SZ_M512;
constexpr size_t R_VT0 = R_K0 + SZ_M512;
constexpr size_t R_MIX0 = R_VT0 + SZ_M512;
constexpr size_t R_Y0 = R_MIX0 + SZ_H;
constexpr size_t R_G0 = 0;
constexpr size_t R_MIX1 = 0;
constexpr size_t R_CQ = 0;
constexpr size_t R_CKV = SZ_M512;
constexpr size_t R_KF = SZ_H;
constexpr size_t SZ_KF = 8ull * 4 * LT * 192 * 2;
constexpr size_t R_VT1 = R_KF + SZ_KF;
constexpr size_t R_HQ = R_VT1 + SZ_M512;
constexpr size_t R_LF = R_HQ + SZ_M512;
constexpr size_t R_HI = R_LF + 2 * SZ_M512;
constexpr size_t R_HG = R_HI + SZ_M512;
constexpr size_t R_OH = R_HG + SZ_M512;
constexpr size_t R_END1 = R_OH + 2 * SZ_M512;
constexpr size_t R_Y1 = R_KF;
constexpr size_t SZ_Y = (size_t)M * 1024 * 4;
constexpr size_t R_G1 = R_Y1 + SZ_Y;
constexpr size_t SZ_G = (size_t)M * DFF * 2;
constexpr size_t R_SIZE = (R_G1 + SZ_G > R_END1) ? (R_G1 + SZ_G) : R_END1;
constexpr size_t WS_NEEDED = OFF_R + R_SIZE;
static_assert(R_Y0 + SZ_Y <= R_SIZE, "layer0 region");
static_assert(R_G0 + SZ_G <= R_Y0, "G0 overlap");
static_assert(WS_NEEDED <= 536870912ull, "ws too big");

struct Params {
  const float* in[25];
  float* out;
  char* ws;
  int ph_lo, ph_hi;
};

constexpr int SMEM_HALF = 73728;
constexpr int SMEM_MAIN = 2 * SMEM_HALF;
constexpr int SMEM_BYTES = SMEM_MAIN + 16;
constexpr int LDT = 72;
constexpr int CLD = 132;

DI int otid() { int t = threadIdx.x & 255; asm volatile("" : "+v"(t)); return t; }
template <int NT> DI int otidn() { int t = threadIdx.x & (NT - 1); asm volatile("" : "+v"(t)); return t; }
DI int vblk() { return __builtin_amdgcn_readfirstlane((int)threadIdx.x >> 8); }
DI u16 f2bf(float x) { return __builtin_bit_cast(u16, (__bf16)x); }
typedef float f32x2v __attribute__((ext_vector_type(2)));
typedef __bf16 bf16x2v __attribute__((ext_vector_type(2)));
DI unsigned pk2(float a, float b) {
  f32x2v v = {a, b};
  return __builtin_bit_cast(unsigned, __builtin_convertvector(v, bf16x2v));
}
DI float bflo(unsigned u) { return __uint_as_float(u << 16); }
DI float bfhi(unsigned u) { return __uint_as_float(u & 0xffff0000u); }
DI float bf2f(u16 v) { return __uint_as_float(((unsigned)v) << 16); }
DI float h2f(u16 v) { return __half2float(__ushort_as_half(v)); }
DI u16 f2h(float x) { return __half_as_ushort(__float2half(x)); }
DI float siluf(float x) { return x / (1.f + __expf(-x)); }
DI float wave_sum(float v) {
#pragma unroll
  for (int o = 32; o > 0; o >>= 1) v += __shfl_xor(v, o);
  return v;
}
DI u32x4 pack8(const float* v) {
  u32x4 o;
  o[0] = pk2(v[0], v[1]); o[1] = pk2(v[2], v[3]); o[2] = pk2(v[4], v[5]); o[3] = pk2(v[6], v[7]);
  return o;
}
DI int crow(int reg, int h) { return (reg & 3) + 8 * (reg >> 2) + 4 * h; }
#define MFMA32(a, b, c) __builtin_amdgcn_mfma_f32_32x32x16_bf16((a), (b), (c), 0, 0, 0)

struct Bufs {
  char* ws;
#define BUFP(T, name, off) DI T* name##_() const { return (T*)(ws + (off)); }
  BUFP(u16, wt_out, OFF_WT_OUT) BUFP(u16, wt_f1, OFF_WT_F1) BUFP(u16, wt_f2, OFF_WT_F2) BUFP(u16, wt_ev, OFF_WT_EV)
  BUFP(u16, wt_od, OFF_WT_OD) BUFP(u16, wt_uq, OFF_WT_UQ) BUFP(u16, wt_ukv, OFF_WT_UKV) BUFP(u16, wt_pool, OFF_WT_POOL)
  BUFP(float, mod, OFF_MOD) BUFP(float, ropec, OFF_ROPE) BUFP(float, ropes, OFF_ROPE + 4096) BUFP(float, lb, OFF_LB)
  BUFP(float, lam, OFF_LAM) BUFP(float, RS, OFF_LAM + 256 + 16384) BUFP(float, xc, OFF_XC) BUFP(u16, H, OFF_H)
  BUFP(u16, U, OFF_R + R_U) BUFP(u16, Q0, OFF_R + R_Q0) BUFP(u16, K0, OFF_R + R_K0) BUFP(u16, VT0, OFF_R + R_VT0)
  BUFP(u16, MIX0, OFF_R + R_MIX0) BUFP(float, Y0, OFF_R + R_Y0) BUFP(u16, G0, OFF_R + R_G0)
  BUFP(u16, CQ, OFF_R + R_CQ) BUFP(u16, CKV, OFF_R + R_CKV) BUFP(u16, MIX1, OFF_R + R_MIX1) BUFP(u16, KF, OFF_R + R_KF)
  BUFP(u16, VT1, OFF_R + R_VT1) BUFP(u16, HQ, OFF_R + R_HQ) BUFP(u16, LF, OFF_R + R_LF) BUFP(u16, HI, OFF_R + R_HI)
  BUFP(u16, HG, OFF_R + R_HG) BUFP(u16, OH, OFF_R + R_OH) BUFP(u16, QF, OFF_H) BUFP(float, Y1, OFF_R + R_Y1)
  BUFP(u16, G1, OFF_R + R_G1)
};
DI Bufs make_bufs(char* ws) { Bufs b; b.ws = ws; return b; }

DI void wt_tile(char* smem, const float* __restrict__ src, int ld, int kt, int ncol0, u16* __restrict__ dst, int K,
                int dst_row0, const float* __restrict__ scale) {
  float* t = (float*)smem;
  const int tid = otid(), col = tid & 63, r0 = tid >> 6;
#pragma unroll 4
  for (int i = 0; i < 16; ++i) {
    int row = i * 4 + r0;
    float v = src[(size_t)(kt * 64 + row) * ld + ncol0 + col];
    if (scale) v *= scale[kt * 64 + row];
    t[row * 65 + col] = v;
  }
  __syncthreads();
#pragma unroll
  for (int it = 0; it < 2; ++it) {
    int c = it * 256 + tid, j = c >> 3, kc = c & 7;
    u32x4 o;
#pragma unroll
    for (int q = 0; q < 4; ++q) o[q] = pk2(t[(kc * 8 + 2 * q) * 65 + j], t[(kc * 8 + 2 * q + 1) * 65 + j]);
    *(u32x4*)(dst + (size_t)(dst_row0 + j) * K + kt * 64 + kc * 8) = o;
  }
  __syncthreads();
}

#define WJOB(SRC, LDD, KK, NN, DST, TS, ROFF, SC)                                        \
  {                                                                                       \
    const int ntn = (NN) / 64, cnt = ((KK) / 64) * ntn;                                   \
    if (idx < cnt) {                                                                      \
      int kt = idx / ntn, nt = idx % ntn;                                                 \
      wt_tile(smem, (SRC), (LDD), kt, nt * 64, (DST), (KK), nt * (TS) + (ROFF), (SC));    \
      return;                                                                             \
    }                                                                                     \
    idx -= cnt;                                                                           \
  }

constexpr int NW_FFN = 704 * 3;
constexpr int NW_P0 = 256 + 256 + NW_FFN + 512 + 848 + 96 + 64 + 16;

DI void ffn_weight_item(char* smem, const Params& p, const Bufs& B, int layer, int idx) {
  for (int gu = 0; gu < 2; ++gu) {
    if (idx < 704) {
      int kt = idx / 44, nt = idx - kt * 44;
      wt_tile(smem, p.in[8 + gu] + (size_t)layer * 1024 * DFF, DFF, kt, nt * 64, B.wt_f1_(), 1024,
              (nt >> 1) * 256 + (nt & 1) * 64 + gu * 128, nullptr);
      return;
    }
    idx -= 704;
  }
  WJOB(p.in[12] + (size_t)layer * DFF * 1024, 1024, DFF, 1024, B.wt_f2_(), 64, 0, nullptr)
}

DI void prep_weight_item(char* smem, const Params& p, const Bufs& B, int idx) {
  WJOB(p.in[7], 1024, 1024, 1024, B.wt_out_(), 64, 0, nullptr)
  WJOB(p.in[7] + 1024 * 1024, 1024, 1024, 1024, B.wt_out_() + 1024 * 1024, 64, 0, nullptr)
  if (idx < NW_FFN) { ffn_weight_item(smem, p, B, 0, idx); return; }
  idx -= NW_FFN;
  WJOB(p.in[13], 2048, 1024, 2048, B.wt_ev_(), 64, 0, nullptr)
  WJOB(p.in[18], 3392, 1024, 3392, B.wt_od_(), 64, 0, nullptr)
  WJOB(p.in[20], 768, 512, 768, B.wt_uq_(), 64, 0, p.in[19])
  WJOB(p.in[22], 1024, 256, 1024, B.wt_ukv_(), 64, 0, p.in[21])
  {
    int g = idx >> 2, t = idx & 3;
    wt_tile(smem, p.in[14] + g * 128 * 128, 128, t >> 1, (t & 1) * 64, B.wt_pool_() + g * 128 * 128, 128, (t & 1) * 64,
            nullptr);
  }
}

DI void mod_gemv_item(char* smem, const Params& p, const Bufs& B, int idx) {
  const int layer = idx / 96, c0 = (idx % 96) * 64, tid = otid();
  float* sc = (float*)smem;
  float* red = sc + 9 * 1024;
  for (int i = tid; i < 9 * 1024; i += VTHR) {
    int rr = i >> 10, k = i & 1023;
    float v = (rr < 8) ? p.in[1][rr * 1024 + k] : p.in[3][k];
    sc[i] = siluf(v);
  }
  __syncthreads();
  const int cq = tid & 15, kg = tid >> 4;
  float acc[9][4];
#pragma unroll
  for (int a = 0; a < 9; ++a)
#pragma unroll
    for (int e = 0; e < 4; ++e) acc[a][e] = 0.f;
  const float* W = p.in[4] + (size_t)layer * 1024 * 6144 + c0 + cq * 4;
#pragma unroll 4
  for (int kk = 0; kk < 64; ++kk) {
    int k = kg * 64 + kk;
    float4 w = *(const float4*)(W + (size_t)k * 6144);
#pragma unroll
    for (int a = 0; a < 9; ++a) {
      float s = sc[a * 1024 + k];
      acc[a][0] += s * w.x; acc[a][1] += s * w.y; acc[a][2] += s * w.z; acc[a][3] += s * w.w;
    }
  }
#pragma unroll
  for (int a = 0; a < 9; ++a)
#pragma unroll
    for (int e = 0; e < 4; ++e) red[(kg * 9 + a) * 64 + cq * 4 + e] = acc[a][e];
  __syncthreads();
  for (int i = tid; i < 9 * 64; i += VTHR) {
    int a = i >> 6, c = i & 63;
    float s = 0.f;
    for (int g = 0; g < 16; ++g) s += red[(g * 9 + a) * 64 + c];
    B.mod_()[(size_t)(layer * 9 + a) * 6144 + c0 + c] = s + p.in[5][layer * 6144 + c0 + c];
  }
  __syncthreads();
}

DI void tables_item(const Params& p, const Bufs& B) {
  const int tid = otid();
  for (int i = tid; i < 1024; i += VTHR) {
    int pos = i >> 4, f = i & 15;
    float inv = powf(10000.f, -(float)f / 16.f);
    float ang = (float)pos * inv;
    B.ropec_()[i] = cosf(ang);
    B.ropes_()[i] = sinf(ang);
    int dir = i >> 9, ch = i & 511;
    float a0 = p.in[24][(dir * 2 + 0) * 512 + ch], a1 = p.in[24][(dir * 2 + 1) * 512 + ch];
    B.lb_()[i] = 1.f / (1.f + expf(a0 - a1));
  }
  if (tid < 64) {
    const float* L = p.in[16];
    float s1 = wave_sum(L[tid] * L[64 + tid]);
    float s2 = wave_sum(L[128 + tid] * L[192 + tid]);
    if (tid == 0) B.lam_()[0] = expf(s1) - expf(s2) + 0.2f;
  }
  for (int i = tid; i < 192 * 1024 / 8; i += VTHR) {
    u32x4 z = {0u, 0u, 0u, 0u};
    *(u32x4*)(B.wt_od_() + (size_t)3392 * 1024 + i * 8) = z;
  }
}

struct RowInfo { int b, pos, mi; bool lat; };
DI RowInfo row_info(int r) {
  RowInfo ri;
  ri.b = r / LT; ri.pos = r - ri.b * LT; ri.lat = ri.pos >= CTX; ri.mi = ri.lat ? ri.b : 8;
  return ri;
}
DI size_t resid_off(const RowInfo& ri) {
  return ri.lat ? ((size_t)ri.b * SEQ + (ri.pos - CTX)) * 1024 : ((size_t)ri.b * CTX + ri.pos) * 1024;
}

DI void norm_mod_row(const float* __restrict__ x, const float* __restrict__ g, const float* __restrict__ sh,
                     const float* __restrict__ sc, u16* __restrict__ hrow, int lane) {
  float4 v[4];
  float ss = 0.f;
#pragma unroll
  for (int i = 0; i < 4; ++i) {
    v[i] = *(const float4*)(x + i * 256 + lane * 4);
    ss += v[i].x * v[i].x + v[i].y * v[i].y + v[i].z * v[i].z + v[i].w * v[i].w;
  }
  ss = wave_sum(ss);
  const float rstd = rsqrtf(ss * (1.f / 1024.f) + EPS);
#pragma unroll
  for (int i = 0; i < 4; ++i) {
    int c = i * 256 + lane * 4;
    float4 gg = *(const float4*)(g + c), s1 = *(const float4*)(sh + c), s2 = *(const float4*)(sc + c);
    u32x2 o;
    o[0] = pk2(v[i].x * rstd * gg.x * (1.f + s2.x) + s1.x, v[i].y * rstd * gg.y * (1.f + s2.y) + s1.y);
    o[1] = pk2(v[i].z * rstd * gg.z * (1.f + s2.z) + s1.z, v[i].w * rstd * gg.w * (1.f + s2.w) + s1.w);
    *(u32x2*)(hrow + c) = o;
  }
}

template <bool NEXT>
DI void resid_row(const u16* __restrict__ y, const float* xs, float* xd, const float* __restrict__ gate,
                  const float* __restrict__ ny, const float* __restrict__ nx, const float* __restrict__ sh,
                  const float* __restrict__ sc, u16* __restrict__ hrow, int lane) {
  float4 v[4];
  float ss = 0.f;
#pragma unroll
  for (int i = 0; i < 4; ++i) {
    u32x2 yy = *(const u32x2*)(y + i * 256 + lane * 4);
    v[i].x = bflo(yy[0]); v[i].y = bfhi(yy[0]); v[i].z = bflo(yy[1]); v[i].w = bfhi(yy[1]);
    ss += v[i].x * v[i].x + v[i].y * v[i].y + v[i].z * v[i].z + v[i].w * v[i].w;
  }
  ss = wave_sum(ss);
  const float rstd = rsqrtf(ss * (1.f / 1024.f) + EPS);
  float ss2 = 0.f;
#pragma unroll
  for (int i = 0; i < 4; ++i) {
    int c = i * 256 + lane * 4;
    float4 xv = *(const float4*)(xs + c), gt = *(const float4*)(gate + c), nn = *(const float4*)(ny + c);
    float4 o;
    o.x = xv.x + gt.x * (v[i].x * rstd * nn.x); o.y = xv.y + gt.y * (v[i].y * rstd * nn.y);
    o.z = xv.z + gt.z * (v[i].z * rstd * nn.z); o.w = xv.w + gt.w * (v[i].w * rstd * nn.w);
    *(float4*)(xd + c) = o;
    v[i] = o;
    ss2 += o.x * o.x + o.y * o.y + o.z * o.z + o.w * o.w;
  }
  if (NEXT) {
    ss2 = wave_sum(ss2);
    const float rstd2 = rsqrtf(ss2 * (1.f / 1024.f) + EPS);
#pragma unroll
    for (int i = 0; i < 4; ++i) {
      int c = i * 256 + lane * 4;
      float4 gg = *(const float4*)(nx + c), s1 = *(const float4*)(sh + c), s2 = *(const float4*)(sc + c);
      u32x2 o;
      o[0] = pk2(v[i].x * rstd2 * gg.x * (1.f + s2.x) + s1.x, v[i].y * rstd2 * gg.y * (1.f + s2.y) + s1.y);
      o[1] = pk2(v[i].z * rstd2 * gg.z * (1.f + s2.z) + s1.z, v[i].w * rstd2 * gg.w * (1.f + s2.w) + s1.w);
      *(u32x2*)(hrow + c) = o;
    }
  }
}


struct RowParams { float4 gt[4], ny[4], nx[4], sh[4], sc[4]; };
template <bool NEXT>
DI void load_row_params(RowParams& P, const float* gate, const float* ny, const float* nx, const float* sh, const float* sc, int lane) {
#pragma unroll
  for (int i = 0; i < 4; ++i) {
    const int c = i * 256 + lane * 4;
    P.gt[i] = *(const float4*)(gate + c); P.ny[i] = *(const float4*)(ny + c);
    if (NEXT) { P.nx[i] = *(const float4*)(nx + c); P.sh[i] = *(const float4*)(sh + c); P.sc[i] = *(const float4*)(sc + c); }
  }
}
template <bool NEXT>
DI void resid_row_p(const u16* __restrict__ y, const float* xs, float* xd, const RowParams& P, u16* __restrict__ hrow, int lane) {
  float4 v[4];
  float ss = 0.f;
#pragma unroll
  for (int i = 0; i < 4; ++i) {
    u32x2 yy = *(const u32x2*)(y + i * 256 + lane * 4);
    v[i].x = bflo(yy[0]); v[i].y = bfhi(yy[0]); v[i].z = bflo(yy[1]); v[i].w = bfhi(yy[1]);
    ss += v[i].x * v[i].x + v[i].y * v[i].y + v[i].z * v[i].z + v[i].w * v[i].w;
  }
  ss = wave_sum(ss);
  const float rstd = rsqrtf(ss * (1.f / 1024.f) + EPS);
  float ss2 = 0.f;
#pragma unroll
  for (int i = 0; i < 4; ++i) {
    const int c = i * 256 + lane * 4;
    const float4 xv = *(const float4*)(xs + c), gt = P.gt[i], nn = P.ny[i];
    float4 o;
    o.x = xv.x + gt.x * (v[i].x * rstd * nn.x); o.y = xv.y + gt.y * (v[i].y * rstd * nn.y);
    o.z = xv.z + gt.z * (v[i].z * rstd * nn.z); o.w = xv.w + gt.w * (v[i].w * rstd * nn.w);
    *(float4*)(xd + c) = o;
    v[i] = o;
    ss2 += o.x * o.x + o.y * o.y + o.z * o.z + o.w * o.w;
  }
  if (NEXT) {
    ss2 = wave_sum(ss2);
    const float rstd2 = rsqrtf(ss2 * (1.f / 1024.f) + EPS);
#pragma unroll
    for (int i = 0; i < 4; ++i) {
      const int c = i * 256 + lane * 4;
      const float4 gg = P.nx[i], s1 = P.sh[i], s2 = P.sc[i];
      u32x2 o;
      o[0] = pk2(v[i].x * rstd2 * gg.x * (1.f + s2.x) + s1.x, v[i].y * rstd2 * gg.y * (1.f + s2.y) + s1.y);
      o[1] = pk2(v[i].z * rstd2 * gg.z * (1.f + s2.z) + s1.z, v[i].w * rstd2 * gg.w * (1.f + s2.w) + s1.w);
      *(u32x2*)(hrow + c) = o;
    }
  }
}

enum { EPI_F32 = 0, EPI_IN0, EPI_IN1, EPI_FFN1, EPI_UQ, EPI_UKV, EPI_POOL };

struct EpiArgs {
  float* outf;
  int layer;
  int seg_lo, seg_hi;
  int aux;
};

DI void mma_ktile(const u16* As, const u16* Bs, f32x16 (&acc)[2][2], int wm, int wn, int r, int h) {
  __builtin_amdgcn_s_setprio(1);
#pragma unroll
  for (int ks = 0; ks < 4; ++ks) {
    bf16x8 a[2], b[2];
#pragma unroll
    for (int i = 0; i < 2; ++i) a[i] = *(const bf16x8*)(As + (wm * 64 + i * 32 + r) * LDT + ks * 16 + h * 8);
#pragma unroll
    for (int j = 0; j < 2; ++j) b[j] = *(const bf16x8*)(Bs + (wn * 64 + j * 32 + r) * LDT + ks * 16 + h * 8);
#pragma unroll
    for (int i = 0; i < 2; ++i)
#pragma unroll
      for (int j = 0; j < 2; ++j) acc[i][j] = MFMA32(a[i], b[j], acc[i][j]);
  }
  __builtin_amdgcn_s_setprio(0);
}

DI void acc_to_lds(float* Ct, f32x16 (&acc)[2][2], int wm, int wn, int r, int h) {
#pragma unroll
  for (int i = 0; i < 2; ++i)
#pragma unroll
    for (int j = 0; j < 2; ++j)
#pragma unroll
      for (int g = 0; g < 16; ++g)
        Ct[(wm * 64 + i * 32 + crow(g, h)) * CLD + wn * 64 + j * 32 + r] = acc[i][j][g];
}

DI void rope8(float* v, const float* Ct_row, int cc8, int d, int n, const Bufs& B) {
  const int axis = d >> 5, pa = axis ? (n & 63) : (n >> 6), f0 = d & 15;
  const bool first = (d & 16) == 0;
  const int pc = first ? cc8 + 16 : cc8 - 16;
  const float4 c0 = *(const float4*)(B.ropec_() + pa * 16 + f0), c1 = *(const float4*)(B.ropec_() + pa * 16 + f0 + 4);
  const float4 s0 = *(const float4*)(B.ropes_() + pa * 16 + f0), s1 = *(const float4*)(B.ropes_() + pa * 16 + f0 + 4);
  const float4 x0 = *(const float4*)(Ct_row + pc), x1 = *(const float4*)(Ct_row + pc + 4);
  const float cs[8] = {c0.x, c0.y, c0.z, c0.w, c1.x, c1.y, c1.z, c1.w};
  const float sn[8] = {s0.x, s0.y, s0.z, s0.w, s1.x, s1.y, s1.z, s1.w};
  const float xp[8] = {x0.x, x0.y, x0.z, x0.w, x1.x, x1.y, x1.z, x1.w};
#pragma unroll
  for (int e = 0; e < 8; ++e) v[e] = first ? v[e] * cs[e] - xp[e] * sn[e] : v[e] * cs[e] + xp[e] * sn[e];
}

DI void ld8(float* v, const float* src) {
  const float4 a = *(const float4*)src, b = *(const float4*)(src + 4);
  v[0] = a.x; v[1] = a.y; v[2] = a.z; v[3] = a.w; v[4] = b.x; v[5] = b.y; v[6] = b.z; v[7] = b.w;
}

template <int EPI>
DI void epilogue(const Params& p, const Bufs& B, const float* Ct, const float* rowss, int rowbase, int n0,
                 const EpiArgs& ea) {
  const int tid = otid();
  if (EPI == EPI_F32) {
#pragma unroll 1
    for (int it = 0; it < 8; ++it) {
      int id = it * 256 + tid, i = id >> 4, cc = id & 15;
      float v[8];
      ld8(v, Ct + i * CLD + cc * 8);
      *(u32x4*)((u16*)ea.outf + (size_t)(rowbase + i) * 1024 + n0 + cc * 8) = pack8(v);
    }
  } else if (EPI == EPI_POOL) {
#pragma unroll 1
    for (int it = 0; it < 8; ++it) {
      int id = it * 256 + tid, i = id >> 4, cc = id & 15;
      float v[8];
#pragma unroll
      for (int e = 0; e < 8; ++e) v[e] = Ct[i * CLD + cc * 8 + e] * p.in[15][ea.aux * 128 + cc * 8 + e];
      *(u32x4*)(B.MIX0_() + (size_t)(rowbase + i) * 1024 + ea.aux * 128 + cc * 8) = pack8(v);
    }
  } else if (EPI == EPI_IN0) {
    const int seg = n0 >> 9, b = rowbase / LT, pos0 = rowbase - b * LT;
    if (seg == 3) {
#pragma unroll 1
      for (int it = 0; it < 8; ++it) {
        int id = it * 256 + tid, c = id & 127, rc = id >> 7;
        float v[8];
#pragma unroll
        for (int e = 0; e < 8; ++e) v[e] = Ct[(rc * 8 + e) * CLD + c];
        int hc = n0 - 1536 + c, vh = hc >> 7, dv = hc & 127;
        *(u32x4*)(B.VT0_() + ((size_t)(b * 4 + vh) * 128 + dv) * LT + pos0 + rc * 8) = pack8(v);
      }
    } else {
#pragma unroll 1
      for (int it = 0; it < 8; ++it) {
        int id = it * 256 + tid, i = id >> 4, cc = id & 15;
        float v[8];
        ld8(v, Ct + i * CLD + cc * 8);
        if (seg == 0) {
          *(u32x4*)(B.U_() + (size_t)(rowbase + i) * 512 + n0 + cc * 8) = pack8(v);
        } else {
          int hc = n0 - 512 * seg + cc * 8, head = hc >> 6, d = hc & 63, pos = pos0 + i;
          if (pos >= CTX) rope8(v, Ct + i * CLD, cc * 8, d, pos - CTX, B);
          if (seg == 1) {
#pragma unroll
            for (int e = 0; e < 8; ++e) v[e] *= QS_DIFF;
          }
          u16* dst = (seg == 1 ? B.Q0_() : B.K0_()) + ((size_t)(b * 8 + head) * LT + pos) * 64 + d;
          *(u32x4*)dst = pack8(v);
        }
      }
    }
  } else if (EPI == EPI_IN1) {
    const int b = rowbase / LT, pos0 = rowbase - b * LT;
#pragma unroll 1
    for (int it = 0; it < 8; ++it) {
      int id = it * 256 + tid, i = id >> 4, cc = id & 15;
      int gc = n0 + cc * 8, pos = pos0 + i;
      size_t grow = (size_t)(rowbase + i);
      float v[8];
      ld8(v, Ct + i * CLD + cc * 8);
      if (gc < 512) {
        *(u32x4*)(B.CQ_() + grow * 512 + gc) = pack8(v);
      } else if (gc < 768) {
        *(u32x4*)(B.CKV_() + grow * 256 + (gc - 512)) = pack8(v);
      } else if (gc < 832) {
        int d = gc - 768;
        if (pos >= CTX) rope8(v, Ct + i * CLD, cc * 8, d, pos - CTX, B);
        u32x4 o = pack8(v);
#pragma unroll
        for (int hh = 0; hh < 4; ++hh) *(u32x4*)(B.KF_() + ((size_t)(b * 4 + hh) * LT + pos) * 192 + 128 + d) = o;
      } else if (gc < 1344) {
#pragma unroll
        for (int e = 0; e < 8; ++e) v[e] = siluf(v[e]);
        *(u32x4*)(B.HQ_() + grow * 512 + (gc - 832)) = pack8(v);
      } else if (gc < 2368) {
        int dir = gc >= 1856, ch = gc - (dir ? 1856 : 1344);
        u32x4 o;
        float lf[8];
        float lb8[8];
        ld8(lb8, B.lb_() + dir * 512 + ch);
#pragma unroll
        for (int e = 0; e < 8; ++e) {
          float lbv = lb8[e];
          float f = lbv + (1.f - lbv) / (1.f + __expf(-v[e]));
          lf[e] = logf(f);
        }
#pragma unroll
        for (int q = 0; q < 4; ++q) o[q] = (unsigned)f2h(lf[2 * q]) | ((unsigned)f2h(lf[2 * q + 1]) << 16);
        *(u32x4*)(B.LF_() + (size_t)dir * M * 512 + grow * 512 + ch) = o;
      } else if (gc < 2880) {
        *(u32x4*)(B.HI_() + grow * 512 + (gc - 2368)) = pack8(v);
      } else if (gc < 3392) {
        *(u32x4*)(B.HG_() + grow * 512 + (gc - 2880)) = pack8(v);
      }
    }
  } else if (EPI == EPI_UQ) {
    const int b = rowbase / LT, nl0 = rowbase - b * LT - CTX;
#pragma unroll 1
    for (int it = 0; it < 8; ++it) {
      int id = it * 256 + tid, i = id >> 4, cc = id & 15;
      int gc = n0 + cc * 8, head = gc / 192, dd = gc - head * 192, n = nl0 + i;
      float v[8];
      ld8(v, Ct + i * CLD + cc * 8);
      if (dd >= 128) rope8(v, Ct + i * CLD, cc * 8, dd - 128, n, B);
      const float s = rsqrtf(rowss[i] * (1.f / 512.f) + EPS) * QS_MLA;
#pragma unroll
      for (int e = 0; e < 8; ++e) v[e] *= s;
      *(u32x4*)(B.QF_() + ((size_t)(b * 4 + head) * SEQ + n) * 192 + dd) = pack8(v);
    }
  } else if (EPI == EPI_UKV) {
    const int b = rowbase / LT, pos0 = rowbase - b * LT, head = n0 >> 8;
    if ((n0 & 128) == 0) {
#pragma unroll 1
      for (int it = 0; it < 8; ++it) {
        int id = it * 256 + tid, i = id >> 4, cc = id & 15;
        const float s = rsqrtf(rowss[i] * (1.f / 256.f) + EPS);
        float v[8];
#pragma unroll
        for (int e = 0; e < 8; ++e) v[e] = Ct[i * CLD + cc * 8 + e] * s;
        *(u32x4*)(B.KF_() + ((size_t)(b * 4 + head) * LT + pos0 + i) * 192 + cc * 8) = pack8(v);
      }
    } else {
#pragma unroll 1
      for (int it = 0; it < 8; ++it) {
        int id = it * 256 + tid, c = id & 127, rc = id >> 7;
        float v[8];
#pragma unroll
        for (int e = 0; e < 8; ++e)
          v[e] = Ct[(rc * 8 + e) * CLD + c] * rsqrtf(rowss[rc * 8 + e] * (1.f / 256.f) + EPS);
        *(u32x4*)(B.VT1_() + ((size_t)(b * 4 + head) * 128 + c) * LT + pos0 + rc * 8) = pack8(v);
      }
    }
  } else if (EPI == EPI_FFN1) {
    const int nt = n0 >> 7;
    const float* cw = p.in[10] + (size_t)ea.layer * 3 * DFF;
    const float* cb = p.in[11] + (size_t)ea.layer * DFF;
    u16* G = ea.layer ? B.G1_() : B.G0_();
#pragma unroll 1
    for (int it = 0; it < 4; ++it) {
      int id = it * 256 + tid, i = id >> 3, cc = id & 7;
      int grow = rowbase + i;
      if (i >= 1 && i <= 126 && grow < ea.seg_hi) {
        const bool hp = (grow - 1 >= ea.seg_lo), hn = (grow + 1 < ea.seg_hi);
        float a[8], ap[8], an[8], u[8], w0[8], w1[8], w2[8], bb[8], v[8];
        const int fc0 = nt * 64 + cc * 8;
        ld8(a, Ct + i * CLD + cc * 8); ld8(ap, Ct + (i - 1) * CLD + cc * 8); ld8(an, Ct + (i + 1) * CLD + cc * 8);
        ld8(u, Ct + i * CLD + 64 + cc * 8);
        ld8(w0, cw + fc0); ld8(w1, cw + DFF + fc0); ld8(w2, cw + 2 * DFF + fc0); ld8(bb, cb + fc0);
#pragma unroll
        for (int e = 0; e < 8; ++e) {
          float av = (hp ? ap[e] : 0.f) * w0[e] + a[e] * w1[e] + (hn ? an[e] : 0.f) * w2[e] + bb[e];
          v[e] = siluf(av) * u[e];
        }
        *(u32x4*)(G + (size_t)grow * DFF + nt * 64 + cc * 8) = pack8(v);
      }
    }
  }
}

template <int EPI, bool SUMSQ>
DI void gemm_tile(char* smem, const Params& p, const Bufs& B, const u16* __restrict__ A, int lda, int rowbase,
                  int rlo, int rhi, const u16* __restrict__ Bt, int K, int n0, const EpiArgs& ea, int live) {
  u16* As = (u16*)smem;
  u16* Bs = As + 2 * 128 * LDT;
  float* Ct = (float*)smem;
  float* rowss = Ct + 128 * CLD;
  const int tid = otid(), lane = tid & 63, wid = tid >> 6, wm = wid >> 1, wn = wid & 1, r = lane & 31,
            h = lane >> 5;
  const int lrow = tid >> 3, lkc = tid & 7;
  int aoff[4], boff[4];
#pragma unroll
  for (int it = 0; it < 4; ++it) {
    int gr = rowbase + it * 32 + lrow;
    gr = gr < rlo ? rlo : (gr > rhi - 1 ? rhi - 1 : gr);
    aoff[it] = gr * lda + lkc * 8;
    boff[it] = (n0 + it * 32 + lrow) * K + lkc * 8;
  }
  u32x4 ra0[4], rb0[4], ra1[4], rb1[4];
  float ssq[4] = {0.f, 0.f, 0.f, 0.f};
  f32x16 acc[2][2];
#pragma unroll
  for (int i = 0; i < 2; ++i)
#pragma unroll
    for (int j = 0; j < 2; ++j)
#pragma unroll
      for (int g = 0; g < 16; ++g) acc[i][j][g] = 0.f;
  const int nk = K >> 6;
#pragma unroll
  for (int it = 0; it < 4; ++it) {
    ra0[it] = *(const u32x4*)(A + aoff[it]);
    rb0[it] = *(const u32x4*)(Bt + boff[it]);
  }
#pragma unroll
  for (int it = 0; it < 4; ++it) {
    ra1[it] = *(const u32x4*)(A + aoff[it] + 64);
    rb1[it] = *(const u32x4*)(Bt + boff[it] + 64);
  }
#define GEMM_STEP(RA, RB, BUF, TNEXT)                                                  \
  {                                                                                    \
    u16* Aw = As + (BUF) * 128 * LDT;                                                  \
    u16* Bw = Bs + (BUF) * 128 * LDT;                                                  \
    _Pragma("unroll") for (int it = 0; it < 4; ++it) {                                 \
      *(u32x4*)(Aw + (it * 32 + lrow) * LDT + lkc * 8) = RA[it];                       \
      *(u32x4*)(Bw + (it * 32 + lrow) * LDT + lkc * 8) = RB[it];                       \
      if (SUMSQ) {                                                                     \
        _Pragma("unroll") for (int q = 0; q < 4; ++q) {                                \
          float lo = bflo(RA[it][q]), hi = bfhi(RA[it][q]);                            \
          ssq[it] += lo * lo + hi * hi;                                                \
        }                                                                              \
      }                                                                                \
    }                                                                                  \
    __syncthreads();                                                                   \
    if ((TNEXT) < nk) {                                                                \
      _Pragma("unroll") for (int it = 0; it < 4; ++it) {                               \
        RA[it] = *(const u32x4*)(A + aoff[it] + (TNEXT) * 64);                         \
        RB[it] = *(const u32x4*)(Bt + boff[it] + (TNEXT) * 64);                        \
      }                                                                                \
    }                                                                                  \
    mma_ktile(Aw, Bw, acc, wm, wn, r, h);                                              \
  }
  for (int t = 0; t < nk; t += 2) {
    GEMM_STEP(ra0, rb0, 0, t + 2)
    GEMM_STEP(ra1, rb1, 1, t + 3)
  }
#undef GEMM_STEP
  __syncthreads();
  acc_to_lds(Ct, acc, wm, wn, r, h);
  if (SUMSQ) {
#pragma unroll
    for (int it = 0; it < 4; ++it) {
      float s = ssq[it];
      s += __shfl_xor(s, 1); s += __shfl_xor(s, 2); s += __shfl_xor(s, 4);
      if (lkc == 0) rowss[it * 32 + lrow] = s;
    }
  }
  __syncthreads();
  if (live) epilogue<EPI>(p, B, Ct, rowss, rowbase, n0, ea);
  __syncthreads();
}

DI void pool_tile(char* smem, const Params& p, const Bufs& B, int rt, int g) {
  u16* As = (u16*)smem;
  u16* Bs = As + 2 * 128 * LDT;
  float* Ct = (float*)smem;
  const int tid = otid(), lane = tid & 63, wid = tid >> 6, wm = wid >> 1, wn = wid & 1, r = lane & 31,
            h = lane >> 5;
  const int rowbase = rt * 128;
  const int b = rowbase / LT, pos0 = rowbase - b * LT;
  const int seg_lo = (pos0 < CTX) ? b * LT : b * LT + CTX;
  const int seg_hi = (pos0 < CTX) ? b * LT + CTX : (b + 1) * LT;
  u16* Ust = Bs;
#pragma unroll 1
  for (int it = 0; it < 9; ++it) {
    int c = it * 256 + tid, rr = c >> 4, kc = c & 15;
    int grow = rowbase - 8 + rr;
    if (grow >= seg_lo && grow < seg_hi)
      *(u32x4*)(Ust + rr * 128 + kc * 8) = *(const u32x4*)(B.U_() + (size_t)grow * 512 + g * 128 + kc * 8);
  }
  __syncthreads();
  {
    const int ch = tid & 127, rh = tid >> 7, hw = 1 << g;
    const u16* Uc = Ust + ch;
    const int bl = 8 - rowbase;
    const int t0 = rowbase + rh * 64;
    int lo = max(t0 - hw, seg_lo), hi = min(t0 + hw, seg_hi);
    float sum = 0.f;
    for (int s2 = lo; s2 < hi; ++s2) sum += bf2f(Uc[(s2 + bl) * 128]);
    u16* Ad = As + (ch >> 6) * 128 * LDT + (ch & 63);
    for (int i = 0; i < 64; ++i) {
      int t = t0 + i;
      float cnt = (float)(hi - lo);
      float d = sum / cnt - bf2f(Uc[(t + bl) * 128]);
      Ad[(rh * 64 + i) * LDT] = f2bf(d);
      if (t + hw < seg_hi) { sum += bf2f(Uc[(t + hw + bl) * 128]); hi = t + hw + 1; }
      if (t - hw >= seg_lo) { sum -= bf2f(Uc[(t - hw + bl) * 128]); lo = t - hw + 1; }
    }
  }
  __syncthreads();
#pragma unroll
  for (int it = 0; it < 8; ++it) {
    int c = it * 256 + tid, n = c >> 4, kc = c & 15;
    u32x4 v = *(const u32x4*)(B.wt_pool_() + (size_t)g * 128 * 128 + n * 128 + kc * 8);
    *(u32x4*)(Bs + (kc >> 3) * 128 * LDT + n * LDT + (kc & 7) * 8) = v;
  }
  __syncthreads();
  f32x16 acc[2][2];
#pragma unroll
  for (int i = 0; i < 2; ++i)
#pragma unroll
    for (int j = 0; j < 2; ++j)
#pragma unroll
      for (int q = 0; q < 16; ++q) acc[i][j][q] = 0.f;
  mma_ktile(As, Bs, acc, wm, wn, r, h);
  mma_ktile(As + 128 * LDT, Bs + 128 * LDT, acc, wm, wn, r, h);
  __syncthreads();
  acc_to_lds(Ct, acc, wm, wn, r, h);
  __syncthreads();
  EpiArgs ea{}; ea.aux = g;
  epilogue<EPI_POOL>(p, B, Ct, nullptr, rowbase, 0, ea);
  __syncthreads();
}

template <int DQK, int KT>
DI void attn_pass_sb(char* smem, const u16* __restrict__ Qg, const u16* __restrict__ Kg, const u16* __restrict__ VTg,
                  int nk, f32x16 (&O)[4], float& l_out, float* m_out = nullptr) {
  constexpr int KLD = DQK + 8, NKS = DQK / 16, KCH = DQK / 8, KPT = KT * KCH / 256, VLD = KT + 8, VPT = KT / 16,
                KB = KT / 32, VCH = KT / 8;
  u16* Ks = (u16*)smem;
  u16* Vs = Ks + KT * KLD;
  const int tid = otid(), lane = tid & 63, wid = tid >> 6, r = lane & 31, h = lane >> 5;
  bf16x8 qf[NKS];
#pragma unroll
  for (int ks = 0; ks < NKS; ++ks) qf[ks] = *(const bf16x8*)(Qg + (size_t)(wid * 32 + r) * DQK + ks * 16 + h * 8);
  u32x4 rk[KPT], rv[VPT];
#pragma unroll
  for (int dvb = 0; dvb < 4; ++dvb)
#pragma unroll
    for (int g = 0; g < 16; ++g) O[dvb][g] = 0.f;
  float m = -1e30f, l = 0.f;
  const int nt = nk / KT;
  int kgo[KPT], klo[KPT], vgo[VPT], vlo[VPT];
#pragma unroll
  for (int it = 0; it < KPT; ++it) {
    int c = it * 256 + tid, key = c / KCH, kc = c - key * KCH;
    int rho = (key & ~12) | ((key & 4) << 1) | ((key & 8) >> 1);
    kgo[it] = key * DQK + kc * 8;
    klo[it] = rho * KLD + kc * 8;
  }
#pragma unroll
  for (int it = 0; it < VPT; ++it) {
    int c = it * 256 + tid, dv = c / VCH, kc = c - dv * VCH;
    vgo[it] = dv * LT + kc * 8;
    vlo[it] = dv * VLD + kc * 8;
  }
#pragma unroll
  for (int it = 0; it < KPT; ++it) rk[it] = *(const u32x4*)(Kg + kgo[it]);
#pragma unroll
  for (int it = 0; it < VPT; ++it) rv[it] = *(const u32x4*)(VTg + vgo[it]);
  for (int t = 0; t < nt; ++t) {
    __syncthreads();
#pragma unroll
    for (int it = 0; it < KPT; ++it) *(u32x4*)(Ks + klo[it]) = rk[it];
#pragma unroll
    for (int it = 0; it < VPT; ++it) *(u32x4*)(Vs + vlo[it]) = rv[it];
    __syncthreads();
    if (t + 1 < nt) {
      const u16* Kn = Kg + (size_t)(t + 1) * KT * DQK;
      const u16* Vn = VTg + (t + 1) * KT;
#pragma unroll
      for (int it = 0; it < KPT; ++it) rk[it] = *(const u32x4*)(Kn + kgo[it]);
#pragma unroll
      for (int it = 0; it < VPT; ++it) rv[it] = *(const u32x4*)(Vn + vgo[it]);
    }
    f32x16 S[KB];
#pragma unroll
    for (int kb = 0; kb < KB; ++kb) {
#pragma unroll
      for (int g = 0; g < 16; ++g) S[kb][g] = 0.f;
#pragma unroll
      for (int ks = 0; ks < NKS; ++ks) {
        bf16x8 a = *(const bf16x8*)(Ks + (kb * 32 + r) * KLD + ks * 16 + h * 8);
        S[kb] = MFMA32(a, qf[ks], S[kb]);
      }
    }
    float mx = -1e30f;
#pragma unroll
    for (int kb = 0; kb < KB; ++kb)
#pragma unroll
      for (int g = 0; g < 16; ++g) mx = fmaxf(mx, S[kb][g]);
    mx = fmaxf(mx, __shfl_xor(mx, 32));
    const bool chg = __any(mx > m + 8.f);
    float alpha = 1.f;
    if (chg) { const float mn_ = fmaxf(m, mx); alpha = __builtin_amdgcn_exp2f(m - mn_); m = mn_; }
    const float mn = m;
    float ps = 0.f;
#pragma unroll
    for (int kb = 0; kb < KB; ++kb)
#pragma unroll
      for (int g = 0; g < 16; ++g) {
        float pv = __builtin_amdgcn_exp2f(S[kb][g] - mn);
        S[kb][g] = pv;
        ps += pv;
      }
    l = l * alpha + ps;
    if (chg) {
#pragma unroll
      for (int dvb = 0; dvb < 4; ++dvb)
#pragma unroll
        for (int g = 0; g < 16; ++g) O[dvb][g] *= alpha;
    }
    bf16x8 pf[KB][2];
#pragma unroll
    for (int kb = 0; kb < KB; ++kb)
#pragma unroll
      for (int s = 0; s < 2; ++s) {
        u32x4 o;
#pragma unroll
        for (int q = 0; q < 4; ++q) o[q] = pk2(S[kb][8 * s + 2 * q], S[kb][8 * s + 2 * q + 1]);
        pf[kb][s] = __builtin_bit_cast(bf16x8, o);
      }
#pragma unroll
    for (int dvb = 0; dvb < 4; ++dvb) {
#pragma unroll
      for (int kb = 0; kb < KB; ++kb)
#pragma unroll
        for (int s = 0; s < 2; ++s) {
          bf16x8 a = *(const bf16x8*)(Vs + (dvb * 32 + r) * VLD + kb * 32 + s * 16 + h * 8);
          O[dvb] = MFMA32(a, pf[kb][s], O[dvb]);
        }
      if (dvb & 1) asm volatile("" ::: "memory");
    }
  }
  l_out = l + __shfl_xor(l, 32);
  if (m_out) *m_out = m;
}

template <int DQK, int KT, int NT>
DI void attn_pass(char* smem, const u16* __restrict__ Qg, const u16* __restrict__ Kg, const u16* __restrict__ VTg,
                  int nk, f32x16 (&O)[4], float& l_out) {
  constexpr int KLD = DQK + 8, NKS = DQK / 16, KCH = DQK / 8, KPT = KT * KCH / NT, VLD = KT + 8, VPT = 128 * (KT / 8) / NT,
                KB = KT / 32, VCH = KT / 8, STAGE = KT * KLD + 128 * VLD;
  u16* base = (u16*)smem;
  const int tid = otidn<NT>(), lane = tid & 63, wid = tid >> 6, r = lane & 31, h = lane >> 5;
  bf16x8 qf[NKS];
#pragma unroll
  for (int ks = 0; ks < NKS; ++ks) qf[ks] = *(const bf16x8*)(Qg + (size_t)(wid * 32 + r) * DQK + ks * 16 + h * 8);
  u32x4 rk[KPT], rv[VPT];
#pragma unroll
  for (int dvb = 0; dvb < 4; ++dvb)
#pragma unroll
    for (int g = 0; g < 16; ++g) O[dvb][g] = 0.f;
  float m = -1e30f, l = 0.f;
  const int nt = nk / KT;
#define KGO(it, T) ({ int c_ = (it) * NT + (T), key_ = c_ / KCH; key_ * DQK + (c_ - key_ * KCH) * 8; })
#define KLO(it, T) ({ int c_ = (it) * NT + (T), key_ = c_ / KCH, kc_ = c_ - key_ * KCH; \
                      int rho_ = (key_ & ~12) | ((key_ & 4) << 1) | ((key_ & 8) >> 1); rho_ * KLD + kc_ * 8; })
#define VGO(it, T) ({ int c_ = (it) * NT + (T), dv_ = c_ / VCH; dv_ * LT + (c_ - dv_ * VCH) * 8; })
#define VLO(it, T) ({ int c_ = (it) * NT + (T), dv_ = c_ / VCH; KT * KLD + dv_ * VLD + (c_ - dv_ * VCH) * 8; })
  { const int tq = otidn<NT>();
#pragma unroll
  for (int it = 0; it < KPT; ++it) rk[it] = *(const u32x4*)(Kg + KGO(it, tq));
#pragma unroll
  for (int it = 0; it < VPT; ++it) rv[it] = *(const u32x4*)(VTg + VGO(it, tq));
  __syncthreads();
#pragma unroll
  for (int it = 0; it < KPT; ++it) *(u32x4*)(base + KLO(it, tq)) = rk[it];
#pragma unroll
  for (int it = 0; it < VPT; ++it) *(u32x4*)(base + VLO(it, tq)) = rv[it];
  if (nt > 1) {
#pragma unroll
    for (int it = 0; it < KPT; ++it) rk[it] = *(const u32x4*)(Kg + (size_t)KT * DQK + KGO(it, tq));
#pragma unroll
    for (int it = 0; it < VPT; ++it) rv[it] = *(const u32x4*)(VTg + KT + VGO(it, tq));
  }
  }
  __syncthreads();
  for (int t = 0; t < nt; ++t) {
    const u16* Ks = base + (t & 1) * STAGE;
    const u16* Vs = Ks + KT * KLD;
    f32x16 S[KB];
#pragma unroll
    for (int kb = 0; kb < KB; ++kb) {
#pragma unroll
      for (int g = 0; g < 16; ++g) S[kb][g] = 0.f;
#pragma unroll
      for (int ks = 0; ks < NKS; ++ks) {
        bf16x8 a = *(const bf16x8*)(Ks + (kb * 32 + r) * KLD + ks * 16 + h * 8);
        S[kb] = MFMA32(a, qf[ks], S[kb]);
      }
    }
    __builtin_amdgcn_sched_group_barrier(0x100, 2, 0);
#pragma unroll
    for (int i = 0; i < KB * NKS - 2; ++i) {
      __builtin_amdgcn_sched_group_barrier(0x008, 1, 0);
      __builtin_amdgcn_sched_group_barrier(0x100, 1, 0);
    }
    __builtin_amdgcn_sched_group_barrier(0x008, 2, 0);
    if (t + 1 < nt) {
      const int tq = otidn<NT>();
      u16* nb_ = base + ((t + 1) & 1) * STAGE;
#pragma unroll
      for (int it = 0; it < KPT; ++it) *(u32x4*)(nb_ + KLO(it, tq)) = rk[it];
#pragma unroll
      for (int it = 0; it < VPT; ++it) *(u32x4*)(nb_ + VLO(it, tq)) = rv[it];
      if (t + 2 < nt) {
        const u16* Kn = Kg + (size_t)(t + 2) * KT * DQK;
        const u16* Vn = VTg + (t + 2) * KT;
#pragma unroll
        for (int it = 0; it < KPT; ++it) rk[it] = *(const u32x4*)(Kn + KGO(it, tq));
#pragma unroll
        for (int it = 0; it < VPT; ++it) rv[it] = *(const u32x4*)(Vn + VGO(it, tq));
      }
    }
    float mx = -1e30f;
#pragma unroll
    for (int kb = 0; kb < KB; ++kb)
#pragma unroll
      for (int g = 0; g < 16; ++g) mx = fmaxf(mx, S[kb][g]);
    mx = fmaxf(mx, __shfl_xor(mx, 32));
    const bool chg = __any(mx > m + 8.f);
    float alpha = 1.f;
    if (chg) { const float mn_ = fmaxf(m, mx); alpha = __builtin_amdgcn_exp2f(m - mn_); m = mn_; }
    const float mn = m;
    float ps = 0.f;
#pragma unroll
    for (int kb = 0; kb < KB; ++kb)
#pragma unroll
      for (int g = 0; g < 16; ++g) {
        float pv = __builtin_amdgcn_exp2f(S[kb][g] - mn);
        S[kb][g] = pv;
        ps += pv;
      }
    l = l * alpha + ps;
    if (chg) {
#pragma unroll
      for (int dvb = 0; dvb < 4; ++dvb)
#pragma unroll
        for (int g = 0; g < 16; ++g) O[dvb][g] *= alpha;
    }
    bf16x8 pf[KB][2];
#pragma unroll
    for (int kb = 0; kb < KB; ++kb)
#pragma unroll
      for (int s = 0; s < 2; ++s) {
        u32x4 o;
#pragma unroll
        for (int q = 0; q < 4; ++q) o[q] = pk2(S[kb][8 * s + 2 * q], S[kb][8 * s + 2 * q + 1]);
        pf[kb][s] = __builtin_bit_cast(bf16x8, o);
      }
#pragma unroll
    for (int dvb = 0; dvb < 4; ++dvb) {
#pragma unroll
      for (int kb = 0; kb < KB; ++kb)
#pragma unroll
        for (int s = 0; s < 2; ++s) {
          bf16x8 a = *(const bf16x8*)(Vs + (dvb * 32 + r) * VLD + kb * 32 + s * 16 + h * 8);
          O[dvb] = MFMA32(a, pf[kb][s], O[dvb]);
        }
    }
    __builtin_amdgcn_sched_group_barrier(0x100, 2, 0);
#pragma unroll
    for (int i = 0; i < 4 * KB * 2 - 2; ++i) {
      __builtin_amdgcn_sched_group_barrier(0x008, 1, 0);
      __builtin_amdgcn_sched_group_barrier(0x100, 1, 0);
    }
    __builtin_amdgcn_sched_group_barrier(0x008, 2, 0);
    __syncthreads();
  }
  l_out = l + __shfl_xor(l, 32);
#undef KGO
#undef KLO
#undef VGO
#undef VLO
}

DI void diff_attn_item(char* smem, const Params& p, const Bufs& B, int b, int vh, int pos0, int nk) {
  const int tid = otid(), lane = tid & 63, wid = tid >> 6, r = lane & 31, h = lane >> 5;
  f32x16 O[4];
  unsigned* Okl = (unsigned*)(smem + 40960);
  const float lam = B.lam_()[0];
  const u16* VT = B.VT0_() + (size_t)(b * 4 + vh) * 128 * LT;
  float ss = 0.f;
#pragma unroll
  for (int e = 0; e < 2; ++e) {
    const int head = 2 * vh + e;
    const u16* Q = B.Q0_() + ((size_t)(b * 8 + head) * LT + pos0) * 64;
    const u16* K = B.K0_() + (size_t)(b * 8 + head) * LT * 64;
    float l;
    attn_pass_sb<64, 64>(smem, Q, K, VT, nk, O, l);
    const float inv = 1.f / l;
    if (e == 0) {
#pragma unroll
      for (int dvb = 0; dvb < 4; ++dvb)
#pragma unroll
        for (int q = 0; q < 8; ++q) Okl[(dvb * 8 + q) * 256 + tid] = pk2(O[dvb][2 * q] * inv, O[dvb][2 * q + 1] * inv);
    } else {
#pragma unroll
      for (int dvb = 0; dvb < 4; ++dvb)
#pragma unroll
        for (int q = 0; q < 8; ++q) {
          unsigned o0 = Okl[(dvb * 8 + q) * 256 + tid];
          float a0 = bflo(o0) - lam * (O[dvb][2 * q] * inv), a1 = bfhi(o0) - lam * (O[dvb][2 * q + 1] * inv);
          O[dvb][2 * q] = a0; O[dvb][2 * q + 1] = a1;
          ss += a0 * a0 + a1 * a1;
        }
    }
  }
  ss += __shfl_xor(ss, 32);
  const float rstd = rsqrtf(ss * (1.f / 128.f) + EPS) * 0.8f;
  const float* sub = p.in[17];
  u16* orow = B.MIX0_() + (size_t)(b * LT + pos0 + wid * 32 + r) * 1024 + 512 + vh * 128;
#pragma unroll
  for (int dvb = 0; dvb < 4; ++dvb)
#pragma unroll
    for (int g = 0; g < 4; ++g) {
      int dv0 = dvb * 32 + 8 * g + 4 * h;
      u32x2 o;
      o[0] = pk2(O[dvb][4 * g] * rstd * sub[dv0], O[dvb][4 * g + 1] * rstd * sub[dv0 + 1]);
      o[1] = pk2(O[dvb][4 * g + 2] * rstd * sub[dv0 + 2], O[dvb][4 * g + 3] * rstd * sub[dv0 + 3]);
      *(u32x2*)(orow + dv0) = o;
    }
}

DI void mla_attn_item(char* smem_wg, char* smem, const Bufs& B, int b, int hd, int qt, bool split, int VB) {
  const int tid = otid(), lane = tid & 63, wid = tid >> 6, r = lane & 31, h = lane >> 5;
  f32x16 O[4];
  float l, m;
  const int key0 = split ? VB * 2176 : 0;
  const u16* Q = B.QF_() + ((size_t)(b * 4 + hd) * SEQ + qt * 128) * 192;
  const u16* K = B.KF_() + ((size_t)(b * 4 + hd) * LT + key0) * 192;
  const u16* VT = B.VT1_() + (size_t)(b * 4 + hd) * 128 * LT + key0;
  attn_pass_sb<192, 64>(smem, Q, K, VT, split ? 2176 : LT, O, l, &m);
  float a0 = 1.f, a1 = 0.f, inv;
  float* X = (float*)(smem_wg + SMEM_HALF);
  if (split) {
    __syncthreads();
    if (VB == 1) {
#pragma unroll
      for (int dvb = 0; dvb < 4; ++dvb)
#pragma unroll
        for (int g = 0; g < 16; ++g) X[(dvb * 16 + g) * 256 + tid] = O[dvb][g];
      X[64 * 256 + tid] = m; X[65 * 256 + tid] = l;
    }
    __syncthreads();
    const float m1 = X[64 * 256 + tid], l1 = X[65 * 256 + tid];
    const float mm = fmaxf(m, m1);
    a0 = __builtin_amdgcn_exp2f(m - mm); a1 = __builtin_amdgcn_exp2f(m1 - mm);
    inv = 1.f / (l * a0 + l1 * a1);
  } else {
    inv = 1.f / l;
  }
  if (!split || VB == 0) {
    u16* orow = B.MIX1_() + (size_t)(b * LT + CTX + qt * 128 + wid * 32 + r) * 1024 + hd * 128;
#pragma unroll
    for (int dvb = 0; dvb < 4; ++dvb)
#pragma unroll
      for (int g = 0; g < 4; ++g) {
        int dv0 = dvb * 32 + 8 * g + 4 * h;
        float v[4];
#pragma unroll
        for (int e = 0; e < 4; ++e) {
          float x = O[dvb][4 * g + e] * a0;
          if (split) x += X[(dvb * 16 + 4 * g + e) * 256 + tid] * a1;
          v[e] = x * inv;
        }
        u32x2 o;
        o[0] = pk2(v[0], v[1]); o[1] = pk2(v[2], v[3]);
        *(u32x2*)(orow + dv0) = o;
      }
  }
  if (split) __syncthreads();
}


DI void attn_pass_pp(char* smem, const u16* __restrict__ Qg, const u16* __restrict__ Kg, const u16* __restrict__ VTg,
                     int nk, f32x16 (&O)[4], float& l_out) {
  constexpr int DQK = 64, KT = 64, KLD = 72, VLD = 72, KSZ = KT * KLD, VSZ = 128 * VLD;
  u16* Kb = (u16*)smem;
  u16* Vb = Kb + 3 * KSZ;
  const int tid = otidn<512>(), lane = tid & 63, wid = tid >> 6, r = lane & 31, h = lane >> 5;
  bf16x8 qf[4];
#pragma unroll
  for (int ks = 0; ks < 4; ++ks) qf[ks] = *(const bf16x8*)(Qg + (size_t)(wid * 32 + r) * DQK + ks * 16 + h * 8);
#pragma unroll
  for (int dvb = 0; dvb < 4; ++dvb)
#pragma unroll
    for (int g = 0; g < 16; ++g) O[dvb][g] = 0.f;
  float m = -1e30f, l = 0.f;
  const int nt = nk / KT;
  const int kkey = tid >> 3, kkc = tid & 7;
  const int krho = (kkey & ~12) | ((kkey & 4) << 1) | ((kkey & 8) >> 1);
  const int kgo = kkey * DQK + kkc * 8, klo = krho * KLD + kkc * 8;
  const int vdv0 = tid >> 3, vkc = tid & 7;
  const int vgo0 = vdv0 * LT + vkc * 8, vlo0 = vdv0 * VLD + vkc * 8;
  u32x4 rk, rv0, rv1;
#define PP_QK(Sx, kbuf) {                                                                 \
    const u16* Ks_ = Kb + (kbuf) * KSZ;                                                   \
    _Pragma("unroll") for (int kb = 0; kb < 2; ++kb) {                                    \
      _Pragma("unroll") for (int g = 0; g < 16; ++g) Sx[kb][g] = 0.f;                     \
      _Pragma("unroll") for (int ks = 0; ks < 4; ++ks) {                                  \
        bf16x8 a_ = *(const bf16x8*)(Ks_ + (kb * 32 + r) * KLD + ks * 16 + h * 8);        \
        Sx[kb] = MFMA32(a_, qf[ks], Sx[kb]);                                              \
      } } }
  __syncthreads();
  rk = *(const u32x4*)(Kg + kgo);
  rv0 = *(const u32x4*)(VTg + vgo0); rv1 = *(const u32x4*)(VTg + vgo0 + 64 * LT);
  *(u32x4*)(Kb + klo) = rk;
  *(u32x4*)(Vb + vlo0) = rv0; *(u32x4*)(Vb + vlo0 + 64 * VLD) = rv1;
  if (nt > 1) { rk = *(const u32x4*)(Kg + (size_t)KT * DQK + kgo); *(u32x4*)(Kb + KSZ + klo) = rk; }
  __syncthreads();
  f32x16 Sc[2], Sn[2];
  PP_QK(Sc, 0)
  if (nt > 2) rk = *(const u32x4*)(Kg + (size_t)2 * KT * DQK + kgo);
  if (nt > 1) { rv0 = *(const u32x4*)(VTg + KT + vgo0); rv1 = *(const u32x4*)(VTg + KT + vgo0 + 64 * LT); }
  int kb_cur = 0;
  for (int t = 0; t < nt; ++t) {
    const int kb_n1 = kb_cur == 2 ? 0 : kb_cur + 1, kb_n2 = kb_n1 == 2 ? 0 : kb_n1 + 1;
    if (t + 1 < nt) PP_QK(Sn, kb_n1)
    float mx = -1e30f;
#pragma unroll
    for (int kb = 0; kb < 2; ++kb)
#pragma unroll
      for (int g = 0; g < 16; ++g) mx = fmaxf(mx, Sc[kb][g]);
    mx = fmaxf(mx, __shfl_xor(mx, 32));
    const bool chg = __any(mx > m + 8.f);
    float alpha = 1.f;
    if (chg) { const float mn_ = fmaxf(m, mx); alpha = __builtin_amdgcn_exp2f(m - mn_); m = mn_; }
    const float mn = m;
    float ps = 0.f;
#pragma unroll
    for (int kb = 0; kb < 2; ++kb)
#pragma unroll
      for (int g = 0; g < 16; ++g) {
        float pv = __builtin_amdgcn_exp2f(Sc[kb][g] - mn);
        Sc[kb][g] = pv;
        ps += pv;
      }
    l = l * alpha + ps;
    if (chg) {
#pragma unroll
      for (int dvb = 0; dvb < 4; ++dvb)
#pragma unroll
        for (int g = 0; g < 16; ++g) O[dvb][g] *= alpha;
    }
    bf16x8 pf[2][2];
#pragma unroll
    for (int kb = 0; kb < 2; ++kb)
#pragma unroll
      for (int s2 = 0; s2 < 2; ++s2) {
        u32x4 o;
#pragma unroll
        for (int q = 0; q < 4; ++q) o[q] = pk2(Sc[kb][8 * s2 + 2 * q], Sc[kb][8 * s2 + 2 * q + 1]);
        pf[kb][s2] = __builtin_bit_cast(bf16x8, o);
      }
    {
      const u16* Vs = Vb + (t & 1) * VSZ;
#pragma unroll
      for (int dvb = 0; dvb < 4; ++dvb)
#pragma unroll
        for (int kb = 0; kb < 2; ++kb)
#pragma unroll
          for (int s2 = 0; s2 < 2; ++s2) {
            bf16x8 a = *(const bf16x8*)(Vs + (dvb * 32 + r) * VLD + kb * 32 + s2 * 16 + h * 8);
            O[dvb] = MFMA32(a, pf[kb][s2], O[dvb]);
          }
    }
    if (t + 2 < nt) *(u32x4*)(Kb + kb_n2 * KSZ + klo) = rk;
    if (t + 1 < nt) { u16* Vn = Vb + ((t + 1) & 1) * VSZ; *(u32x4*)(Vn + vlo0) = rv0; *(u32x4*)(Vn + vlo0 + 64 * VLD) = rv1; }
    if (t + 3 < nt) rk = *(const u32x4*)(Kg + (size_t)(t + 3) * KT * DQK + kgo);
    if (t + 2 < nt) { const u16* Vg = VTg + (t + 2) * KT; rv0 = *(const u32x4*)(Vg + vgo0); rv1 = *(const u32x4*)(Vg + vgo0 + 64 * LT); }
    __syncthreads();
#pragma unroll
    for (int kb = 0; kb < 2; ++kb) Sc[kb] = Sn[kb];
    kb_cur = kb_n1;
  }
#undef PP_QK
  l_out = l + __shfl_xor(l, 32);
}

DI void diff_attn_item8(char* smem_wg, const Params& p, const Bufs& B, int b, int vh, int pos0, int nk) {
  const int tid = otidn<512>(), lane = tid & 63, wid = tid >> 6, r = lane & 31, h = lane >> 5;
  f32x16 O[4];
  unsigned* Okl = (unsigned*)(smem_wg + 65536);
  const float lam = B.lam_()[0];
  const u16* VT = B.VT0_() + (size_t)(b * 4 + vh) * 128 * LT;
  float ss = 0.f;
#pragma unroll
  for (int e = 0; e < 2; ++e) {
    const int head = 2 * vh + e;
    const u16* Q = B.Q0_() + ((size_t)(b * 8 + head) * LT + pos0) * 64;
    const u16* K = B.K0_() + (size_t)(b * 8 + head) * LT * 64;
    float l;
    attn_pass_pp(smem_wg, Q, K, VT, nk, O, l);
    const float inv = 1.f / l;
    if (e == 0) {
#pragma unroll
      for (int dvb = 0; dvb < 4; ++dvb)
#pragma unroll
        for (int q = 0; q < 8; ++q) Okl[(dvb * 8 + q) * 512 + tid] = pk2(O[dvb][2 * q] * inv, O[dvb][2 * q + 1] * inv);
    } else {
#pragma unroll
      for (int dvb = 0; dvb < 4; ++dvb)
#pragma unroll
        for (int q = 0; q < 8; ++q) {
          unsigned o0 = Okl[(dvb * 8 + q) * 512 + tid];
          float a0 = bflo(o0) - lam * (O[dvb][2 * q] * inv), a1 = bfhi(o0) - lam * (O[dvb][2 * q + 1] * inv);
          O[dvb][2 * q] = a0; O[dvb][2 * q + 1] = a1;
          ss += a0 * a0 + a1 * a1;
        }
    }
  }
  ss += __shfl_xor(ss, 32);
  const float rstd = rsqrtf(ss * (1.f / 128.f) + EPS) * 0.8f;
  const float* sub = p.in[17];
  u16* orow = B.MIX0_() + (size_t)(b * LT + pos0 + wid * 32 + r) * 1024 + 512 + vh * 128;
#pragma unroll
  for (int dvb = 0; dvb < 4; ++dvb)
#pragma unroll
    for (int g = 0; g < 4; ++g) {
      int dv0 = dvb * 32 + 8 * g + 4 * h;
      u32x2 o;
      o[0] = pk2(O[dvb][4 * g] * rstd * sub[dv0], O[dvb][4 * g + 1] * rstd * sub[dv0 + 1]);
      o[1] = pk2(O[dvb][4 * g + 2] * rstd * sub[dv0 + 2], O[dvb][4 * g + 3] * rstd * sub[dv0 + 3]);
      *(u32x2*)(orow + dv0) = o;
    }
}
DI void mla_attn_item8(char* smem_wg, const Bufs& B, int b, int hd, int qt) {
  const int tid = otidn<512>(), lane = tid & 63, wid = tid >> 6, r = lane & 31, h = lane >> 5;
  f32x16 O[4];
  float l;
  const u16* Q = B.QF_() + ((size_t)(b * 4 + hd) * SEQ + qt * 256) * 192;
  const u16* K = B.KF_() + (size_t)(b * 4 + hd) * LT * 192;
  const u16* VT = B.VT1_() + (size_t)(b * 4 + hd) * 128 * LT;
  attn_pass<192, 64, 512>(smem_wg, Q, K, VT, LT, O, l);
  const float inv = 1.f / l;
  u16* orow = B.MIX1_() + (size_t)(b * LT + CTX + qt * 256 + wid * 32 + r) * 1024 + hd * 128;
#pragma unroll
  for (int dvb = 0; dvb < 4; ++dvb)
#pragma unroll
    for (int g = 0; g < 4; ++g) {
      int dv0 = dvb * 32 + 8 * g + 4 * h;
      u32x2 o;
      o[0] = pk2(O[dvb][4 * g] * inv, O[dvb][4 * g + 1] * inv);
      o[1] = pk2(O[dvb][4 * g + 2] * inv, O[dvb][4 * g + 3] * inv);
      *(u32x2*)(orow + dv0) = o;
    }
}

constexpr int HLD = 136;
DI void hgrn_item(char* smem, const Bufs& B, int b, int hd, int dir) {
  u16* Qs = (u16*)smem;
  u16* Ksm = Qs + 64 * HLD;
  u16* KsT = Ksm + 64 * HLD;
  u16* VsT = KsT + 128 * LDT;
  float* emid = (float*)(VsT + 128 * LDT);
  float* ecm = emid + 128;
  const int tid = otid(), lane = tid & 63, w = tid >> 6, r = lane & 31, h = lane >> 5;
  f32x16 S[4];
#pragma unroll
  for (int kb = 0; kb < 4; ++kb)
#pragma unroll
    for (int g = 0; g < 16; ++g) S[kb][g] = 0.f;
  const u16* LFd = B.LF_() + (size_t)dir * M * 512;
  u16* OHd = B.OH_() + (size_t)dir * M * 512;
  u32x4 pq[4], pl[4], pv[4];
#define HG_LOAD(CI) {                                                                         \
    const int c_ = dir ? ((CI) < 4 ? 3 - (CI) : 71 - (CI)) : (CI);                             \
    const int rowc_ = b * LT + c_ * 64;                                                        \
    _Pragma("unroll") for (int it = 0; it < 4; ++it) {                                         \
      const int cid = it * 256 + tid, pp = cid >> 4, cc = cid & 15;                            \
      const size_t grow = (size_t)(rowc_ + (dir ? 63 - pp : pp));                              \
      pq[it] = *(const u32x4*)(B.HQ_() + grow * 512 + hd * 128 + cc * 8);                      \
      pl[it] = *(const u32x4*)(LFd + grow * 512 + hd * 128 + cc * 8);                          \
      const int cc2 = it * 4 + w;                                                              \
      const size_t grow2 = (size_t)(rowc_ + (dir ? 63 - lane : lane));                         \
      pv[it] = *(const u32x4*)(B.HI_() + grow2 * 512 + hd * 128 + cc2 * 8);                    \
    } }
  HG_LOAD(0)
  for (int ci = 0; ci < 68; ++ci) {
    const int c = dir ? (ci < 4 ? 3 - ci : 71 - ci) : ci;
    const int rowc = b * LT + c * 64;
#pragma unroll
    for (int it = 0; it < 4; ++it) {
      const int cid = it * 256 + tid, pp = cid >> 4, cc = cid & 15;
      *(u32x4*)(Qs + pp * HLD + cc * 8) = pq[it];
      *(u32x4*)(Ksm + pp * HLD + cc * 8) = pl[it];
      const int cc2 = it * 4 + w;
#pragma unroll
      for (int q = 0; q < 4; ++q) {
        VsT[(cc2 * 8 + 2 * q) * LDT + lane] = (u16)(pv[it][q] & 0xffffu);
        VsT[(cc2 * 8 + 2 * q + 1) * LDT + lane] = (u16)(pv[it][q] >> 16);
      }
    }
    if (ci + 1 < 68) HG_LOAD(ci + 1)
    __syncthreads();
    {
      const int ch = tid & 127, half = tid >> 7;
      float tot0 = 0.f;
      for (int pp = 0; pp < 32; ++pp) tot0 += h2f(Ksm[pp * HLD + ch]);
      __syncthreads();
      float run = half ? 0.f : -tot0;
#pragma unroll
      for (int p8 = 0; p8 < 4; ++p8) {
        float kt[8];
#pragma unroll
        for (int e = 0; e < 8; ++e) {
          int pp = half * 32 + p8 * 8 + e;
          float lf = h2f(Ksm[pp * HLD + ch]);
          run += lf;
          float q = bf2f(Qs[pp * HLD + ch]);
          float er = __expf(run);
          Qs[pp * HLD + ch] = f2bf(q * er);
          kt[e] = (1.f - __expf(lf)) / er;
          Ksm[pp * HLD + ch] = f2bf(kt[e]);
        }
        *(u32x4*)(KsT + ch * LDT + half * 32 + p8 * 8) = pack8(kt);
      }
      if (half == 0) emid[ch] = __expf(tot0); else ecm[ch] = __expf(run);
    }
    __syncthreads();
#define HG_FENCE asm volatile("" ::: "memory")
    f32x16 oTb[2];
#pragma unroll
    for (int tb = 0; tb < 2; ++tb)
#pragma unroll
      for (int g = 0; g < 16; ++g) oTb[tb][g] = 0.f;
#pragma unroll
    for (int kb = 0; kb < 4; ++kb) {
#pragma unroll
      for (int g4 = 0; g4 < 4; ++g4) {
        const float4 e4 = *(const float4*)(emid + kb * 32 + 8 * g4 + 4 * h);
        S[kb][4 * g4] *= e4.x; S[kb][4 * g4 + 1] *= e4.y; S[kb][4 * g4 + 2] *= e4.z; S[kb][4 * g4 + 3] *= e4.w;
      }
#pragma unroll
      for (int s = 0; s < 2; ++s) {
        u32x4 o;
#pragma unroll
        for (int q = 0; q < 4; ++q) o[q] = pk2(S[kb][8 * s + 2 * q], S[kb][8 * s + 2 * q + 1]);
        const bf16x8 xa = __builtin_bit_cast(bf16x8, o);
#pragma unroll
        for (int tb = 0; tb < 2; ++tb) {
          const u16* qp = Qs + (tb * 32 + r) * HLD + kb * 32 + s * 16 + 4 * h;
          u32x2 lo = *(const u32x2*)qp, hi = *(const u32x2*)(qp + 8);
          u32x4 bq = {lo[0], lo[1], hi[0], hi[1]};
          oTb[tb] = MFMA32(xa, __builtin_bit_cast(bf16x8, bq), oTb[tb]);
        }
      }
      HG_FENCE;
    }
#pragma unroll
    for (int tb = 0; tb < 2; ++tb) {
#pragma unroll
      for (int sb = 0; sb <= tb; ++sb) {
        f32x16 P;
#pragma unroll
        for (int g = 0; g < 16; ++g) P[g] = 0.f;
#pragma unroll
        for (int ks = 0; ks < 8; ++ks) {
          bf16x8 a = *(const bf16x8*)(Ksm + (sb * 32 + r) * HLD + ks * 16 + h * 8);
          bf16x8 bb = *(const bf16x8*)(Qs + (tb * 32 + r) * HLD + ks * 16 + h * 8);
          P = MFMA32(a, bb, P);
          if ((ks & 3) == 3) HG_FENCE;
        }
        if (sb == tb) {
#pragma unroll
          for (int g = 0; g < 16; ++g) P[g] = (crow(g, h) <= r) ? P[g] : 0.f;
        }
#pragma unroll
        for (int s = 0; s < 2; ++s) {
          u32x4 o;
#pragma unroll
          for (int q = 0; q < 4; ++q) o[q] = pk2(P[8 * s + 2 * q], P[8 * s + 2 * q + 1]);
          const u16* vp = VsT + (w * 32 + r) * LDT + sb * 32 + s * 16 + 4 * h;
          u32x2 lo = *(const u32x2*)vp, hi = *(const u32x2*)(vp + 8);
          u32x4 av = {lo[0], lo[1], hi[0], hi[1]};
          oTb[tb] = MFMA32(__builtin_bit_cast(bf16x8, av), __builtin_bit_cast(bf16x8, o), oTb[tb]);
        }
        HG_FENCE;
      }
      {
        int pp = tb * 32 + r;
        size_t grow = (size_t)(rowc + (dir ? 63 - pp : pp));
        u16* op = OHd + grow * 512 + hd * 128 + w * 32;
#pragma unroll
        for (int g4 = 0; g4 < 4; ++g4) {
          u32x2 o;
          o[0] = pk2(oTb[tb][4 * g4], oTb[tb][4 * g4 + 1]);
          o[1] = pk2(oTb[tb][4 * g4 + 2], oTb[tb][4 * g4 + 3]);
          *(u32x2*)(op + 8 * g4 + 4 * h) = o;
        }
      }
      HG_FENCE;
    }
#pragma unroll
    for (int kb = 0; kb < 4; ++kb) {
#pragma unroll
      for (int ts = 0; ts < 4; ++ts) {
        bf16x8 a = *(const bf16x8*)(KsT + (kb * 32 + r) * LDT + ts * 16 + h * 8);
        bf16x8 bb = *(const bf16x8*)(VsT + (w * 32 + r) * LDT + ts * 16 + h * 8);
        S[kb] = MFMA32(a, bb, S[kb]);
      }
#pragma unroll
      for (int g4 = 0; g4 < 4; ++g4) {
        const float4 e4 = *(const float4*)(ecm + kb * 32 + 8 * g4 + 4 * h);
        S[kb][4 * g4] *= e4.x; S[kb][4 * g4 + 1] *= e4.y; S[kb][4 * g4 + 2] *= e4.z; S[kb][4 * g4 + 3] *= e4.w;
      }
      HG_FENCE;
    }
#undef HG_FENCE
    __syncthreads();
  }
#undef HG_LOAD
}

DI void hgrn_readout_row(const Params& p, const Bufs& B, int grow, int hd, int lane) {
  const size_t o = (size_t)grow * 512 + hd * 128 + lane * 2;
  unsigned a = *(const unsigned*)(B.OH_() + o), bq = *(const unsigned*)(B.OH_() + (size_t)M * 512 + o);
  unsigned gq = *(const unsigned*)(B.HG_() + o);
  float v0 = bflo(a) + bflo(bq), v1 = bfhi(a) + bfhi(bq);
  float ss = wave_sum(v0 * v0 + v1 * v1);
  float rstd = rsqrtf(ss * (1.f / 128.f) + EPS);
  const float* hn = p.in[23];
  float g0 = bflo(gq), g1 = bfhi(gq);
  unsigned out = pk2(v0 * rstd * hn[lane * 2] * siluf(g0), v1 * rstd * hn[lane * 2 + 1] * siluf(g1));
  *(unsigned*)(B.MIX1_() + (size_t)grow * 1024 + 512 + hd * 128 + lane * 2) = out;
}


namespace pg8 {
#define PG8_LAS __attribute__((address_space(3)))
typedef unsigned short bf16_t;
typedef short bf16x8 __attribute__((ext_vector_type(8)));
typedef float f32x4 __attribute__((ext_vector_type(4)));
typedef unsigned u32x4 __attribute__((ext_vector_type(4)));
constexpr int BM = 256, BK = 64, HALF = 128, HTB = HALF * BK * 2  , STAGE_BYTES = 8 * HTB, NXCD = 8, WGM = 8;

__host__ __device__ __forceinline__ int lds_byte(int r, int c) { const int st = (r >> 4) * 2 + (c >> 5), rr = r & 15, cc = c & 31, ob = rr * 64 + cc * 2; return st * 1024 + (ob ^ (((ob >> 9) & 1) << 5)); }
__host__ __device__ __forceinline__ void stage_rc(int b, int& R, int& C) { const int st = b / 1024, sb = b % 1024, swz = sb ^ (((sb >> 9) & 1) << 5); R = (st >> 1) * 16 + swz / 64; C = (st & 1) * 32 + (swz % 64) / 2; }
__host__ __device__ __forceinline__ int perm32(int rho) { const int n = rho >> 4, i = rho & 15; return 8 * (i >> 2) + 4 * n + (i & 3); }

struct Unit { int pm, pn; };
struct Gemm { const bf16_t* A; const bf16_t* Bt; int M, N, K; };

struct StaticOrder {
    int nM, nN, nwg, G, c;
    __host__ __device__ void init(int M, int N, int G_, int c_) { nM = M / BM; nN = N / BM; nwg = nM * nN; G = G_; c = c_; }
    __host__ __device__ bool next(int i, Unit& u) const {
        const long L = (long)i * G + c; if (L >= nwg) return false;
        int wgid = (int)L; { const int q = nwg / NXCD, r = nwg % NXCD, xcd = wgid % NXCD, off = wgid / NXCD; wgid = (xcd < r ? xcd * (q + 1) : r * (q + 1) + (xcd - r) * q) + off; }
        const int nig = WGM * nN, gid = wgid / nig, fm = gid * WGM, gsz = (nM - fm) < WGM ? (nM - fm) : WGM;
        u.pm = fm + ((wgid % nig) % gsz); u.pn = (wgid % nig) / gsz; return true;
    }
    __device__ __forceinline__ void a_ready(const Unit&) const {}
    __device__ __forceinline__ void done(const Unit&) const {}
};
template <class Epi, class Sched, bool STAMP = false, int AMODE = 0>
__device__ __forceinline__ void gemm_phase(PG8_LAS unsigned char* lds, const Gemm g, const Sched& S, const Epi& E, unsigned long long* stamps) {
    const int tid = threadIdx.x, wid = __builtin_amdgcn_readfirstlane(tid >> 6), lane = tid & 63, wr = wid >> 2, wc = wid & 3, fr = lane & 15, fq = lane >> 4;
    const int K = g.K, nt = K / BK;
    int ts_lo = 0, ts_hi = 0, nts = 0; const unsigned long long rt_entry = STAMP ? (unsigned long long)wall_clock64() : 0ull;
#define PG8_STAMP() do { if (STAMP && wid == 0 && nts < 64) { const unsigned long long _c = (unsigned long long)clock64(); \
        ts_lo = (lane == nts) ? (int)(unsigned)_c : ts_lo; ts_hi = (lane == nts) ? (int)(unsigned)(_c >> 32) : ts_hi; ++nts; } } while (0)
    PG8_STAMP();
    unsigned voffA[2], voffB[2];
#pragma unroll
    for (int i = 0; i < 2; ++i) { int R, C; stage_rc(tid * 16 + i * 8192, R, C); const int Rb = Epi::PERM ? ((R & ~31) + perm32(R & 31)) : R;
        const int Ra = AMODE ? (((R >> 6) ? 126 : 0) + (R & 15) * 8 + ((R >> 4) & 3)) : R;
        voffA[i] = (unsigned)(Ra * K + C) * 2u; voffB[i] = (unsigned)(Rb * K + C) * 2u; }
    const size_t kstep = (size_t)(BK * 2);
    const size_t hstep = (size_t)HALF * K * 2;
    const size_t hstepA = AMODE ? (size_t)4 * K * 2 : hstep;
    const size_t tstep = 2 * hstep;
    const unsigned ldsw = (unsigned)wid * 1024u;
    const int aoff = lds_byte(wr * 64 + fr, fq * 8), boff = lds_byte(wc * 32 + fr, fq * 8);
#define PG8_SA(b, h) (((b) * 2 + (h)) * HTB)
#define PG8_SB(b, h) ((4 + (b) * 2 + (h)) * HTB)
#define PG8_STAGE(bufoff, gbase, voff) do { _Pragma("unroll") for (int _i = 0; _i < 2; ++_i) \
        __builtin_amdgcn_global_load_lds((const unsigned*)((const char*)(gbase) + (voff)[_i]), (PG8_LAS unsigned*)(lds + (bufoff) + ldsw + _i * 8192), 16, 0, 0); } while (0)
#define PG8_LDA(dst, b, h) do { _Pragma("unroll") for (int m = 0; m < 4; ++m) _Pragma("unroll") for (int k = 0; k < 2; ++k) dst[m][k] = *(const PG8_LAS bf16x8*)(lds + PG8_SA(b, h) + aoff + m * 2048 + k * 1024); } while (0)
#define PG8_LDB(dst, b, h) do { _Pragma("unroll") for (int n = 0; n < 2; ++n) _Pragma("unroll") for (int k = 0; k < 2; ++k) dst[n][k] = *(const PG8_LAS bf16x8*)(lds + PG8_SB(b, h) + boff + n * 2048 + k * 1024); } while (0)
#define PG8_MMA(ai, bj, At, Bt) do { __builtin_amdgcn_s_setprio(1); _Pragma("unroll") for (int m = 0; m < 4; ++m) _Pragma("unroll") for (int n = 0; n < 2; ++n) _Pragma("unroll") for (int k = 0; k < 2; ++k) \
        acc[ai][bj][m][n] = __builtin_amdgcn_mfma_f32_16x16x32_bf16(Bt[n][k], At[m][k], acc[ai][bj][m][n], 0, 0, 0); __builtin_amdgcn_s_setprio(0); } while (0)
#define PG8_WAIT_V(n) asm volatile("s_waitcnt vmcnt(" #n ")" ::: "memory")
#define PG8_WAIT_L(n) asm volatile("s_waitcnt lgkmcnt(" #n ")" ::: "memory")
#define PG8_BAR __builtin_amdgcn_s_barrier()
#define PG8_SCHED __builtin_amdgcn_sched_barrier(0)
    Unit cur, nxt; int ui = 0;
    if (!S.next(0, cur)) return;
    f32x4 acc[2][2][4][2];
#pragma unroll
    for (int a = 0; a < 2; ++a)
#pragma unroll
        for (int b = 0; b < 2; ++b)
#pragma unroll
            for (int m = 0; m < 4; ++m)
#pragma unroll
                for (int n = 0; n < 2; ++n) acc[a][b][m][n] = (f32x4){0.f, 0.f, 0.f, 0.f};
    bf16x8 At[4][2], B0[2][2], B1[2][2];
    const char* cA = AMODE ? (const char*)g.A + (long)S.abase(cur) * K * 2 : (const char*)g.A + (size_t)cur.pm * tstep; const char* cB = (const char*)g.Bt + (size_t)cur.pn * tstep;
    S.a_ready(cur);
    PG8_STAGE(PG8_SB(0, 0), cB, voffB); PG8_STAGE(PG8_SA(0, 0), cA, voffA); PG8_STAGE(PG8_SB(0, 1), cB + hstep, voffB); PG8_STAGE(PG8_SA(0, 1), cA + hstepA, voffA);
    if (wr == 1) PG8_BAR;
    PG8_WAIT_V(4); PG8_BAR;
    PG8_STAGE(PG8_SB(1, 0), cB + kstep, voffB); PG8_STAGE(PG8_SA(1, 0), cA + kstep, voffA); PG8_STAGE(PG8_SB(1, 1), cB + hstep + kstep, voffB);
    PG8_WAIT_V(6); PG8_BAR;
    PG8_STAMP();
    for (;;) {
        const bool has_next = S.next(ui + 1, nxt);
        const char* nA = has_next ? (AMODE ? (const char*)g.A + (long)S.abase(nxt) * K * 2 : (const char*)g.A + (size_t)nxt.pm * tstep) : cA; const char* nB = has_next ? (const char*)g.Bt + (size_t)nxt.pn * tstep : cB;
        for (int t = 0; t < nt; t += 2) {
            const bool last = (t == nt - 2);
            const char* a1 = cA + (size_t)(t + 1) * kstep;
            const char* a2 = last ? nA : cA + (size_t)(t + 2) * kstep; const char* b2 = last ? nB : cB + (size_t)(t + 2) * kstep;
            const char* a3 = a2 + kstep; const char* b3 = b2 + kstep;
            if (last && has_next) S.a_ready(nxt);
            PG8_LDB(B0, 0, 0); PG8_SCHED; PG8_LDA(At, 0, 0); PG8_STAGE(PG8_SA(1, 1), a1 + hstepA, voffA);
            PG8_WAIT_L(8); PG8_BAR; PG8_WAIT_L(0); PG8_MMA(0, 0, At, B0); PG8_BAR; PG8_SCHED;
            PG8_LDB(B1, 0, 1); PG8_STAGE(PG8_SB(0, 0), b2, voffB);
            PG8_BAR; PG8_WAIT_L(0); PG8_MMA(0, 1, At, B1); PG8_BAR;
            PG8_LDA(At, 0, 1); PG8_STAGE(PG8_SA(0, 0), a2, voffA);
            PG8_BAR; PG8_WAIT_L(0); PG8_MMA(1, 0, At, B0); PG8_BAR; PG8_SCHED;
            PG8_STAGE(PG8_SB(0, 1), b2 + hstep, voffB);
            PG8_WAIT_V(6); PG8_BAR; PG8_MMA(1, 1, At, B1); PG8_BAR;
            PG8_LDB(B0, 1, 0); PG8_SCHED; PG8_LDA(At, 1, 0); PG8_STAGE(PG8_SA(0, 1), a2 + hstepA, voffA);
            PG8_WAIT_L(8); PG8_BAR; PG8_WAIT_L(0); PG8_MMA(0, 0, At, B0); PG8_BAR; PG8_SCHED;
            PG8_LDB(B1, 1, 1); PG8_STAGE(PG8_SB(1, 0), b3, voffB);
            PG8_BAR; PG8_WAIT_L(0); PG8_MMA(0, 1, At, B1); PG8_BAR;
            PG8_LDA(At, 1, 1); PG8_STAGE(PG8_SA(1, 0), a3, voffA);
            PG8_BAR; PG8_WAIT_L(0); PG8_MMA(1, 0, At, B0); PG8_BAR; PG8_SCHED;
            PG8_STAGE(PG8_SB(1, 1), b3 + hstep, voffB);
            PG8_WAIT_V(6); PG8_BAR; PG8_MMA(1, 1, At, B1); PG8_BAR;
        }
        PG8_STAMP();
        if constexpr (!Epi::AFTER_DRAIN) { E(acc, cur, wr, wc, fr, fq); S.done(cur); }
        PG8_STAMP();
        if (!has_next) break;
#pragma unroll
        for (int a = 0; a < 2; ++a)
#pragma unroll
            for (int b = 0; b < 2; ++b)
#pragma unroll
                for (int m = 0; m < 4; ++m)
#pragma unroll
                    for (int n = 0; n < 2; ++n) acc[a][b][m][n] = (f32x4){0.f, 0.f, 0.f, 0.f};
        cur = nxt; cA = nA; cB = nB; ++ui;
    }
    PG8_WAIT_V(0);
    if (wr == 0) PG8_BAR;
    PG8_BAR;
    if constexpr (Epi::AFTER_DRAIN) { E.fused(acc, cur, wr, wc, fr, fq, lds, wid, lane); S.done(cur); }
    PG8_STAMP();
    if (STAMP && wid == 0) { stamps[lane] = lane < nts ? (((unsigned long long)(unsigned)ts_hi << 32) | (unsigned)ts_lo) : 0ull;
        if (lane == 62) stamps[62] = rt_entry; if (lane == 63) stamps[63] = (unsigned long long)wall_clock64(); }
#undef PG8_STAMP
#undef PG8_SA
#undef PG8_SB
#undef PG8_STAGE
#undef PG8_LDA
#undef PG8_LDB
#undef PG8_MMA
#undef PG8_WAIT_V
#undef PG8_WAIT_L
#undef PG8_BAR
#undef PG8_SCHED
}
}

struct POrder {
  pg8::StaticOrder so; int mode;
  DI void init(int nrow_tiles, int N, int mode_) { so.init(nrow_tiles * 256, N, gridDim.x, blockIdx.x); mode = mode_; }
  DI bool next(int i, pg8::Unit& u) const {
    if (!so.next(i, u)) return false;
    if (mode == 1) u.pm = (u.pm >> 4) * 17 + 1 + (u.pm & 15);
    return true;
  }
  DI int abase(const pg8::Unit&) const { return 0; }
  DI void a_ready(const pg8::Unit&) const {}
  DI void done(const pg8::Unit&) const {}
};
struct EpiStoreBf16 {
  static constexpr bool PERM = true, AFTER_DRAIN = false;
  u16* O;
  DI void operator()(const pg8::f32x4 (&acc)[2][2][4][2], const pg8::Unit& u, int wr, int wc, int fr, int fq) const {
    const int row0 = u.pm * 256 + wr * 64 + fr, col0 = u.pn * 256 + wc * 32 + 8 * fq;
#pragma unroll
    for (int ai = 0; ai < 2; ++ai)
#pragma unroll
      for (int m = 0; m < 4; ++m) {
        u16* rowp = O + (size_t)(row0 + ai * 128 + m * 16) * 1024 + col0;
#pragma unroll
        for (int bj = 0; bj < 2; ++bj) {
          const pg8::f32x4 v0 = acc[ai][bj][m][0], v1 = acc[ai][bj][m][1];
          u32x4 w;
          w[0] = pk2(v0[0], v0[1]); w[1] = pk2(v0[2], v0[3]); w[2] = pk2(v1[0], v1[1]); w[3] = pk2(v1[2], v1[3]);
          *(u32x4*)(rowp + bj * 128) = w;
        }
      }
  }
};

struct FOrder {
  pg8::StaticOrder so; int per_b, pos0;
  DI void init(int per_b_, int pos0_) { per_b = per_b_; pos0 = pos0_; so.init(NB * per_b_ * 256, 22 * 256, gridDim.x, blockIdx.x); }
  DI bool next(int i, pg8::Unit& u) const { return so.next(i, u); }
  DI int gb(const pg8::Unit& u) const { int b = u.pm / per_b, j = u.pm - b * per_b; return b * LT + pos0 + 252 * j; }
  DI int abase(const pg8::Unit& u) const { return gb(u) - 1; }
  DI void a_ready(const pg8::Unit&) const {}
  DI void done(const pg8::Unit&) const {}
};
struct EpiFFN1 {
  static constexpr bool PERM = true, AFTER_DRAIN = false;
  const float* cw; const float* cb; u16* G; int per_b, pos0;
  DI void operator()(const pg8::f32x4 (&acc)[2][2][4][2], const pg8::Unit& u, int wr, int wc, int fr, int fq) const {
    const int b = u.pm / per_b, j = u.pm - b * per_b;
    const int tok0 = b * LT + pos0 + 252 * j + (wr ? 126 : 0) - 1 + fr * 8;
    const int fc0 = u.pn * 128 + wc * 32 + 8 * fq;
#pragma unroll
    for (int hh = 0; hh < 2; ++hh) {
      const int fc = fc0 + 4 * hh;
      const float4 w0 = *(const float4*)(cw + fc), w1 = *(const float4*)(cw + DFF + fc), w2 = *(const float4*)(cw + 2 * DFF + fc),
                   bb = *(const float4*)(cb + fc);
      const float w0a[4] = {w0.x, w0.y, w0.z, w0.w}, w1a[4] = {w1.x, w1.y, w1.z, w1.w}, w2a[4] = {w2.x, w2.y, w2.z, w2.w},
                  bba[4] = {bb.x, bb.y, bb.z, bb.w};
      float pv[4], nx[4];
#pragma unroll
      for (int e = 0; e < 4; ++e) {
        pv[e] = __shfl_up(acc[1][0][3][hh][e], 1, 16);
        nx[e] = __shfl_down(acc[0][0][0][hh][e], 1, 16);
      }
#pragma unroll
      for (int i = 0; i < 8; ++i) {
        const int ai = i >> 2, m = i & 3;
        const int lam = fr * 8 + i, tok = tok0 + i, pos = tok - b * LT;
        const bool hp = !(pos == 0 || pos == CTX), hn = !(pos == CTX - 1 || pos == LT - 1);
        float v[4];
#pragma unroll
        for (int e = 0; e < 4; ++e) {
          const float a = acc[ai][0][m][hh][e], up = acc[ai][1][m][hh][e];
          const float ap = (i > 0) ? acc[(i - 1) >> 2][0][(i - 1) & 3][hh][e] : pv[e];
          const float an = (i < 7) ? acc[(i + 1) >> 2][0][(i + 1) & 3][hh][e] : nx[e];
          const float av = (hp ? ap : 0.f) * w0a[e] + a * w1a[e] + (hn ? an : 0.f) * w2a[e] + bba[e];
          v[e] = siluf(av) * up;
        }
        if (lam >= 1 && lam <= 126 && pos < LT) {
          u32x2 o; o[0] = pk2(v[0], v[1]); o[1] = pk2(v[2], v[3]);
          *(u32x2*)(G + (size_t)tok * DFF + fc) = o;
        }
      }
    }
  }
};

DI void rope8_reg(float* v, int d, int n, const float* ropec, const float* ropes) {
  const int axis = d >> 5, pa = axis ? (n & 63) : (n >> 6), f0 = d & 15;
  const bool first = (d & 16) == 0;
  float cs[8], sn[8];
  ld8(cs, ropec + pa * 16 + f0); ld8(sn, ropes + pa * 16 + f0);
#pragma unroll
  for (int e = 0; e < 8; ++e) {
    const float xp = __shfl_xor(v[e], 32);
    v[e] = first ? v[e] * cs[e] - xp * sn[e] : v[e] * cs[e] + xp * sn[e];
  }
}
struct EpiIn0 {
  static constexpr bool PERM = true, AFTER_DRAIN = false;
  Bufs B;
  DI void operator()(const pg8::f32x4 (&acc)[2][2][4][2], const pg8::Unit& u, int wr, int wc, int fr, int fq) const {
    const int seg = u.pn >> 1;
    const int b = u.pm / 17, pos00 = (u.pm - b * 17) * 256 + wr * 64 + fr;
    const bool lat = (u.pm - b * 17) != 0;
#pragma unroll
    for (int ai = 0; ai < 2; ++ai)
#pragma unroll
      for (int m = 0; m < 4; ++m) {
        int pos = pos00 + ai * 128 + m * 16;
        asm volatile("" : "+v"(pos));
        const size_t grow = (size_t)b * LT + pos;
#pragma unroll
        for (int bj = 0; bj < 2; ++bj) {
          const int c = u.pn * 256 + bj * 128 + wc * 32 + 8 * fq;
          float v[8];
#pragma unroll
          for (int e = 0; e < 8; ++e) v[e] = acc[ai][bj][m][e >> 2][e & 3];
          if (seg == 0) {
            *(u32x4*)(B.U_() + grow * 512 + c) = pack8(v);
          } else if (seg == 3) {
            const int hc = c - 1536, vh = hc >> 7, dv = hc & 127;
            u16* dst = B.VT0_() + ((size_t)(b * 4 + vh) * 128 + dv) * LT + pos;
#pragma unroll
            for (int e = 0; e < 8; ++e) dst[(size_t)e * LT] = f2bf(v[e]);
          } else {
            const int hc = c - 512 * seg, head = hc >> 6, d = hc & 63;
            if (lat) rope8_reg(v, d, pos - CTX, B.ropec_(), B.ropes_());
            if (seg == 1) {
#pragma unroll
              for (int e = 0; e < 8; ++e) v[e] *= QS_DIFF;
            }
            u16* dst = (seg == 1 ? B.Q0_() : B.K0_()) + ((size_t)(b * 8 + head) * LT + pos) * 64 + d;
            *(u32x4*)dst = pack8(v);
          }
        }
        asm volatile("" ::: "memory");
      }
  }
};

DI float quad_sum(float s) { s += __shfl_xor(s, 16); s += __shfl_xor(s, 32); return s; }

struct EpiIn1 {
  static constexpr bool PERM = true, AFTER_DRAIN = false;
  Bufs B;
  DI void operator()(const pg8::f32x4 (&acc)[2][2][4][2], const pg8::Unit& u, int wr, int wc, int fr, int fq) const {
    const int b = u.pm / 17, pos00 = (u.pm - b * 17) * 256 + wr * 64 + fr;
    const bool lat = (u.pm - b * 17) != 0;
#pragma unroll
    for (int bj = 0; bj < 2; ++bj) {
      const int c = u.pn * 256 + bj * 128 + wc * 32 + 8 * fq;
      const int cg = u.pn * 256 + bj * 128 + wc * 32;
      if (cg >= 3392) continue;
      float lb8[8];
      if (cg >= 1344 && cg < 2368) ld8(lb8, B.lb_() + (cg >= 1856 ? 512 + c - 1856 : c - 1344));
#pragma unroll
      for (int ai = 0; ai < 2; ++ai)
#pragma unroll
        for (int m = 0; m < 4; ++m) {
          int pos = pos00 + ai * 128 + m * 16;
        asm volatile("" : "+v"(pos));
          const size_t grow = (size_t)b * LT + pos;
          float v[8];
#pragma unroll
          for (int e = 0; e < 8; ++e) v[e] = acc[ai][bj][m][e >> 2][e & 3];
          if (cg < 768) {
            float ss = 0.f;
#pragma unroll
            for (int e = 0; e < 8; ++e) ss += v[e] * v[e];
            ss = quad_sum(ss);
            if (fq == 0) B.RS_()[grow * 24 + (cg >> 5)] = ss;
            if (cg < 512) *(u32x4*)(B.CQ_() + grow * 512 + c) = pack8(v);
            else *(u32x4*)(B.CKV_() + grow * 256 + (c - 512)) = pack8(v);
          } else if (cg < 832) {
            const int d = c - 768;
            if (lat) rope8_reg(v, d, pos - CTX, B.ropec_(), B.ropes_());
            const u32x4 o = pack8(v);
#pragma unroll
            for (int hh = 0; hh < 4; ++hh) *(u32x4*)(B.KF_() + ((size_t)(b * 4 + hh) * LT + pos) * 192 + 128 + d) = o;
          } else if (cg < 1344) {
#pragma unroll
            for (int e = 0; e < 8; ++e) v[e] = siluf(v[e]);
            *(u32x4*)(B.HQ_() + grow * 512 + (c - 832)) = pack8(v);
          } else if (cg < 2368) {
            const int dir = cg >= 1856, ch = c - (dir ? 1856 : 1344);
            u32x4 o;
            float lf[8];
#pragma unroll
            for (int e = 0; e < 8; ++e) {
              const float f = lb8[e] + (1.f - lb8[e]) / (1.f + __expf(-v[e]));
              lf[e] = logf(f);
            }
#pragma unroll
            for (int q = 0; q < 4; ++q) o[q] = (unsigned)f2h(lf[2 * q]) | ((unsigned)f2h(lf[2 * q + 1]) << 16);
            *(u32x4*)(B.LF_() + (size_t)dir * M * 512 + grow * 512 + ch) = o;
          } else if (cg < 2880) {
            *(u32x4*)(B.HI_() + grow * 512 + (c - 2368)) = pack8(v);
          } else {
            *(u32x4*)(B.HG_() + grow * 512 + (c - 2880)) = pack8(v);
          }
          asm volatile("" ::: "memory");
        }
    }
  }
};
struct EpiUQ {
  static constexpr bool PERM = true, AFTER_DRAIN = false;
  Bufs B;
  DI void operator()(const pg8::f32x4 (&acc)[2][2][4][2], const pg8::Unit& u, int wr, int wc, int fr, int fq) const {
    const int b = u.pm / 17, n00 = (u.pm - b * 17 - 1) * 256 + wr * 64 + fr;
#pragma unroll
    for (int ai = 0; ai < 2; ++ai)
#pragma unroll
      for (int m = 0; m < 4; ++m) {
        int n = n00 + ai * 128 + m * 16;
        asm volatile("" : "+v"(n));
        const size_t grow = (size_t)b * LT + CTX + n;
        const float4 r4 = *(const float4*)(B.RS_() + grow * 24 + 4 * fq);
        const float sc = rsqrtf(quad_sum(r4.x + r4.y + r4.z + r4.w) * (1.f / 512.f) + EPS) * QS_MLA;
#pragma unroll
        for (int bj = 0; bj < 2; ++bj) {
          const int c = u.pn * 256 + bj * 128 + wc * 32 + 8 * fq;
          const int cg = u.pn * 256 + bj * 128 + wc * 32, head = cg / 192, dd = c - head * 192;
          float v[8];
#pragma unroll
          for (int e = 0; e < 8; ++e) v[e] = acc[ai][bj][m][e >> 2][e & 3];
          if (cg - head * 192 >= 128) rope8_reg(v, dd - 128, n, B.ropec_(), B.ropes_());
#pragma unroll
          for (int e = 0; e < 8; ++e) v[e] *= sc;
          *(u32x4*)(B.QF_() + ((size_t)(b * 4 + head) * SEQ + n) * 192 + dd) = pack8(v);
        }
        asm volatile("" ::: "memory");
      }
  }
};
struct EpiUKV {
  static constexpr bool PERM = true, AFTER_DRAIN = false;
  Bufs B;
  DI void operator()(const pg8::f32x4 (&acc)[2][2][4][2], const pg8::Unit& u, int wr, int wc, int fr, int fq) const {
    const int b = u.pm / 17, pos00 = (u.pm - b * 17) * 256 + wr * 64 + fr, head = u.pn;
    const int dd = wc * 32 + 8 * fq;
    u16* const kf = B.KF_() + (size_t)(b * 4 + head) * LT * 192 + 0;
    u16* const vt = B.VT1_() + (size_t)(b * 4 + head) * 128 * LT;
    const float* const rs = B.RS_() + (size_t)b * LT * 24 + 16 + 2 * fq;
#pragma unroll
    for (int ai = 0; ai < 2; ++ai)
#pragma unroll
      for (int m = 0; m < 4; ++m) {
        int pos = pos00 + ai * 128 + m * 16;
        asm volatile("" : "+v"(pos));
        const float2 r2 = *(const float2*)(rs + pos * 24);
        const float sc = rsqrtf(quad_sum(r2.x + r2.y) * (1.f / 256.f) + EPS);
        {
          float v[8];
#pragma unroll
          for (int e = 0; e < 8; ++e) v[e] = acc[ai][0][m][e >> 2][e & 3] * sc;
          *(u32x4*)(kf + pos * 192 + dd) = pack8(v);
        }
        int vo = dd * LT + pos;
#pragma unroll
        for (int e = 0; e < 8; ++e) {
          vt[vo] = f2bf(acc[ai][1][m][e >> 2][e & 3] * sc);
          vo += LT;
          asm volatile("" : "+v"(vo));
        }
        asm volatile("" ::: "memory");
      }
  }
};
template <class Epi>
DI void run_gemm256(char* smem_wg, const u16* A, const u16* Bt, int K, int nrow_tiles, int N, int mode, const Epi& E) {
  asm volatile("" : "+s"(K));
  pg8::Gemm g; g.A = A; g.Bt = Bt; g.M = 0; g.N = N; g.K = K;
  POrder S; S.init(nrow_tiles, N, mode);
  pg8::gemm_phase<Epi, POrder, false>((PG8_LAS unsigned char*)smem_wg, g, S, E, nullptr);
}

constexpr int NPHASE = 18;


struct TileIter {
  int qg, step, ntn, nloc, total, xcd;
  DI TileIter(int nrt, int ntn_) {
    xcd = blockIdx.x & 7; qg = (blockIdx.x >> 3) * 2 + vblk(); step = (gridDim.x >> 3) * 2; ntn = ntn_;
    nloc = (nrt - xcd + 7) >> 3;
    total = ((nloc + 7) >> 3) * 8 * ntn;
  }
  DI bool next(int& rt, int& nt, int& live) {
    const int per = 8 * ntn, full = ntn >> 3, wrem = ntn & 7;
    live = 0; rt = 0; nt = 0;
    while (qg < total) {
      int grp = qg / per, q = qg - grp * per, r, c;
      qg += step;
      if (q < full * 64) { int ch = q >> 6, qq = q & 63; r = qq >> 3; c = ch * 8 + (qq & 7); }
      else { int qq = q - full * 64; r = qq / wrem; c = full * 8 + (qq - r * wrem); }
      int rl = grp * 8 + r;
      if (rl < nloc) { rt = rl * 8 + xcd; nt = c; live = 1; break; }
    }
    return __syncthreads_or(live) != 0;
  }
};

DI int lat_rowbase(int rt) { return (rt >> 5) * LT + CTX + (rt & 31) * 128; }

DI void run_phase(int ph, const Params& p, const Bufs& B, char* smem_wg) {
  const int VB = vblk();
  char* smem = smem_wg + VB * SMEM_HALF;
  const int bid = blockIdx.x * 2 + VB, nb = gridDim.x * 2, tid = otid(), lane = tid & 63, wid = tid >> 6;
  switch (ph) {
    case 0: {
      const int n = NW_P0 + 192 + 1;
      for (int it = bid; it < n; it += nb) {
        if (it < NW_P0) prep_weight_item(smem, p, B, it);
        else if (it < NW_P0 + 192) mod_gemv_item(smem, p, B, it - NW_P0);
        else tables_item(p, B);
      }
    } break;
    case 1: {
      for (int it = bid; it < M / 32; it += nb) {
        for (int rr = 0; rr < 8; ++rr) {
          int row = it * 32 + rr * 4 + wid;
          RowInfo ri = row_info(row);
          const float* x = (ri.lat ? p.in[0] : p.in[2]) + resid_off(ri);
          const float* md = B.mod_() + (size_t)(0 * 9 + ri.mi) * 6144;
          norm_mod_row(x, p.in[6] + 0, md, md + 1024, B.H_() + (size_t)row * 1024, lane);
        }
      }
    } break;
    case 2: {
      EpiIn0 E; E.B = B;
      run_gemm256(smem_wg, B.H_(), B.wt_ev_(), 1024, 136, 2048, 0, E);
    } break;
    case 3: {
      const int n_lat = 8 * 4 * 16, n_ctx = 8 * 4, n_pool = 272 * 4;
      for (int it = blockIdx.x; it < n_lat + n_ctx; it += gridDim.x) {
        const bool lt = it < n_lat;
        const int j = lt ? it : it - n_lat;
        const int b = lt ? (j >> 6) : (j >> 2), vh = lt ? ((j >> 4) & 3) : (j & 3);
        diff_attn_item8(smem_wg, p, B, b, vh, lt ? CTX + (j & 15) * 256 : 0, lt ? LT : CTX);
      }
      __syncthreads();
      for (int it = nb - 1 - bid; it < n_pool; it += nb) pool_tile(smem, p, B, it >> 2, it & 3);
    } break;
    case 4: {
      EpiStoreBf16 E; E.O = (u16*)B.Y0_();
      run_gemm256(smem_wg, B.MIX0_(), B.wt_out_(), 1024, 128, 1024, 1, E);
      {
        EpiArgs ea{}; ea.outf = B.Y0_();
        for (int it = bid; it < 128; it += nb) {
          const int rt = it >> 3, nt = it & 7;
          gemm_tile<EPI_F32, false>(smem, p, B, B.MIX0_(), 1024, (rt >> 1) * LT + (rt & 1) * 128, 0, M, B.wt_out_(), 1024, nt * 128, ea, 1);
        }
      }
    } break;
    case 5: case 8: {
      const bool first = (ph == 5);
      const u16* Yb = (const u16*)B.Y0_();
      for (int it = bid; it < M / 32; it += nb) {
        const RowInfo r0 = row_info(it * 32);
        const float* md0 = B.mod_() + (size_t)(0 * 9 + r0.mi) * 6144;
        const float* md1 = B.mod_() + (size_t)(1 * 9 + r0.mi) * 6144;
        RowParams P;
        if (first) load_row_params<true>(P, md0 + 2 * 1024, p.in[6] + 1 * 1024, p.in[6] + 2 * 1024, md0 + 3 * 1024, md0 + 4 * 1024, lane);
        else load_row_params<true>(P, md0 + 5 * 1024, p.in[6] + 3 * 1024, p.in[6] + 4 * 1024, md1, md1 + 1024, lane);
        for (int rr = 0; rr < 8; ++rr) {
          int row = it * 32 + rr * 4 + wid;
          RowInfo ri = row_info(row);
          size_t ro = resid_off(ri);
          float* xd = (ri.lat ? p.out : B.xc_()) + ro;
          const float* xs = first ? (ri.lat ? p.in[0] : p.in[2]) + ro : xd;
          resid_row_p<true>(Yb + (size_t)row * 1024, xs, xd, P, B.H_() + (size_t)row * 1024, lane);
        }
      }
    } break;
    case 6: {
      FOrder S; S.init(18, 0);
      EpiFFN1 E; E.cw = p.in[10]; E.cb = p.in[11]; E.G = B.G0_(); E.per_b = 18; E.pos0 = 0;
      pg8::Gemm g; g.A = B.H_(); g.Bt = B.wt_f1_(); g.M = 0; g.N = 22 * 256; g.K = 1024;
      pg8::gemm_phase<EpiFFN1, FOrder, false, 1>((PG8_LAS unsigned char*)smem_wg, g, S, E, nullptr);
    } break;
    case 7: {
      EpiStoreBf16 E; E.O = (u16*)B.Y0_();
      run_gemm256(smem_wg, B.G0_(), B.wt_f2_(), DFF, 128, 1024, 1, E);
      {
        EpiArgs ea{}; ea.outf = B.Y0_();
        for (int it = bid; it < 128; it += nb) {
          const int rt = it >> 3, nt = it & 7;
          gemm_tile<EPI_F32, false>(smem, p, B, B.G0_(), DFF, (rt >> 1) * LT + (rt & 1) * 128, 0, M, B.wt_f2_(), DFF, nt * 128, ea, 1);
        }
      }
    } break;
    case 9: {
      EpiIn1 E; E.B = B;
      run_gemm256(smem_wg, B.H_(), B.wt_od_(), 1024, 136, 3584, 0, E);
    } break;
    case 10: {
      {
        EpiUQ E; E.B = B;
        run_gemm256(smem_wg, B.CQ_(), B.wt_uq_(), 512, 128, 768, 1, E);
      }
      {
        EpiUKV E; E.B = B;
        run_gemm256(smem_wg, B.CKV_(), B.wt_ukv_(), 256, 136, 1024, 0, E);
      }
      for (int it = nb - 1 - bid; it < NW_FFN; it += nb) ffn_weight_item(smem, p, B, 1, it);
    } break;
    case 11: {
      const int n_h = 64, n_a = 8 * 4 * 32;
      unsigned* qctr = (unsigned*)(p.ws + OFF_LAM + 256) + 64;
      volatile int* sitem = (volatile int*)(smem_wg + SMEM_MAIN + 8);
      const int vb = VB;
      for (;;) {
        __syncthreads();
        if (threadIdx.x == 0) *sitem = (int)atomicAdd(qctr, 1u);
        __syncthreads();
        const int it = *sitem;
        if (it >= n_h) break;
        if (vb == 0) hgrn_item(smem, B, it >> 3, (it >> 1) & 3, it & 1);
        else for (int ci = 0; ci < 68 * 4; ++ci) __syncthreads();
      }
      for (;;) {
        __syncthreads();
        if (threadIdx.x == 0) *sitem = (int)atomicAdd(qctr + 1, 1u);
        __syncthreads();
        const int j = *sitem;
        if (j >= 480 + 64) break;
        const bool split = j >= 480;
        const int it = split ? 960 + (j - 480) : 2 * j + vb;
        mla_attn_item(smem_wg, smem, B, it >> 7, (it >> 5) & 3, it & 31, split, vb);
      }
    } break;
    case 12: {
      const int n = NB * SEQ * 4 / 4;
      for (int it = bid; it < n; it += nb) {
        int j = it * 4 + wid, rl = j >> 2, hd = j & 3;
        int grow = (rl >> 12) * LT + CTX + (rl & 4095);
        hgrn_readout_row(p, B, grow, hd, lane);
      }
    } break;
    case 13: {
      EpiStoreBf16 E; E.O = (u16*)B.Y1_();
      run_gemm256(smem_wg, B.MIX1_(), B.wt_out_() + 1024 * 1024, 1024, 128, 1024, 1, E);
    } break;
    case 14: case 17: {
      const bool first = (ph == 14);
      for (int it = bid; it < NB * SEQ / 32; it += nb) {
        const int bb = (it * 32) >> 12;
        const float* md1 = B.mod_() + (size_t)(1 * 9 + bb) * 6144;
        const float* ng = p.in[6] + 4 * 1024;
        RowParams P;
        if (first) load_row_params<true>(P, md1 + 2 * 1024, ng + 1 * 1024, ng + 2 * 1024, md1 + 3 * 1024, md1 + 4 * 1024, lane);
        else load_row_params<false>(P, md1 + 5 * 1024, ng + 3 * 1024, nullptr, nullptr, nullptr, lane);
        for (int rr = 0; rr < 8; ++rr) {
          int rl = it * 32 + rr * 4 + wid;
          int row = bb * LT + CTX + (rl & 4095);
          float* xd = p.out + (size_t)rl * 1024;
          if (first) resid_row_p<true>((const u16*)B.Y1_() + (size_t)row * 1024, xd, xd, P, B.H_() + (size_t)row * 1024, lane);
          else resid_row_p<false>((const u16*)B.Y1_() + (size_t)row * 1024, xd, xd, P, nullptr, lane);
        }
      }
    } break;
    case 15: {
      FOrder S; S.init(17, CTX);
      EpiFFN1 E; E.cw = p.in[10] + 3 * DFF; E.cb = p.in[11] + DFF; E.G = B.G1_(); E.per_b = 17; E.pos0 = CTX;
      pg8::Gemm g; g.A = B.H_(); g.Bt = B.wt_f1_(); g.M = 0; g.N = 22 * 256; g.K = 1024;
      pg8::gemm_phase<EpiFFN1, FOrder, false, 1>((PG8_LAS unsigned char*)smem_wg, g, S, E, nullptr);
    } break;
    case 16: {
      EpiStoreBf16 E; E.O = (u16*)B.Y1_();
      run_gemm256(smem_wg, B.G1_(), B.wt_f2_(), DFF, 128, 1024, 1, E);
    } break;
    default: break;
  }
}

#define XB_TMO      128
#define XB_XCNT(j)  (256  + 64 * (j))
#define XB_XSUB(j)  (1280 + 64 * (j))
#define XB_XGEN(j)  (2304 + 64 * (j))
#define XB_TOP      3328
#define XB_TOPGEN   3392
#define XCD_BAR_WORDS 3456
#define XB_SPIN_CAP (1u << 18)
#define LAS __attribute__((address_space(3)))
DI unsigned xb_ld(unsigned* p) { return __hip_atomic_load(p, __ATOMIC_RELAXED, __HIP_MEMORY_SCOPE_AGENT); }
DI unsigned xb_add(unsigned* p, unsigned v) { return __hip_atomic_fetch_add(p, v, __ATOMIC_RELAXED, __HIP_MEMORY_SCOPE_AGENT); }
DI unsigned xb_xcc_id() { return (unsigned)__builtin_amdgcn_s_getreg((3 << 11) | 20) & 0xFu; }
#define XB_SPIN(cond, bar) do { unsigned _sp = 0; while (cond) { __builtin_amdgcn_s_sleep(1); \
    if ((++_sp & 255u) == 0u) { if (xb_ld(&(bar)[XB_TMO])) break; if (_sp > XB_SPIN_CAP) { atomicAdd(&(bar)[XB_TMO], 1u); break; } } } } while (0)
struct XcdBarrier { unsigned* bar; unsigned x; volatile LAS unsigned* st; };
DI XcdBarrier xcd_barrier_post(unsigned* bar, volatile LAS unsigned* st) {
  XcdBarrier b; b.bar = bar; b.x = xb_xcc_id(); b.st = st;
  if (threadIdx.x == 0) (void)xb_add(&bar[XB_XCNT(b.x)], 1u);
  return b;
}
DI void xcd_barrier_complete(unsigned* bar, unsigned x, unsigned& nloc, unsigned& nx) {
  const unsigned G = gridDim.x * gridDim.y * gridDim.z;
  unsigned sum, cnt, mine, sp = 0u;
  for (;;) {
    sum = 0u; cnt = 0u; mine = 0u;
#pragma unroll
    for (unsigned j = 0; j < 16; ++j) { const unsigned c = xb_ld(&bar[XB_XCNT(j)]); sum += c; cnt += (c > 0u) ? 1u : 0u; mine = (j == x) ? c : mine; }
    if (sum == G) break;
    __builtin_amdgcn_s_sleep(1);
    if ((++sp & 255u) == 0u) { if (xb_ld(&bar[XB_TMO])) break; if (sp > XB_SPIN_CAP) { atomicAdd(&bar[XB_TMO], 1u); break; } }
  }
  nloc = mine > 0u ? mine : 1u; nx = cnt > 0u ? cnt : 1u;
}
DI void xcd_barrier(const XcdBarrier& b) {
  asm volatile("s_waitcnt vmcnt(0)" ::: "memory");
  __syncthreads();
  if (threadIdx.x == 0) {
    unsigned* bar = b.bar;
    __builtin_amdgcn_s_waitcnt(0);
    unsigned nloc = b.st[0], nx = b.st[1];
    if (nloc == 0u) { xcd_barrier_complete(bar, b.x, nloc, nx); b.st[0] = nloc; b.st[1] = nx; }
    const unsigned old = xb_add(&bar[XB_XSUB(b.x)], 1u);
    const unsigned gen = old / nloc;
    if (old + 1u == (gen + 1u) * nloc) {
      __builtin_amdgcn_fence(__ATOMIC_RELEASE, "agent");
      asm volatile("s_waitcnt vmcnt(0)" ::: "memory");
      const unsigned og = xb_add(&bar[XB_TOP], 1u);
      const unsigned tg = og / nx;
      if (og + 1u == (tg + 1u) * nx) xb_add(&bar[XB_TOPGEN], 1u);
      else XB_SPIN(xb_ld(&bar[XB_TOPGEN]) == tg, bar);
      __builtin_amdgcn_fence(__ATOMIC_ACQUIRE, "agent");
      xb_add(&bar[XB_XGEN(b.x)], 1u);
      asm volatile("s_waitcnt vmcnt(0)" ::: "memory");
    } else {
      XB_SPIN(xb_ld(&bar[XB_XGEN(b.x)]) == gen, bar);
      __builtin_amdgcn_fence(__ATOMIC_ACQUIRE, "agent");
      asm volatile("s_waitcnt vmcnt(0)" ::: "memory");
    }
  }
  __syncthreads();
}
#define RUNPH(k)                                                                       \
  if (p.ph_lo <= (k) && (k) < p.ph_hi) {                                               \
    run_phase((k), p, B, smem);                                                        \
    if ((k) + 1 < p.ph_hi) {                                                           \
      if ((k) == 0) cg::this_grid().sync();                                            \
      else xcd_barrier(xb);                                                            \
    }                                                                                  \
  }
__global__ void __launch_bounds__(NTHR, 2) fwd_megakernel(Params p) {
  extern __shared__ __attribute__((aligned(16))) char smem[];
  const Bufs B = make_bufs(p.ws);
  volatile LAS unsigned* xst = (volatile LAS unsigned*)(smem + SMEM_MAIN);
  if (threadIdx.x == 0) { xst[0] = 0u; xst[1] = 0u; xst[2] = 0u; xst[3] = 0u; }
  __syncthreads();
  const XcdBarrier xb = xcd_barrier_post((unsigned*)(p.ws + OFF_LAM + 256), xst);
  RUNPH(0) RUNPH(1) RUNPH(2) RUNPH(3) RUNPH(4) RUNPH(5) RUNPH(6) RUNPH(7) RUNPH(8)
  RUNPH(9) RUNPH(10) RUNPH(11) RUNPH(12) RUNPH(13) RUNPH(14) RUNPH(15) RUNPH(16) RUNPH(17)
}

constexpr bool ONE_LAUNCH = true;

extern "C" void kernel_launch(void* const* d_in, const int* in_sizes, int n_in, void* d_out, int out_size, void* d_ws,
                              size_t ws_size, hipStream_t stream) {
  static int grid_blocks = 0;
  if (!grid_blocks) {
    int dev = 0, cus = 0, per_cu = 0;
    hipGetDevice(&dev);
    hipDeviceGetAttribute(&cus, hipDeviceAttributeMultiprocessorCount, dev);
    hipFuncSetAttribute((const void*)fwd_megakernel, hipFuncAttributeMaxDynamicSharedMemorySize, SMEM_BYTES);
    hipOccupancyMaxActiveBlocksPerMultiprocessor(&per_cu, fwd_megakernel, NTHR, SMEM_BYTES);
    if (per_cu < 1) per_cu = 1;
    if (per_cu > 1) per_cu = 1;
    grid_blocks = cus * per_cu;
  }
  if (ws_size < WS_NEEDED) {
    fprintf(stderr, "workspace too small: %zu < %zu\n", ws_size, (size_t)WS_NEEDED);
    return;
  }
  Params p{};
  for (int i = 0; i < 25; ++i) p.in[i] = (const float*)d_in[i];
  p.out = (float*)d_out;
  p.ws = (char*)d_ws;
  hipMemsetAsync((char*)d_ws + OFF_LAM + 256, 0, XCD_BAR_WORDS * 4, stream);
  if (ONE_LAUNCH) {
    p.ph_lo = 0; p.ph_hi = NPHASE;

    void* args[] = {&p};
    hipError_t e = hipLaunchCooperativeKernel((const void*)fwd_megakernel, dim3(grid_blocks), dim3(NTHR), args,
                                              SMEM_BYTES, stream);
    if (e != hipSuccess) fprintf(stderr, "cooperative launch failed: %s (grid %d)\n", hipGetErrorString(e), grid_blocks);
  } else {
    for (int ph = 0; ph < NPHASE; ++ph) {
      p.ph_lo = ph; p.ph_hi = ph + 1;
      hipLaunchKernelGGL(fwd_megakernel, dim3(grid_blocks), dim3(NTHR), SMEM_BYTES, stream, p);
    }
  }
}
```

```cpp
#include <hip/hip_runtime.h>
#include <hip/hip_fp16.h>
#include <hip/hip_cooperative_groups.h>
#include <cstdio>
#include <cstdint>
namespace cg = cooperative_groups;

#define DI __device__ __forceinline__
typedef unsigned short u16;
typedef __attribute__((ext_vector_type(8))) short bf16x8;
typedef __attribute__((ext_vector_type(16))) float f32x16;
typedef __attribute__((ext_vector_type(4))) unsigned u32x4;
typedef __attribute__((ext_vector_type(2))) unsigned u32x2;

constexpr int D = 1024, NB = 8, SEQ = 4096, CTX = 256, LT = 4352, M = NB * LT, DFF = 2816;
constexpr float EPS = 1e-6f;
constexpr float LOG2E = 1.4426950408889634f;
constexpr float QS_DIFF = 0.125f * LOG2E;
constexpr float QS_MLA = 0.07216878364870323f * LOG2E;
constexpr int NTHR = 512;
constexpr int VTHR = 256;

constexpr size_t SZ_WT_OUT = 2ull * 1024 * 1024 * 2;
constexpr size_t SZ_WT_F1 = 5632ull * 1024 * 2;
constexpr size_t SZ_WT_F2 = 1024ull * 2816 * 2;
constexpr size_t SZ_WT_EV = 2048ull * 1024 * 2;
constexpr size_t SZ_WT_OD = 3584ull * 1024 * 2;
constexpr size_t SZ_WT_UQ = 768ull * 512 * 2;
constexpr size_t SZ_WT_UKV = 1024ull * 256 * 2;
constexpr size_t SZ_WT_POOL = 4ull * 128 * 128 * 2;
constexpr size_t SZ_MOD = 2ull * 9 * 6144 * 4;
constexpr size_t SZ_ROPE = 2ull * 1024 * 4;
constexpr size_t SZ_LB = 1024 * 4;
constexpr size_t SZ_RS = (size_t)M * 24 * 4;
constexpr size_t SZ_LAM = 256 + 16384 + SZ_RS;
constexpr size_t SZ_XC = 2048ull * 1024 * 4;
constexpr size_t SZ_H = (size_t)M * 1024 * 2;
constexpr size_t SZ_M512 = (size_t)M * 512 * 2;

constexpr size_t OFF_WT_OUT = 0;
constexpr size_t OFF_WT_F1 = OFF_WT_OUT + SZ_WT_OUT;
constexpr size_t OFF_WT_F2 = OFF_WT_F1 + SZ_WT_F1;
constexpr size_t OFF_WT_EV = OFF_WT_F2 + SZ_WT_F2;
constexpr size_t OFF_WT_OD = OFF_WT_EV + SZ_WT_EV;
constexpr size_t OFF_WT_UQ = OFF_WT_OD + SZ_WT_OD;
constexpr size_t OFF_WT_UKV = OFF_WT_UQ + SZ_WT_UQ;
constexpr size_t OFF_WT_POOL = OFF_WT_UKV + SZ_WT_UKV;
constexpr size_t OFF_MOD = OFF_WT_POOL + SZ_WT_POOL;
constexpr size_t OFF_ROPE = OFF_MOD + SZ_MOD;
constexpr size_t OFF_LB = OFF_ROPE + SZ_ROPE;
constexpr size_t OFF_LAM = OFF_LB + SZ_LB;
constexpr size_t OFF_XC = OFF_LAM + SZ_LAM;
constexpr size_t OFF_H = OFF_XC + SZ_XC;
constexpr size_t OFF_R = OFF_H + SZ_H;
constexpr size_t R_U = 0;
constexpr size_t R_Q0 = R_U + SZ_M512;
constexpr size_t R_K0 = R_Q0 + SZ_M512;
constexpr size_t R_VT0 = R_K0 + SZ_M512;
constexpr size_t R_MIX0 = R_VT0 + SZ_M512;
constexpr size_t R_Y0 = R_MIX0 + SZ_H;
constexpr size_t R_G0 = 0;
constexpr size_t R_MIX1 = 0;
constexpr size_t R_CQ = 0;
constexpr size_t R_CKV = SZ_M512;
constexpr size_t R_KF = SZ_H;
constexpr size_t SZ_KF = 8ull * 4 * LT * 192 * 2;
constexpr size_t R_VT1 = R_KF + SZ_KF;
constexpr size_t R_HQ = R_VT1 + SZ_M512;
constexpr size_t R_LF = R_HQ + SZ_M512;
constexpr size_t R_HI = R_LF + 2 * SZ_M512;
constexpr size_t R_HG = R_HI + SZ_M512;
constexpr size_t R_OH = R_HG + SZ_M512;
constexpr size_t R_END1 = R_OH + 2 * SZ_M512;
constexpr size_t R_Y1 = R_KF;
constexpr size_t SZ_Y = (size_t)M * 1024 * 4;
constexpr size_t R_G1 = R_Y1 + SZ_Y;
constexpr size_t SZ_G = (size_t)M * DFF * 2;
constexpr size_t R_SIZE = (R_G1 + SZ_G > R_END1) ? (R_G1 + SZ_G) : R_END1;
constexpr size_t WS_NEEDED = OFF_R + R_SIZE;
static_assert(R_Y0 + SZ_Y <= R_SIZE, "layer0 region");
static_assert(R_G0 + SZ_G <= R_Y0, "G0 overlap");
static_assert(WS_NEEDED <= 536870912ull, "ws too big");

struct Params {
  const float* in[25];
  float* out;
  char* ws;
  int ph_lo, ph_hi;
};

constexpr int SMEM_HALF = 73728;
constexpr int SMEM_MAIN = 2 * SMEM_HALF;
constexpr int SMEM_BYTES = SMEM_MAIN + 16;
constexpr int LDT = 72;
constexpr int CLD = 132;

DI int otid() { int t = threadIdx.x & 255; asm volatile("" : "+v"(t)); return t; }
template <int NT> DI int otidn() { int t = threadIdx.x & (NT - 1); asm volatile("" : "+v"(t)); return t; }
DI int vblk() { return __builtin_amdgcn_readfirstlane((int)threadIdx.x >> 8); }
DI u16 f2bf(float x) { return __builtin_bit_cast(u16, (__bf16)x); }
typedef float f32x2v __attribute__((ext_vector_type(2)));
typedef __bf16 bf16x2v __attribute__((ext_vector_type(2)));
DI unsigned pk2(float a, float b) {
  f32x2v v = {a, b};
  return __builtin_bit_cast(unsigned, __builtin_convertvector(v, bf16x2v));
}
DI float bflo(unsigned u) { return __uint_as_float(u << 16); }
DI float bfhi(unsigned u) { return __uint_as_float(u & 0xffff0000u); }
DI float bf2f(u16 v) { return __uint_as_float(((unsigned)v) << 16); }
DI float h2f(u16 v) { return __half2float(__ushort_as_half(v)); }
DI u16 f2h(float x) { return __half_as_ushort(__float2half(x)); }
DI float siluf(float x) { return x / (1.f + __expf(-x)); }
DI float wave_sum(float v) {
#pragma unroll
  for (int o = 32; o > 0; o >>= 1) v += __shfl_xor(v, o);
  return v;
}
DI u32x4 pack8(const float* v) {
  u32x4 o;
  o[0] = pk2(v[0], v[1]); o[1] = pk2(v[2], v[3]); o[2] = pk2(v[4], v[5]); o[3] = pk2(v[6], v[7]);
  return o;
}
DI int crow(int reg, int h) { return (reg & 3) + 8 * (reg >> 2) + 4 * h; }
#define MFMA32(a, b, c) __builtin_amdgcn_mfma_f32_32x32x16_bf16((a), (b), (c), 0, 0, 0)

struct Bufs {
  char* ws;
#define BUFP(T, name, off) DI T* name##_() const { return (T*)(ws + (off)); }
  BUFP(u16, wt_out, OFF_WT_OUT) BUFP(u16, wt_f1, OFF_WT_F1) BUFP(u16, wt_f2, OFF_WT_F2) BUFP(u16, wt_ev, OFF_WT_EV)
  BUFP(u16, wt_od, OFF_WT_OD) BUFP(u16, wt_uq, OFF_WT_UQ) BUFP(u16, wt_ukv, OFF_WT_UKV) BUFP(u16, wt_pool, OFF_WT_POOL)
  BUFP(float, mod, OFF_MOD) BUFP(float, ropec, OFF_ROPE) BUFP(float, ropes, OFF_ROPE + 4096) BUFP(float, lb, OFF_LB)
  BUFP(float, lam, OFF_LAM) BUFP(float, RS, OFF_LAM + 256 + 16384) BUFP(float, xc, OFF_XC) BUFP(u16, H, OFF_H)
  BUFP(u16, U, OFF_R + R_U) BUFP(u16, Q0, OFF_R + R_Q0) BUFP(u16, K0, OFF_R + R_K0) BUFP(u16, VT0, OFF_R + R_VT0)
  BUFP(u16, MIX0, OFF_R + R_MIX0) BUFP(float, Y0, OFF_R + R_Y0) BUFP(u16, G0, OFF_R + R_G0)
  BUFP(u16, CQ, OFF_R + R_CQ) BUFP(u16, CKV, OFF_R + R_CKV) BUFP(u16, MIX1, OFF_R + R_MIX1) BUFP(u16, KF, OFF_R + R_KF)
  BUFP(u16, VT1, OFF_R + R_VT1) BUFP(u16, HQ, OFF_R + R_HQ) BUFP(u16, LF, OFF_R + R_LF) BUFP(u16, HI, OFF_R + R_HI)
  BUFP(u16, HG, OFF_R + R_HG) BUFP(u16, OH, OFF_R + R_OH) BUFP(u16, QF, OFF_H) BUFP(float, Y1, OFF_R + R_Y1)
  BUFP(u16, G1, OFF_R + R_G1)
};
DI Bufs make_bufs(char* ws) { Bufs b; b.ws = ws; return b; }

DI void wt_tile(char* smem, const float* __restrict__ src, int ld, int kt, int ncol0, u16* __restrict__ dst, int K,
                int dst_row0, const float* __restrict__ scale) {
  float* t = (float*)smem;
  const int tid = otid(), col = tid & 63, r0 = tid >> 6;
#pragma unroll 4
  for (int i = 0; i < 16; ++i) {
    int row = i * 4 + r0;
    float v = src[(size_t)(kt * 64 + row) * ld + ncol0 + col];
    if (scale) v *= scale[kt * 64 + row];
    t[row * 65 + col] = v;
  }
  __syncthreads();
#pragma unroll
  for (int it = 0; it < 2; ++it) {
    int c = it * 256 + tid, j = c >> 3, kc = c & 7;
    u32x4 o;
#pragma unroll
    for (int q = 0; q < 4; ++q) o[q] = pk2(t[(kc * 8 + 2 * q) * 65 + j], t[(kc * 8 + 2 * q + 1) * 65 + j]);
    *(u32x4*)(dst + (size_t)(dst_row0 + j) * K + kt * 64 + kc * 8) = o;
  }
  __syncthreads();
}

#define WJOB(SRC, LDD, KK, NN, DST, TS, ROFF, SC)                                        \
  {                                                                                       \
    const int ntn = (NN) / 64, cnt = ((KK) / 64) * ntn;                                   \
    if (idx < cnt) {                                                                      \
      int kt = idx / ntn, nt = idx % ntn;                                                 \
      wt_tile(smem, (SRC), (LDD), kt, nt * 64, (DST), (KK), nt * (TS) + (ROFF), (SC));    \
      return;                                                                             \
    }                                                                                     \
    idx -= cnt;                                                                           \
  }

constexpr int NW_FFN = 704 * 3;
constexpr int NW_P0 = 256 + 256 + NW_FFN + 512 + 848 + 96 + 64 + 16;

DI void ffn_weight_item(char* smem, const Params& p, const Bufs& B, int layer, int idx) {
  for (int gu = 0; gu < 2; ++gu) {
    if (idx < 704) {
      int kt = idx / 44, nt = idx - kt * 44;
      wt_tile(smem, p.in[8 + gu] + (size_t)layer * 1024 * DFF, DFF, kt, nt * 64, B.wt_f1_(), 1024,
              (nt >> 1) * 256 + (nt & 1) * 64 + gu * 128, nullptr);
      return;
    }
    idx -= 704;
  }
  WJOB(p.in[12] + (size_t)layer * DFF * 1024, 1024, DFF, 1024, B.wt_f2_(), 64, 0, nullptr)
}

DI void prep_weight_item(char* smem, const Params& p, const Bufs& B, int idx) {
  WJOB(p.in[7], 1024, 1024, 1024, B.wt_out_(), 64, 0, nullptr)
  WJOB(p.in[7] + 1024 * 1024, 1024, 1024, 1024, B.wt_out_() + 1024 * 1024, 64, 0, nullptr)
  if (idx < NW_FFN) { ffn_weight_item(smem, p, B, 0, idx); return; }
  idx -= NW_FFN;
  WJOB(p.in[13], 2048, 1024, 2048, B.wt_ev_(), 64, 0, nullptr)
  WJOB(p.in[18], 3392, 1024, 3392, B.wt_od_(), 64, 0, nullptr)
  WJOB(p.in[20], 768, 512, 768, B.wt_uq_(), 64, 0, p.in[19])
  WJOB(p.in[22], 1024, 256, 1024, B.wt_ukv_(), 64, 0, p.in[21])
  {
    int g = idx >> 2, t = idx & 3;
    wt_tile(smem, p.in[14] + g * 128 * 128, 128, t >> 1, (t & 1) * 64, B.wt_pool_() + g * 128 * 128, 128, (t & 1) * 64,
            nullptr);
  }
}

DI void mod_gemv_item(char* smem, const Params& p, const Bufs& B, int idx) {
  const int layer = idx / 96, c0 = (idx % 96) * 64, tid = otid();
  float* sc = (float*)smem;
  float* red = sc + 9 * 1024;
  for (int i = tid; i < 9 * 1024; i += VTHR) {
    int rr = i >> 10, k = i & 1023;
    float v = (rr < 8) ? p.in[1][rr * 1024 + k] : p.in[3][k];
    sc[i] = siluf(v);
  }
  __syncthreads();
  const int cq = tid & 15, kg = tid >> 4;
  float acc[9][4];
#pragma unroll
  for (int a = 0; a < 9; ++a)
#pragma unroll
    for (int e = 0; e < 4; ++e) acc[a][e] = 0.f;
  const float* W = p.in[4] + (size_t)layer * 1024 * 6144 + c0 + cq * 4;
#pragma unroll 4
  for (int kk = 0; kk < 64; ++kk) {
    int k = kg * 64 + kk;
    float4 w = *(const float4*)(W + (size_t)k * 6144);
#pragma unroll
    for (int a = 0; a < 9; ++a) {
      float s = sc[a * 1024 + k];
      acc[a][0] += s * w.x; acc[a][1] += s * w.y; acc[a][2] += s * w.z; acc[a][3] += s * w.w;
    }
  }
#pragma unroll
  for (int a = 0; a < 9; ++a)
#pragma unroll
    for (int e = 0; e < 4; ++e) red[(kg * 9 + a) * 64 + cq * 4 + e] = acc[a][e];
  __syncthreads();
  for (int i = tid; i < 9 * 64; i += VTHR) {
    int a = i >> 6, c = i & 63;
    float s = 0.f;
    for (int g = 0; g < 16; ++g) s += red[(g * 9 + a) * 64 + c];
    B.mod_()[(size_t)(layer * 9 + a) * 6144 + c0 + c] = s + p.in[5][layer * 6144 + c0 + c];
  }
  __syncthreads();
}

DI void tables_item(const Params& p, const Bufs& B) {
  const int tid = otid();
  for (int i = tid; i < 1024; i += VTHR) {
    int pos = i >> 4, f = i & 15;
    float inv = powf(10000.f, -(float)f / 16.f);
    float ang = (float)pos * inv;
    B.ropec_()[i] = cosf(ang);
    B.ropes_()[i] = sinf(ang);
    int dir = i >> 9, ch = i & 511;
    float a0 = p.in[24][(dir * 2 + 0) * 512 + ch], a1 = p.in[24][(dir * 2 + 1) * 512 + ch];
    B.lb_()[i] = 1.f / (1.f + expf(a0 - a1));
  }
  if (tid < 64) {
    const float* L = p.in[16];
    float s1 = wave_sum(L[tid] * L[64 + tid]);
    float s2 = wave_sum(L[128 + tid] * L[192 + tid]);
    if (tid == 0) B.lam_()[0] = expf(s1) - expf(s2) + 0.2f;
  }
  for (int i = tid; i < 192 * 1024 / 8; i += VTHR) {
    u32x4 z = {0u, 0u, 0u, 0u};
    *(u32x4*)(B.wt_od_() + (size_t)3392 * 1024 + i * 8) = z;
  }
}

struct RowInfo { int b, pos, mi; bool lat; };
DI RowInfo row_info(int r) {
  RowInfo ri;
  ri.b = r / LT; ri.pos = r - ri.b * LT; ri.lat = ri.pos >= CTX; ri.mi = ri.lat ? ri.b : 8;
  return ri;
}
DI size_t resid_off(const RowInfo& ri) {
  return ri.lat ? ((size_t)ri.b * SEQ + (ri.pos - CTX)) * 1024 : ((size_t)ri.b * CTX + ri.pos) * 1024;
}

DI void norm_mod_row(const float* __restrict__ x, const float* __restrict__ g, const float* __restrict__ sh,
                     const float* __restrict__ sc, u16* __restrict__ hrow, int lane) {
  float4 v[4];
  float ss = 0.f;
#pragma unroll
  for (int i = 0; i < 4; ++i) {
    v[i] = *(const float4*)(x + i * 256 + lane * 4);
    ss += v[i].x * v[i].x + v[i].y * v[i].y + v[i].z * v[i].z + v[i].w * v[i].w;
  }
  ss = wave_sum(ss);
  const float rstd = rsqrtf(ss * (1.f / 1024.f) + EPS);
#pragma unroll
  for (int i = 0; i < 4; ++i) {
    int c = i * 256 + lane * 4;
    float4 gg = *(const float4*)(g + c), s1 = *(const float4*)(sh + c), s2 = *(const float4*)(sc + c);
    u32x2 o;
    o[0] = pk2(v[i].x * rstd * gg.x * (1.f + s2.x) + s1.x, v[i].y * rstd * gg.y * (1.f + s2.y) + s1.y);
    o[1] = pk2(v[i].z * rstd * gg.z * (1.f + s2.z) + s1.z, v[i].w * rstd * gg.w * (1.f + s2.w) + s1.w);
    *(u32x2*)(hrow + c) = o;
  }
}

template <bool NEXT>
DI void resid_row(const u16* __restrict__ y, const float* xs, float* xd, const float* __restrict__ gate,
                  const float* __restrict__ ny, const float* __restrict__ nx, const float* __restrict__ sh,
                  const float* __restrict__ sc, u16* __restrict__ hrow, int lane) {
  float4 v[4];
  float ss = 0.f;
#pragma unroll
  for (int i = 0; i < 4; ++i) {
    u32x2 yy = *(const u32x2*)(y + i * 256 + lane * 4);
    v[i].x = bflo(yy[0]); v[i].y = bfhi(yy[0]); v[i].z = bflo(yy[1]); v[i].w = bfhi(yy[1]);
    ss += v[i].x * v[i].x + v[i].y * v[i].y + v[i].z * v[i].z + v[i].w * v[i].w;
  }
  ss = wave_sum(ss);
  const float rstd = rsqrtf(ss * (1.f / 1024.f) + EPS);
  float ss2 = 0.f;
#pragma unroll
  for (int i = 0; i < 4; ++i) {
    int c = i * 256 + lane * 4;
    float4 xv = *(const float4*)(xs + c), gt = *(const float4*)(gate + c), nn = *(const float4*)(ny + c);
    float4 o;
    o.x = xv.x + gt.x * (v[i].x * rstd * nn.x); o.y = xv.y + gt.y * (v[i].y * rstd * nn.y);
    o.z = xv.z + gt.z * (v[i].z * rstd * nn.z); o.w = xv.w + gt.w * (v[i].w * rstd * nn.w);
    *(float4*)(xd + c) = o;
    v[i] = o;
    ss2 += o.x * o.x + o.y * o.y + o.z * o.z + o.w * o.w;
  }
  if (NEXT) {
    ss2 = wave_sum(ss2);
    const float rstd2 = rsqrtf(ss2 * (1.f / 1024.f) + EPS);
#pragma unroll
    for (int i = 0; i < 4; ++i) {
      int c = i * 256 + lane * 4;
      float4 gg = *(const float4*)(nx + c), s1 = *(const float4*)(sh + c), s2 = *(const float4*)(sc + c);
      u32x2 o;
      o[0] = pk2(v[i].x * rstd2 * gg.x * (1.f + s2.x) + s1.x, v[i].y * rstd2 * gg.y * (1.f + s2.y) + s1.y);
      o[1] = pk2(v[i].z * rstd2 * gg.z * (1.f + s2.z) + s1.z, v[i].w * rstd2 * gg.w * (1.f + s2.w) + s1.w);
      *(u32x2*)(hrow + c) = o;
    }
  }
}


struct RowParams { float4 gt[4], ny[4], nx[4], sh[4], sc[4]; };
template <bool NEXT>
DI void load_row_params(RowParams& P, const float* gate, const float* ny, const float* nx, const float* sh, const float* sc, int lane) {
#pragma unroll
  for (int i = 0; i < 4; ++i) {
    const int c = i * 256 + lane * 4;
    P.gt[i] = *(const float4*)(gate + c); P.ny[i] = *(const float4*)(ny + c);
    if (NEXT) { P.nx[i] = *(const float4*)(nx + c); P.sh[i] = *(const float4*)(sh + c); P.sc[i] = *(const float4*)(sc + c); }
  }
}
template <bool NEXT>
DI void resid_row_p(const u16* __restrict__ y, const float* xs, float* xd, const RowParams& P, u16* __restrict__ hrow, int lane) {
  float4 v[4];
  float ss = 0.f;
#pragma unroll
  for (int i = 0; i < 4; ++i) {
    u32x2 yy = *(const u32x2*)(y + i * 256 + lane * 4);
    v[i].x = bflo(yy[0]); v[i].y = bfhi(yy[0]); v[i].z = bflo(yy[1]); v[i].w = bfhi(yy[1]);
    ss += v[i].x * v[i].x + v[i].y * v[i].y + v[i].z * v[i].z + v[i].w * v[i].w;
  }
  ss = wave_sum(ss);
  const float rstd = rsqrtf(ss * (1.f / 1024.f) + EPS);
  float ss2 = 0.f;
#pragma unroll
  for (int i = 0; i < 4; ++i) {
    const int c = i * 256 + lane * 4;
    const float4 xv = *(const float4*)(xs + c), gt = P.gt[i], nn = P.ny[i];
    float4 o;
    o.x = xv.x + gt.x * (v[i].x * rstd * nn.x); o.y = xv.y + gt.y * (v[i].y * rstd * nn.y);
    o.z = xv.z + gt.z * (v[i].z * rstd * nn.z); o.w = xv.w + gt.w * (v[i].w * rstd * nn.w);
    *(float4*)(xd + c) = o;
    v[i] = o;
    ss2 += o.x * o.x + o.y * o.y + o.z * o.z + o.w * o.w;
  }
  if (NEXT) {
    ss2 = wave_sum(ss2);
    const float rstd2 = rsqrtf(ss2 * (1.f / 1024.f) + EPS);
#pragma unroll
    for (int i = 0; i < 4; ++i) {
      const int c = i * 256 + lane * 4;
      const float4 gg = P.nx[i], s1 = P.sh[i], s2 = P.sc[i];
      u32x2 o;
      o[0] = pk2(v[i].x * rstd2 * gg.x * (1.f + s2.x) + s1.x, v[i].y * rstd2 * gg.y * (1.f + s2.y) + s1.y);
      o[1] = pk2(v[i].z * rstd2 * gg.z * (1.f + s2.z) + s1.z, v[i].w * rstd2 * gg.w * (1.f + s2.w) + s1.w);
      *(u32x2*)(hrow + c) = o;
    }
  }
}

enum { EPI_F32 = 0, EPI_IN0, EPI_IN1, EPI_FFN1, EPI_UQ, EPI_UKV, EPI_POOL };

struct EpiArgs {
  float* outf;
  int layer;
  int seg_lo, seg_hi;
  int aux;
};

DI void mma_ktile(const u16* As, const u16* Bs, f32x16 (&acc)[2][2], int wm, int wn, int r, int h) {
  __builtin_amdgcn_s_setprio(1);
#pragma unroll
  for (int ks = 0; ks < 4; ++ks) {
    bf16x8 a[2], b[2];
#pragma unroll
    for (int i = 0; i < 2; ++i) a[i] = *(const bf16x8*)(As + (wm * 64 + i * 32 + r) * LDT + ks * 16 + h * 8);
#pragma unroll
    for (int j = 0; j < 2; ++j) b[j] = *(const bf16x8*)(Bs + (wn * 64 + j * 32 + r) * LDT + ks * 16 + h * 8);
#pragma unroll
    for (int i = 0; i < 2; ++i)
#pragma unroll
      for (int j = 0; j < 2; ++j) acc[i][j] = MFMA32(a[i], b[j], acc[i][j]);
  }
  __builtin_amdgcn_s_setprio(0);
}

DI void acc_to_lds(float* Ct, f32x16 (&acc)[2][2], int wm, int wn, int r, int h) {
#pragma unroll
  for (int i = 0; i < 2; ++i)
#pragma unroll
    for (int j = 0; j < 2; ++j)
#pragma unroll
      for (int g = 0; g < 16; ++g)
        Ct[(wm * 64 + i * 32 + crow(g, h)) * CLD + wn * 64 + j * 32 + r] = acc[i][j][g];
}

DI void rope8(float* v, const float* Ct_row, int cc8, int d, int n, const Bufs& B) {
  const int axis = d >> 5, pa = axis ? (n & 63) : (n >> 6), f0 = d & 15;
  const bool first = (d & 16) == 0;
  const int pc = first ? cc8 + 16 : cc8 - 16;
  const float4 c0 = *(const float4*)(B.ropec_() + pa * 16 + f0), c1 = *(const float4*)(B.ropec_() + pa * 16 + f0 + 4);
  const float4 s0 = *(const float4*)(B.ropes_() + pa * 16 + f0), s1 = *(const float4*)(B.ropes_() + pa * 16 + f0 + 4);
  const float4 x0 = *(const float4*)(Ct_row + pc), x1 = *(const float4*)(Ct_row + pc + 4);
  const float cs[8] = {c0.x, c0.y, c0.z, c0.w, c1.x, c1.y, c1.z, c1.w};
  const float sn[8] = {s0.x, s0.y, s0.z, s0.w, s1.x, s1.y, s1.z, s1.w};
  const float xp[8] = {x0.x, x0.y, x0.z, x0.w, x1.x, x1.y, x1.z, x1.w};
#pragma unroll
  for (int e = 0; e < 8; ++e) v[e] = first ? v[e] * cs[e] - xp[e] * sn[e] : v[e] * cs[e] + xp[e] * sn[e];
}

DI void ld8(float* v, const float* src) {
  const float4 a = *(const float4*)src, b = *(const float4*)(src + 4);
  v[0] = a.x; v[1] = a.y; v[2] = a.z; v[3] = a.w; v[4] = b.x; v[5] = b.y; v[6] = b.z; v[7] = b.w;
}

template <int EPI>
DI void epilogue(const Params& p, const Bufs& B, const float* Ct, const float* rowss, int rowbase, int n0,
                 const EpiArgs& ea) {
  const int tid = otid();
  if (EPI == EPI_F32) {
#pragma unroll 1
    for (int it = 0; it < 8; ++it) {
      int id = it * 256 + tid, i = id >> 4, cc = id & 15;
      float v[8];
      ld8(v, Ct + i * CLD + cc * 8);
      *(u32x4*)((u16*)ea.outf + (size_t)(rowbase + i) * 1024 + n0 + cc * 8) = pack8(v);
    }
  } else if (EPI == EPI_POOL) {
#pragma unroll 1
    for (int it = 0; it < 8; ++it) {
      int id = it * 256 + tid, i = id >> 4, cc = id & 15;
      float v[8];
#pragma unroll
      for (int e = 0; e < 8; ++e) v[e] = Ct[i * CLD + cc * 8 + e] * p.in[15][ea.aux * 128 + cc * 8 + e];
      *(u32x4*)(B.MIX0_() + (size_t)(rowbase + i) * 1024 + ea.aux * 128 + cc * 8) = pack8(v);
    }
  } else if (EPI == EPI_IN0) {
    const int seg = n0 >> 9, b = rowbase / LT, pos0 = rowbase - b * LT;
    if (seg == 3) {
#pragma unroll 1
      for (int it = 0; it < 8; ++it) {
        int id = it * 256 + tid, c = id & 127, rc = id >> 7;
        float v[8];
#pragma unroll
        for (int e = 0; e < 8; ++e) v[e] = Ct[(rc * 8 + e) * CLD + c];
        int hc = n0 - 1536 + c, vh = hc >> 7, dv = hc & 127;
        *(u32x4*)(B.VT0_() + ((size_t)(b * 4 + vh) * 128 + dv) * LT + pos0 + rc * 8) = pack8(v);
      }
    } else {
#pragma unroll 1
      for (int it = 0; it < 8; ++it) {
        int id = it * 256 + tid, i = id >> 4, cc = id & 15;
        float v[8];
        ld8(v, Ct + i * CLD + cc * 8);
        if (seg == 0) {
          *(u32x4*)(B.U_() + (size_t)(rowbase + i) * 512 + n0 + cc * 8) = pack8(v);
        } else {
          int hc = n0 - 512 * seg + cc * 8, head = hc >> 6, d = hc & 63, pos = pos0 + i;
          if (pos >= CTX) rope8(v, Ct + i * CLD, cc * 8, d, pos - CTX, B);
          if (seg == 1) {
#pragma unroll
            for (int e = 0; e < 8; ++e) v[e] *= QS_DIFF;
          }
          u16* dst = (seg == 1 ? B.Q0_() : B.K0_()) + ((size_t)(b * 8 + head) * LT + pos) * 64 + d;
          *(u32x4*)dst = pack8(v);
        }
      }
    }
  } else if (EPI == EPI_IN1) {
    const int b = rowbase / LT, pos0 = rowbase - b * LT;
#pragma unroll 1
    for (int it = 0; it < 8; ++it) {
      int id = it * 256 + tid, i = id >> 4, cc = id & 15;
      int gc = n0 + cc * 8, pos = pos0 + i;
      size_t grow = (size_t)(rowbase + i);
      float v[8];
      ld8(v, Ct + i * CLD + cc * 8);
      if (gc < 512) {
        *(u32x4*)(B.CQ_() + grow * 512 + gc) = pack8(v);
      } else if (gc < 768) {
        *(u32x4*)(B.CKV_() + grow * 256 + (gc - 512)) = pack8(v);
      } else if (gc < 832) {
        int d = gc - 768;
        if (pos >= CTX) rope8(v, Ct + i * CLD, cc * 8, d, pos - CTX, B);
        u32x4 o = pack8(v);
#pragma unroll
        for (int hh = 0; hh < 4; ++hh) *(u32x4*)(B.KF_() + ((size_t)(b * 4 + hh) * LT + pos) * 192 + 128 + d) = o;
      } else if (gc < 1344) {
#pragma unroll
        for (int e = 0; e < 8; ++e) v[e] = siluf(v[e]);
        *(u32x4*)(B.HQ_() + grow * 512 + (gc - 832)) = pack8(v);
      } else if (gc < 2368) {
        int dir = gc >= 1856, ch = gc - (dir ? 1856 : 1344);
        u32x4 o;
        float lf[8];
        float lb8[8];
        ld8(lb8, B.lb_() + dir * 512 + ch);
#pragma unroll
        for (int e = 0; e < 8; ++e) {
          float lbv = lb8[e];
          float f = lbv + (1.f - lbv) / (1.f + __expf(-v[e]));
          lf[e] = logf(f);
        }
#pragma unroll
        for (int q = 0; q < 4; ++q) o[q] = (unsigned)f2h(lf[2 * q]) | ((unsigned)f2h(lf[2 * q + 1]) << 16);
        *(u32x4*)(B.LF_() + (size_t)dir * M * 512 + grow * 512 + ch) = o;
      } else if (gc < 2880) {
        *(u32x4*)(B.HI_() + grow * 512 + (gc - 2368)) = pack8(v);
      } else if (gc < 3392) {
        *(u32x4*)(B.HG_() + grow * 512 + (gc - 2880)) = pack8(v);
      }
    }
  } else if (EPI == EPI_UQ) {
    const int b = rowbase / LT, nl0 = rowbase - b * LT - CTX;
#pragma unroll 1
    for (int it = 0; it < 8; ++it) {
      int id = it * 256 + tid, i = id >> 4, cc = id & 15;
      int gc = n0 + cc * 8, head = gc / 192, dd = gc - head * 192, n = nl0 + i;
      float v[8];
      ld8(v, Ct + i * CLD + cc * 8);
      if (dd >= 128) rope8(v, Ct + i * CLD, cc * 8, dd - 128, n, B);
      const float s = rsqrtf(rowss[i] * (1.f / 512.f) + EPS) * QS_MLA;
#pragma unroll
      for (int e = 0; e < 8; ++e) v[e] *= s;
      *(u32x4*)(B.QF_() + ((size_t)(b * 4 + head) * SEQ + n) * 192 + dd) = pack8(v);
    }
  } else if (EPI == EPI_UKV) {
    const int b = rowbase / LT, pos0 = rowbase - b * LT, head = n0 >> 8;
    if ((n0 & 128) == 0) {
#pragma unroll 1
      for (int it = 0; it < 8; ++it) {
        int id = it * 256 + tid, i = id >> 4, cc = id & 15;
        const float s = rsqrtf(rowss[i] * (1.f / 256.f) + EPS);
        float v[8];
#pragma unroll
        for (int e = 0; e < 8; ++e) v[e] = Ct[i * CLD + cc * 8 + e] * s;
        *(u32x4*)(B.KF_() + ((size_t)(b * 4 + head) * LT + pos0 + i) * 192 + cc * 8) = pack8(v);
      }
    } else {
#pragma unroll 1
      for (int it = 0; it < 8; ++it) {
        int id = it * 256 + tid, c = id & 127, rc = id >> 7;
        float v[8];
#pragma unroll
        for (int e = 0; e < 8; ++e)
          v[e] = Ct[(rc * 8 + e) * CLD + c] * rsqrtf(rowss[rc * 8 + e] * (1.f / 256.f) + EPS);
        *(u32x4*)(B.VT1_() + ((size_t)(b * 4 + head) * 128 + c) * LT + pos0 + rc * 8) = pack8(v);
      }
    }
  } else if (EPI == EPI_FFN1) {
    const int nt = n0 >> 7;
    const float* cw = p.in[10] + (size_t)ea.layer * 3 * DFF;
    const float* cb = p.in[11] + (size_t)ea.layer * DFF;
    u16* G = ea.layer ? B.G1_() : B.G0_();
#pragma unroll 1
    for (int it = 0; it < 4; ++it) {
      int id = it * 256 + tid, i = id >> 3, cc = id & 7;
      int grow = rowbase + i;
      if (i >= 1 && i <= 126 && grow < ea.seg_hi) {
        const bool hp = (grow - 1 >= ea.seg_lo), hn = (grow + 1 < ea.seg_hi);
        float a[8], ap[8], an[8], u[8], w0[8], w1[8], w2[8], bb[8], v[8];
        const int fc0 = nt * 64 + cc * 8;
        ld8(a, Ct + i * CLD + cc * 8); ld8(ap, Ct + (i - 1) * CLD + cc * 8); ld8(an, Ct + (i + 1) * CLD + cc * 8);
        ld8(u, Ct + i * CLD + 64 + cc * 8);
        ld8(w0, cw + fc0); ld8(w1, cw + DFF + fc0); ld8(w2, cw + 2 * DFF + fc0); ld8(bb, cb + fc0);
#pragma unroll
        for (int e = 0; e < 8; ++e) {
          float av = (hp ? ap[e] : 0.f) * w0[e] + a[e] * w1[e] + (hn ? an[e] : 0.f) * w2[e] + bb[e];
          v[e] = siluf(av) * u[e];
        }
        *(u32x4*)(G + (size_t)grow * DFF + nt * 64 + cc * 8) = pack8(v);
      }
    }
  }
}

template <int EPI, bool SUMSQ>
DI void gemm_tile(char* smem, const Params& p, const Bufs& B, const u16* __restrict__ A, int lda, int rowbase,
                  int rlo, int rhi, const u16* __restrict__ Bt, int K, int n0, const EpiArgs& ea, int live) {
  u16* As = (u16*)smem;
  u16* Bs = As + 2 * 128 * LDT;
  float* Ct = (float*)smem;
  float* rowss = Ct + 128 * CLD;
  const int tid = otid(), lane = tid & 63, wid = tid >> 6, wm = wid >> 1, wn = wid & 1, r = lane & 31,
            h = lane >> 5;
  const int lrow = tid >> 3, lkc = tid & 7;
  int aoff[4], boff[4];
#pragma unroll
  for (int it = 0; it < 4; ++it) {
    int gr = rowbase + it * 32 + lrow;
    gr = gr < rlo ? rlo : (gr > rhi - 1 ? rhi - 1 : gr);
    aoff[it] = gr * lda + lkc * 8;
    boff[it] = (n0 + it * 32 + lrow) * K + lkc * 8;
  }
  u32x4 ra0[4], rb0[4], ra1[4], rb1[4];
  float ssq[4] = {0.f, 0.f, 0.f, 0.f};
  f32x16 acc[2][2];
#pragma unroll
  for (int i = 0; i < 2; ++i)
#pragma unroll
    for (int j = 0; j < 2; ++j)
#pragma unroll
      for (int g = 0; g < 16; ++g) acc[i][j][g] = 0.f;
  const int nk = K >> 6;
#pragma unroll
  for (int it = 0; it < 4; ++it) {
    ra0[it] = *(const u32x4*)(A + aoff[it]);
    rb0[it] = *(const u32x4*)(Bt + boff[it]);
  }
#pragma unroll
  for (int it = 0; it < 4; ++it) {
    ra1[it] = *(const u32x4*)(A + aoff[it] + 64);
    rb1[it] = *(const u32x4*)(Bt + boff[it] + 64);
  }
#define GEMM_STEP(RA, RB, BUF, TNEXT)                                                  \
  {                                                                                    \
    u16* Aw = As + (BUF) * 128 * LDT;                                                  \
    u16* Bw = Bs + (BUF) * 128 * LDT;                                                  \
    _Pragma("unroll") for (int it = 0; it < 4; ++it) {                                 \
      *(u32x4*)(Aw + (it * 32 + lrow) * LDT + lkc * 8) = RA[it];                       \
      *(u32x4*)(Bw + (it * 32 + lrow) * LDT + lkc * 8) = RB[it];                       \
      if (SUMSQ) {                                                                     \
        _Pragma("unroll") for (int q = 0; q < 4; ++q) {                                \
          float lo = bflo(RA[it][q]), hi = bfhi(RA[it][q]);                            \
          ssq[it] += lo * lo + hi * hi;                                                \
        }                                                                              \
      }                                                                                \
    }                                                                                  \
    __syncthreads();                                                                   \
    if ((TNEXT) < nk) {                                                                \
      _Pragma("unroll") for (int it = 0; it < 4; ++it) {                               \
        RA[it] = *(const u32x4*)(A + aoff[it] + (TNEXT) * 64);                         \
        RB[it] = *(const u32x4*)(Bt + boff[it] + (TNEXT) * 64);                        \
      }                                                                                \
    }                                                                                  \
    mma_ktile(Aw, Bw, acc, wm, wn, r, h);                                              \
  }
  for (int t = 0; t < nk; t += 2) {
    GEMM_STEP(ra0, rb0, 0, t + 2)
    GEMM_STEP(ra1, rb1, 1, t + 3)
  }
#undef GEMM_STEP
  __syncthreads();
  acc_to_lds(Ct, acc, wm, wn, r, h);
  if (SUMSQ) {
#pragma unroll
    for (int it = 0; it < 4; ++it) {
      float s = ssq[it];
      s += __shfl_xor(s, 1); s += __shfl_xor(s, 2); s += __shfl_xor(s, 4);
      if (lkc == 0) rowss[it * 32 + lrow] = s;
    }
  }
  __syncthreads();
  if (live) epilogue<EPI>(p, B, Ct, rowss, rowbase, n0, ea);
  __syncthreads();
}

DI void pool_tile(char* smem, const Params& p, const Bufs& B, int rt, int g) {
  u16* As = (u16*)smem;
  u16* Bs = As + 2 * 128 * LDT;
  float* Ct = (float*)smem;
  const int tid = otid(), lane = tid & 63, wid = tid >> 6, wm = wid >> 1, wn = wid & 1, r = lane & 31,
            h = lane >> 5;
  const int rowbase = rt * 128;
  const int b = rowbase / LT, pos0 = rowbase - b * LT;
  const int seg_lo = (pos0 < CTX) ? b * LT : b * LT + CTX;
  const int seg_hi = (pos0 < CTX) ? b * LT + CTX : (b + 1) * LT;
  u16* Ust = Bs;
#pragma unroll 1
  for (int it = 0; it < 9; ++it) {
    int c = it * 256 + tid, rr = c >> 4, kc = c & 15;
    int grow = rowbase - 8 + rr;
    if (grow >= seg_lo && grow < seg_hi)
      *(u32x4*)(Ust + rr * 128 + kc * 8) = *(const u32x4*)(B.U_() + (size_t)grow * 512 + g * 128 + kc * 8);
  }
  __syncthreads();
  {
    const int ch = tid & 127, rh = tid >> 7, hw = 1 << g;
    const u16* Uc = Ust + ch;
    const int bl = 8 - rowbase;
    const int t0 = rowbase + rh * 64;
    int lo = max(t0 - hw, seg_lo), hi = min(t0 + hw, seg_hi);
    float sum = 0.f;
    for (int s2 = lo; s2 < hi; ++s2) sum += bf2f(Uc[(s2 + bl) * 128]);
    u16* Ad = As + (ch >> 6) * 128 * LDT + (ch & 63);
    for (int i = 0; i < 64; ++i) {
      int t = t0 + i;
      float cnt = (float)(hi - lo);
      float d = sum / cnt - bf2f(Uc[(t + bl) * 128]);
      Ad[(rh * 64 + i) * LDT] = f2bf(d);
      if (t + hw < seg_hi) { sum += bf2f(Uc[(t + hw + bl) * 128]); hi = t + hw + 1; }
      if (t - hw >= seg_lo) { sum -= bf2f(Uc[(t - hw + bl) * 128]); lo = t - hw + 1; }
    }
  }
  __syncthreads();
#pragma unroll
  for (int it = 0; it < 8; ++it) {
    int c = it * 256 + tid, n = c >> 4, kc = c & 15;
    u32x4 v = *(const u32x4*)(B.wt_pool_() + (size_t)g * 128 * 128 + n * 128 + kc * 8);
    *(u32x4*)(Bs + (kc >> 3) * 128 * LDT + n * LDT + (kc & 7) * 8) = v;
  }
  __syncthreads();
  f32x16 acc[2][2];
#pragma unroll
  for (int i = 0; i < 2; ++i)
#pragma unroll
    for (int j = 0; j < 2; ++j)
#pragma unroll
      for (int q = 0; q < 16; ++q) acc[i][j][q] = 0.f;
  mma_ktile(As, Bs, acc, wm, wn, r, h);
  mma_ktile(As + 128 * LDT, Bs + 128 * LDT, acc, wm, wn, r, h);
  __syncthreads();
  acc_to_lds(Ct, acc, wm, wn, r, h);
  __syncthreads();
  EpiArgs ea{}; ea.aux = g;
  epilogue<EPI_POOL>(p, B, Ct, nullptr, rowbase, 0, ea);
  __syncthreads();
}

template <int DQK, int KT>
DI void attn_pass_sb(char* smem, const u16* __restrict__ Qg, const u16* __restrict__ Kg, const u16* __restrict__ VTg,
                  int nk, f32x16 (&O)[4], float& l_out, float* m_out = nullptr) {
  constexpr int KLD = DQK + 8, NKS = DQK / 16, KCH = DQK / 8, KPT = KT * KCH / 256, VLD = KT + 8, VPT = KT / 16,
                KB = KT / 32, VCH = KT / 8;
  u16* Ks = (u16*)smem;
  u16* Vs = Ks + KT * KLD;
  const int tid = otid(), lane = tid & 63, wid = tid >> 6, r = lane & 31, h = lane >> 5;
  bf16x8 qf[NKS];
#pragma unroll
  for (int ks = 0; ks < NKS; ++ks) qf[ks] = *(const bf16x8*)(Qg + (size_t)(wid * 32 + r) * DQK + ks * 16 + h * 8);
  u32x4 rk[KPT], rv[VPT];
#pragma unroll
  for (int dvb = 0; dvb < 4; ++dvb)
#pragma unroll
    for (int g = 0; g < 16; ++g) O[dvb][g] = 0.f;
  float m = -1e30f, l = 0.f;
  const int nt = nk / KT;
  int kgo[KPT], klo[KPT], vgo[VPT], vlo[VPT];
#pragma unroll
  for (int it = 0; it < KPT; ++it) {
    int c = it * 256 + tid, key = c / KCH, kc = c - key * KCH;
    int rho = (key & ~12) | ((key & 4) << 1) | ((key & 8) >> 1);
    kgo[it] = key * DQK + kc * 8;
    klo[it] = rho * KLD + kc * 8;
  }
#pragma unroll
  for (int it = 0; it < VPT; ++it) {
    int c = it * 256 + tid, dv = c / VCH, kc = c - dv * VCH;
    vgo[it] = dv * LT + kc * 8;
    vlo[it] = dv * VLD + kc * 8;
  }
#pragma unroll
  for (int it = 0; it < KPT; ++it) rk[it] = *(const u32x4*)(Kg + kgo[it]);
#pragma unroll
  for (int it = 0; it < VPT; ++it) rv[it] = *(const u32x4*)(VTg + vgo[it]);
  for (int t = 0; t < nt; ++t) {
    __syncthreads();
#pragma unroll
    for (int it = 0; it < KPT; ++it) *(u32x4*)(Ks + klo[it]) = rk[it];
#pragma unroll
    for (int it = 0; it < VPT; ++it) *(u32x4*)(Vs + vlo[it]) = rv[it];
    __syncthreads();
    if (t + 1 < nt) {
      const u16* Kn = Kg + (size_t)(t + 1) * KT * DQK;
      const u16* Vn = VTg + (t + 1) * KT;
#pragma unroll
      for (int it = 0; it < KPT; ++it) rk[it] = *(const u32x4*)(Kn + kgo[it]);
#pragma unroll
      for (int it = 0; it < VPT; ++it) rv[it] = *(const u32x4*)(Vn + vgo[it]);
    }
    f32x16 S[KB];
#pragma unroll
    for (int kb = 0; kb < KB; ++kb) {
#pragma unroll
      for (int g = 0; g < 16; ++g) S[kb][g] = 0.f;
#pragma unroll
      for (int ks = 0; ks < NKS; ++ks) {
        bf16x8 a = *(const bf16x8*)(Ks + (kb * 32 + r) * KLD + ks * 16 + h * 8);
        S[kb] = MFMA32(a, qf[ks], S[kb]);
      }
    }
    float mx = -1e30f;
#pragma unroll
    for (int kb = 0; kb < KB; ++kb)
#pragma unroll
      for (int g = 0; g < 16; ++g) mx = fmaxf(mx, S[kb][g]);
    mx = fmaxf(mx, __shfl_xor(mx, 32));
    const bool chg = __any(mx > m + 8.f);
    float alpha = 1.f;
    if (chg) { const float mn_ = fmaxf(m, mx); alpha = __builtin_amdgcn_exp2f(m - mn_); m = mn_; }
    const float mn = m;
    float ps = 0.f;
#pragma unroll
    for (int kb = 0; kb < KB; ++kb)
#pragma unroll
      for (int g = 0; g < 16; ++g) {
        float pv = __builtin_amdgcn_exp2f(S[kb][g] - mn);
        S[kb][g] = pv;
        ps += pv;
      }
    l = l * alpha + ps;
    if (chg) {
#pragma unroll
      for (int dvb = 0; dvb < 4; ++dvb)
#pragma unroll
        for (int g = 0; g < 16; ++g) O[dvb][g] *= alpha;
    }
    bf16x8 pf[KB][2];
#pragma unroll
    for (int kb = 0; kb < KB; ++kb)
#pragma unroll
      for (int s = 0; s < 2; ++s) {
        u32x4 o;
#pragma unroll
        for (int q = 0; q < 4; ++q) o[q] = pk2(S[kb][8 * s + 2 * q], S[kb][8 * s + 2 * q + 1]);
        pf[kb][s] = __builtin_bit_cast(bf16x8, o);
      }
#pragma unroll
    for (int dvb = 0; dvb < 4; ++dvb) {
#pragma unroll
      for (int kb = 0; kb < KB; ++kb)
#pragma unroll
        for (int s = 0; s < 2; ++s) {
          bf16x8 a = *(const bf16x8*)(Vs + (dvb * 32 + r) * VLD + kb * 32 + s * 16 + h * 8);
          O[dvb] = MFMA32(a, pf[kb][s], O[dvb]);
        }
      if (dvb & 1) asm volatile("" ::: "memory");
    }
  }
  l_out = l + __shfl_xor(l, 32);
  if (m_out) *m_out = m;
}

template <int DQK, int KT, int NT>
DI void attn_pass(char* smem, const u16* __restrict__ Qg, const u16* __restrict__ Kg, const u16* __restrict__ VTg,
                  int nk, f32x16 (&O)[4], float& l_out) {
  constexpr int KLD = DQK + 8, NKS = DQK / 16, KCH = DQK / 8, KPT = KT * KCH / NT, VLD = KT + 8, VPT = 128 * (KT / 8) / NT,
                KB = KT / 32, VCH = KT / 8, STAGE = KT * KLD + 128 * VLD;
  u16* base = (u16*)smem;
  const int tid = otidn<NT>(), lane = tid & 63, wid = tid >> 6, r = lane & 31, h = lane >> 5;
  bf16x8 qf[NKS];
#pragma unroll
  for (int ks = 0; ks < NKS; ++ks) qf[ks] = *(const bf16x8*)(Qg + (size_t)(wid * 32 + r) * DQK + ks * 16 + h * 8);
  u32x4 rk[KPT], rv[VPT];
#pragma unroll
  for (int dvb = 0; dvb < 4; ++dvb)
#pragma unroll
    for (int g = 0; g < 16; ++g) O[dvb][g] = 0.f;
  float m = -1e30f, l = 0.f;
  const int nt = nk / KT;
#define KGO(it, T) ({ int c_ = (it) * NT + (T), key_ = c_ / KCH; key_ * DQK + (c_ - key_ * KCH) * 8; })
#define KLO(it, T) ({ int c_ = (it) * NT + (T), key_ = c_ / KCH, kc_ = c_ - key_ * KCH; \
                      int rho_ = (key_ & ~12) | ((key_ & 4) << 1) | ((key_ & 8) >> 1); rho_ * KLD + kc_ * 8; })
#define VGO(it, T) ({ int c_ = (it) * NT + (T), dv_ = c_ / VCH; dv_ * LT + (c_ - dv_ * VCH) * 8; })
#define VLO(it, T) ({ int c_ = (it) * NT + (T), dv_ = c_ / VCH; KT * KLD + dv_ * VLD + (c_ - dv_ * VCH) * 8; })
  { const int tq = otidn<NT>();
#pragma unroll
  for (int it = 0; it < KPT; ++it) rk[it] = *(const u32x4*)(Kg + KGO(it, tq));
#pragma unroll
  for (int it = 0; it < VPT; ++it) rv[it] = *(const u32x4*)(VTg + VGO(it, tq));
  __syncthreads();
#pragma unroll
  for (int it = 0; it < KPT; ++it) *(u32x4*)(base + KLO(it, tq)) = rk[it];
#pragma unroll
  for (int it = 0; it < VPT; ++it) *(u32x4*)(base + VLO(it, tq)) = rv[it];
  if (nt > 1) {
#pragma unroll
    for (int it = 0; it < KPT; ++it) rk[it] = *(const u32x4*)(Kg + (size_t)KT * DQK + KGO(it, tq));
#pragma unroll
    for (int it = 0; it < VPT; ++it) rv[it] = *(const u32x4*)(VTg + KT + VGO(it, tq));
  }
  }
  __syncthreads();
  for (int t = 0; t < nt; ++t) {
    const u16* Ks = base + (t & 1) * STAGE;
    const u16* Vs = Ks + KT * KLD;
    f32x16 S[KB];
#pragma unroll
    for (int kb = 0; kb < KB; ++kb) {
#pragma unroll
      for (int g = 0; g < 16; ++g) S[kb][g] = 0.f;
#pragma unroll
      for (int ks = 0; ks < NKS; ++ks) {
        bf16x8 a = *(const bf16x8*)(Ks + (kb * 32 + r) * KLD + ks * 16 + h * 8);
        S[kb] = MFMA32(a, qf[ks], S[kb]);
      }
    }
    __builtin_amdgcn_sched_group_barrier(0x100, 2, 0);
#pragma unroll
    for (int i = 0; i < KB * NKS - 2; ++i) {
      __builtin_amdgcn_sched_group_barrier(0x008, 1, 0);
      __builtin_amdgcn_sched_group_barrier(0x100, 1, 0);
    }
    __builtin_amdgcn_sched_group_barrier(0x008, 2, 0);
    if (t + 1 < nt) {
      const int tq = otidn<NT>();
      u16* nb_ = base + ((t + 1) & 1) * STAGE;
#pragma unroll
      for (int it = 0; it < KPT; ++it) *(u32x4*)(nb_ + KLO(it, tq)) = rk[it];
#pragma unroll
      for (int it = 0; it < VPT; ++it) *(u32x4*)(nb_ + VLO(it, tq)) = rv[it];
      if (t + 2 < nt) {
        const u16* Kn = Kg + (size_t)(t + 2) * KT * DQK;
        const u16* Vn = VTg + (t + 2) * KT;
#pragma unroll
        for (int it = 0; it < KPT; ++it) rk[it] = *(const u32x4*)(Kn + KGO(it, tq));
#pragma unroll
        for (int it = 0; it < VPT; ++it) rv[it] = *(const u32x4*)(Vn + VGO(it, tq));
      }
    }
    float mx = -1e30f;
#pragma unroll
    for (int kb = 0; kb < KB; ++kb)
#pragma unroll
      for (int g = 0; g < 16; ++g) mx = fmaxf(mx, S[kb][g]);
    mx = fmaxf(mx, __shfl_xor(mx, 32));
    const bool chg = __any(mx > m + 8.f);
    float alpha = 1.f;
    if (chg) { const float mn_ = fmaxf(m, mx); alpha = __builtin_amdgcn_exp2f(m - mn_); m = mn_; }
    const float mn = m;
    float ps = 0.f;
#pragma unroll
    for (int kb = 0; kb < KB; ++kb)
#pragma unroll
      for (int g = 0; g < 16; ++g) {
        float pv = __builtin_amdgcn_exp2f(S[kb][g] - mn);
        S[kb][g] = pv;
        ps += pv;
      }
    l = l * alpha + ps;
    if (chg) {
#pragma unroll
      for (int dvb = 0; dvb < 4; ++dvb)
#pragma unroll
        for (int g = 0; g < 16; ++g) O[dvb][g] *= alpha;
    }
    bf16x8 pf[KB][2];
#pragma unroll
    for (int kb = 0; kb < KB; ++kb)
#pragma unroll
      for (int s = 0; s < 2; ++s) {
        u32x4 o;
#pragma unroll
        for (int q = 0; q < 4; ++q) o[q] = pk2(S[kb][8 * s + 2 * q], S[kb][8 * s + 2 * q + 1]);
        pf[kb][s] = __builtin_bit_cast(bf16x8, o);
      }
#pragma unroll
    for (int dvb = 0; dvb < 4; ++dvb) {
#pragma unroll
      for (int kb = 0; kb < KB; ++kb)
#pragma unroll
        for (int s = 0; s < 2; ++s) {
          bf16x8 a = *(const bf16x8*)(Vs + (dvb * 32 + r) * VLD + kb * 32 + s * 16 + h * 8);
          O[dvb] = MFMA32(a, pf[kb][s], O[dvb]);
        }
    }
    __builtin_amdgcn_sched_group_barrier(0x100, 2, 0);
#pragma unroll
    for (int i = 0; i < 4 * KB * 2 - 2; ++i) {
      __builtin_amdgcn_sched_group_barrier(0x008, 1, 0);
      __builtin_amdgcn_sched_group_barrier(0x100, 1, 0);
    }
    __builtin_amdgcn_sched_group_barrier(0x008, 2, 0);
    __syncthreads();
  }
  l_out = l + __shfl_xor(l, 32);
#undef KGO
#undef KLO
#undef VGO
#undef VLO
}

DI void diff_attn_item(char* smem, const Params& p, const Bufs& B, int b, int vh, int pos0, int nk) {
  const int tid = otid(), lane = tid & 63, wid = tid >> 6, r = lane & 31, h = lane >> 5;
  f32x16 O[4];
  unsigned* Okl = (unsigned*)(smem + 40960);
  const float lam = B.lam_()[0];
  const u16* VT = B.VT0_() + (size_t)(b * 4 + vh) * 128 * LT;
  float ss = 0.f;
#pragma unroll
  for (int e = 0; e < 2; ++e) {
    const int head = 2 * vh + e;
    const u16* Q = B.Q0_() + ((size_t)(b * 8 + head) * LT + pos0) * 64;
    const u16* K = B.K0_() + (size_t)(b * 8 + head) * LT * 64;
    float l;
    attn_pass_sb<64, 64>(smem, Q, K, VT, nk, O, l);
    const float inv = 1.f / l;
    if (e == 0) {
#pragma unroll
      for (int dvb = 0; dvb < 4; ++dvb)
#pragma unroll
        for (int q = 0; q < 8; ++q) Okl[(dvb * 8 + q) * 256 + tid] = pk2(O[dvb][2 * q] * inv, O[dvb][2 * q + 1] * inv);
    } else {
#pragma unroll
      for (int dvb = 0; dvb < 4; ++dvb)
#pragma unroll
        for (int q = 0; q < 8; ++q) {
          unsigned o0 = Okl[(dvb * 8 + q) * 256 + tid];
          float a0 = bflo(o0) - lam * (O[dvb][2 * q] * inv), a1 = bfhi(o0) - lam * (O[dvb][2 * q + 1] * inv);
          O[dvb][2 * q] = a0; O[dvb][2 * q + 1] = a1;
          ss += a0 * a0 + a1 * a1;
        }
    }
  }
  ss += __shfl_xor(ss, 32);
  const float rstd = rsqrtf(ss * (1.f / 128.f) + EPS) * 0.8f;
  const float* sub = p.in[17];
  u16* orow = B.MIX0_() + (size_t)(b * LT + pos0 + wid * 32 + r) * 1024 + 512 + vh * 128;
#pragma unroll
  for (int dvb = 0; dvb < 4; ++dvb)
#pragma unroll
    for (int g = 0; g < 4; ++g) {
      int dv0 = dvb * 32 + 8 * g + 4 * h;
      u32x2 o;
      o[0] = pk2(O[dvb][4 * g] * rstd * sub[dv0], O[dvb][4 * g + 1] * rstd * sub[dv0 + 1]);
      o[1] = pk2(O[dvb][4 * g + 2] * rstd * sub[dv0 + 2], O[dvb][4 * g + 3] * rstd * sub[dv0 + 3]);
      *(u32x2*)(orow + dv0) = o;
    }
}

DI void mla_attn_item(char* smem_wg, char* smem, const Bufs& B, int b, int hd, int qt, bool split, int VB) {
  const int tid = otid(), lane = tid & 63, wid = tid >> 6, r = lane & 31, h = lane >> 5;
  f32x16 O[4];
  float l, m;
  const int key0 = split ? VB * 2176 : 0;
  const u16* Q = B.QF_() + ((size_t)(b * 4 + hd) * SEQ + qt * 128) * 192;
  const u16* K = B.KF_() + ((size_t)(b * 4 + hd) * LT + key0) * 192;
  const u16* VT = B.VT1_() + (size_t)(b * 4 + hd) * 128 * LT + key0;
  attn_pass_sb<192, 64>(smem, Q, K, VT, split ? 2176 : LT, O, l, &m);
  float a0 = 1.f, a1 = 0.f, inv;
  float* X = (float*)(smem_wg + SMEM_HALF);
  if (split) {
    __syncthreads();
    if (VB == 1) {
#pragma unroll
      for (int dvb = 0; dvb < 4; ++dvb)
#pragma unroll
        for (int g = 0; g < 16; ++g) X[(dvb * 16 + g) * 256 + tid] = O[dvb][g];
      X[64 * 256 + tid] = m; X[65 * 256 + tid] = l;
    }
    __syncthreads();
    const float m1 = X[64 * 256 + tid], l1 = X[65 * 256 + tid];
    const float mm = fmaxf(m, m1);
    a0 = __builtin_amdgcn_exp2f(m - mm); a1 = __builtin_amdgcn_exp2f(m1 - mm);
    inv = 1.f / (l * a0 + l1 * a1);
  } else {
    inv = 1.f / l;
  }
  if (!split || VB == 0) {
    u16* orow = B.MIX1_() + (size_t)(b * LT + CTX + qt * 128 + wid * 32 + r) * 1024 + hd * 128;
#pragma unroll
    for (int dvb = 0; dvb < 4; ++dvb)
#pragma unroll
      for (int g = 0; g < 4; ++g) {
        int dv0 = dvb * 32 + 8 * g + 4 * h;
        float v[4];
#pragma unroll
        for (int e = 0; e < 4; ++e) {
          float x = O[dvb][4 * g + e] * a0;
          if (split) x += X[(dvb * 16 + 4 * g + e) * 256 + tid] * a1;
          v[e] = x * inv;
        }
        u32x2 o;
        o[0] = pk2(v[0], v[1]); o[1] = pk2(v[2], v[3]);
        *(u32x2*)(orow + dv0) = o;
      }
  }
  if (split) __syncthreads();
}


DI void attn_pass_pp(char* smem, const u16* __restrict__ Qg, const u16* __restrict__ Kg, const u16* __restrict__ VTg,
                     int nk, f32x16 (&O)[4], float& l_out) {
  constexpr int DQK = 64, KT = 64, KLD = 72, VLD = 72, KSZ = KT * KLD, VSZ = 128 * VLD;
  u16* Kb = (u16*)smem;
  u16* Vb = Kb + 3 * KSZ;
  const int tid = otidn<512>(), lane = tid & 63, wid = tid >> 6, r = lane & 31, h = lane >> 5;
  bf16x8 qf[4];
#pragma unroll
  for (int ks = 0; ks < 4; ++ks) qf[ks] = *(const bf16x8*)(Qg + (size_t)(wid * 32 + r) * DQK + ks * 16 + h * 8);
#pragma unroll
  for (int dvb = 0; dvb < 4; ++dvb)
#pragma unroll
    for (int g = 0; g < 16; ++g) O[dvb][g] = 0.f;
  float m = -1e30f, l = 0.f;
  const int nt = nk / KT;
  const int kkey = tid >> 3, kkc = tid & 7;
  const int krho = (kkey & ~12) | ((kkey & 4) << 1) | ((kkey & 8) >> 1);
  const int kgo = kkey * DQK + kkc * 8, klo = krho * KLD + kkc * 8;
  const int vdv0 = tid >> 3, vkc = tid & 7;
  const int vgo0 = vdv0 * LT + vkc * 8, vlo0 = vdv0 * VLD + vkc * 8;
  u32x4 rk, rv0, rv1;
#define PP_QK(Sx, kbuf) {                                                                 \
    const u16* Ks_ = Kb + (kbuf) * KSZ;                                                   \
    _Pragma("unroll") for (int kb = 0; kb < 2; ++kb) {                                    \
      _Pragma("unroll") for (int g = 0; g < 16; ++g) Sx[kb][g] = 0.f;                     \
      _Pragma("unroll") for (int ks = 0; ks < 4; ++ks) {                                  \
        bf16x8 a_ = *(const bf16x8*)(Ks_ + (kb * 32 + r) * KLD + ks * 16 + h * 8);        \
        Sx[kb] = MFMA32(a_, qf[ks], Sx[kb]);                                              \
      } } }
  __syncthreads();
  rk = *(const u32x4*)(Kg + kgo);
  rv0 = *(const u32x4*)(VTg + vgo0); rv1 = *(const u32x4*)(VTg + vgo0 + 64 * LT);
  *(u32x4*)(Kb + klo) = rk;
  *(u32x4*)(Vb + vlo0) = rv0; *(u32x4*)(Vb + vlo0 + 64 * VLD) = rv1;
  if (nt > 1) { rk = *(const u32x4*)(Kg + (size_t)KT * DQK + kgo); *(u32x4*)(Kb + KSZ + klo) = rk; }
  __syncthreads();
  f32x16 Sc[2], Sn[2];
  PP_QK(Sc, 0)
  if (nt > 2) rk = *(const u32x4*)(Kg + (size_t)2 * KT * DQK + kgo);
  if (nt > 1) { rv0 = *(const u32x4*)(VTg + KT + vgo0); rv1 = *(const u32x4*)(VTg + KT + vgo0 + 64 * LT); }
  int kb_cur = 0;
  for (int t = 0; t < nt; ++t) {
    const int kb_n1 = kb_cur == 2 ? 0 : kb_cur + 1, kb_n2 = kb_n1 == 2 ? 0 : kb_n1 + 1;
    if (t + 1 < nt) PP_QK(Sn, kb_n1)
    float mx = -1e30f;
#pragma unroll
    for (int kb = 0; kb < 2; ++kb)
#pragma unroll
      for (int g = 0; g < 16; ++g) mx = fmaxf(mx, Sc[kb][g]);
    mx = fmaxf(mx, __shfl_xor(mx, 32));
    const bool chg = __any(mx > m + 8.f);
    float alpha = 1.f;
    if (chg) { const float mn_ = fmaxf(m, mx); alpha = __builtin_amdgcn_exp2f(m - mn_); m = mn_; }
    const float mn = m;
    float ps = 0.f;
#pragma unroll
    for (int kb = 0; kb < 2; ++kb)
#pragma unroll
      for (int g = 0; g < 16; ++g) {
        float pv = __builtin_amdgcn_exp2f(Sc[kb][g] - mn);
        Sc[kb][g] = pv;
        ps += pv;
      }
    l = l * alpha + ps;
    if (chg) {
#pragma unroll
      for (int dvb = 0; dvb < 4; ++dvb)
#pragma unroll
        for (int g = 0; g < 16; ++g) O[dvb][g] *= alpha;
    }
    bf16x8 pf[2][2];
#pragma unroll
    for (int kb = 0; kb < 2; ++kb)
#pragma unroll
      for (int s2 = 0; s2 < 2; ++s2) {
        u32x4 o;
#pragma unroll
        for (int q = 0; q < 4; ++q) o[q] = pk2(Sc[kb][8 * s2 + 2 * q], Sc[kb][8 * s2 + 2 * q + 1]);
        pf[kb][s2] = __builtin_bit_cast(bf16x8, o);
      }
    {
      const u16* Vs = Vb + (t & 1) * VSZ;
#pragma unroll
      for (int dvb = 0; dvb < 4; ++dvb)
#pragma unroll
        for (int kb = 0; kb < 2; ++kb)
#pragma unroll
          for (int s2 = 0; s2 < 2; ++s2) {
            bf16x8 a = *(const bf16x8*)(Vs + (dvb * 32 + r) * VLD + kb * 32 + s2 * 16 + h * 8);
            O[dvb] = MFMA32(a, pf[kb][s2], O[dvb]);
          }
    }
    if (t + 2 < nt) *(u32x4*)(Kb + kb_n2 * KSZ + klo) = rk;
    if (t + 1 < nt) { u16* Vn = Vb + ((t + 1) & 1) * VSZ; *(u32x4*)(Vn + vlo0) = rv0; *(u32x4*)(Vn + vlo0 + 64 * VLD) = rv1; }
    if (t + 3 < nt) rk = *(const u32x4*)(Kg + (size_t)(t + 3) * KT * DQK + kgo);
    if (t + 2 < nt) { const u16* Vg = VTg + (t + 2) * KT; rv0 = *(const u32x4*)(Vg + vgo0); rv1 = *(const u32x4*)(Vg + vgo0 + 64 * LT); }
    __syncthreads();
#pragma unroll
    for (int kb = 0; kb < 2; ++kb) Sc[kb] = Sn[kb];
    kb_cur = kb_n1;
  }
#undef PP_QK
  l_out = l + __shfl_xor(l, 32);
}

DI void diff_attn_item8(char* smem_wg, const Params& p, const Bufs& B, int b, int vh, int pos0, int nk) {
  const int tid = otidn<512>(), lane = tid & 63, wid = tid >> 6, r = lane & 31, h = lane >> 5;
  f32x16 O[4];
  unsigned* Okl = (unsigned*)(smem_wg + 65536);
  const float lam = B.lam_()[0];
  const u16* VT = B.VT0_() + (size_t)(b * 4 + vh) * 128 * LT;
  float ss = 0.f;
#pragma unroll
  for (int e = 0; e < 2; ++e) {
    const int head = 2 * vh + e;
    const u16* Q = B.Q0_() + ((size_t)(b * 8 + head) * LT + pos0) * 64;
    const u16* K = B.K0_() + (size_t)(b * 8 + head) * LT * 64;
    float l;
    attn_pass_pp(smem_wg, Q, K, VT, nk, O, l);
    const float inv = 1.f / l;
    if (e == 0) {
#pragma unroll
      for (int dvb = 0; dvb < 4; ++dvb)
#pragma unroll
        for (int q = 0; q < 8; ++q) Okl[(dvb * 8 + q) * 512 + tid] = pk2(O[dvb][2 * q] * inv, O[dvb][2 * q + 1] * inv);
    } else {
#pragma unroll
      for (int dvb = 0; dvb < 4; ++dvb)
#pragma unroll
        for (int q = 0; q < 8; ++q) {
          unsigned o0 = Okl[(dvb * 8 + q) * 512 + tid];
          float a0 = bflo(o0) - lam * (O[dvb][2 * q] * inv), a1 = bfhi(o0) - lam * (O[dvb][2 * q + 1] * inv);
          O[dvb][2 * q] = a0; O[dvb][2 * q + 1] = a1;
          ss += a0 * a0 + a1 * a1;
        }
    }
  }
  ss += __shfl_xor(ss, 32);
  const float rstd = rsqrtf(ss * (1.f / 128.f) + EPS) * 0.8f;
  const float* sub = p.in[17];
  u16* orow = B.MIX0_() + (size_t)(b * LT + pos0 + wid * 32 + r) * 1024 + 512 + vh * 128;
#pragma unroll
  for (int dvb = 0; dvb < 4; ++dvb)
#pragma unroll
    for (int g = 0; g < 4; ++g) {
      int dv0 = dvb * 32 + 8 * g + 4 * h;
      u32x2 o;
      o[0] = pk2(O[dvb][4 * g] * rstd * sub[dv0], O[dvb][4 * g + 1] * rstd * sub[dv0 + 1]);
      o[1] = pk2(O[dvb][4 * g + 2] * rstd * sub[dv0 + 2], O[dvb][4 * g + 3] * rstd * sub[dv0 + 3]);
      *(u32x2*)(orow + dv0) = o;
    }
}
DI void mla_attn_item8(char* smem_wg, const Bufs& B, int b, int hd, int qt) {
  const int tid = otidn<512>(), lane = tid & 63, wid = tid >> 6, r = lane & 31, h = lane >> 5;
  f32x16 O[4];
  float l;
  const u16* Q = B.QF_() + ((size_t)(b * 4 + hd) * SEQ + qt * 256) * 192;
  const u16* K = B.KF_() + (size_t)(b * 4 + hd) * LT * 192;
  const u16* VT = B.VT1_() + (size_t)(b * 4 + hd) * 128 * LT;
  attn_pass<192, 64, 512>(smem_wg, Q, K, VT, LT, O, l);
  const float inv = 1.f / l;
  u16* orow = B.MIX1_() + (size_t)(b * LT + CTX + qt * 256 + wid * 32 + r) * 1024 + hd * 128;
#pragma unroll
  for (int dvb = 0; dvb < 4; ++dvb)
#pragma unroll
    for (int g = 0; g < 4; ++g) {
      int dv0 = dvb * 32 + 8 * g + 4 * h;
      u32x2 o;
      o[0] = pk2(O[dvb][4 * g] * inv, O[dvb][4 * g + 1] * inv);
      o[1] = pk2(O[dvb][4 * g + 2] * inv, O[dvb][4 * g + 3] * inv);
      *(u32x2*)(orow + dv0) = o;
    }
}

constexpr int HLD = 136;
DI void hgrn_item(char* smem, const Bufs& B, int b, int hd, int dir) {
  u16* Qs = (u16*)smem;
  u16* Ksm = Qs + 64 * HLD;
  u16* KsT = Ksm + 64 * HLD;
  u16* VsT = KsT + 128 * LDT;
  float* emid = (float*)(VsT + 128 * LDT);
  float* ecm = emid + 128;
  const int tid = otid(), lane = tid & 63, w = tid >> 6, r = lane & 31, h = lane >> 5;
  f32x16 S[4];
#pragma unroll
  for (int kb = 0; kb < 4; ++kb)
#pragma unroll
    for (int g = 0; g < 16; ++g) S[kb][g] = 0.f;
  const u16* LFd = B.LF_() + (size_t)dir * M * 512;
  u16* OHd = B.OH_() + (size_t)dir * M * 512;
  u32x4 pq[4], pl[4], pv[4];
#define HG_LOAD(CI) {                                                                         \
    const int c_ = dir ? ((CI) < 4 ? 3 - (CI) : 71 - (CI)) : (CI);                             \
    const int rowc_ = b * LT + c_ * 64;                                                        \
    _Pragma("unroll") for (int it = 0; it < 4; ++it) {                                         \
      const int cid = it * 256 + tid, pp = cid >> 4, cc = cid & 15;                            \
      const size_t grow = (size_t)(rowc_ + (dir ? 63 - pp : pp));                              \
      pq[it] = *(const u32x4*)(B.HQ_() + grow * 512 + hd * 128 + cc * 8);                      \
      pl[it] = *(const u32x4*)(LFd + grow * 512 + hd * 128 + cc * 8);                          \
      const int cc2 = it * 4 + w;                                                              \
      const size_t grow2 = (size_t)(rowc_ + (dir ? 63 - lane : lane));                         \
      pv[it] = *(const u32x4*)(B.HI_() + grow2 * 512 + hd * 128 + cc2 * 8);                    \
    } }
  HG_LOAD(0)
  for (int ci = 0; ci < 68; ++ci) {
    const int c = dir ? (ci < 4 ? 3 - ci : 71 - ci) : ci;
    const int rowc = b * LT + c * 64;
#pragma unroll
    for (int it = 0; it < 4; ++it) {
      const int cid = it * 256 + tid, pp = cid >> 4, cc = cid & 15;
      *(u32x4*)(Qs + pp * HLD + cc * 8) = pq[it];
      *(u32x4*)(Ksm + pp * HLD + cc * 8) = pl[it];
      const int cc2 = it * 4 + w;
#pragma unroll
      for (int q = 0; q < 4; ++q) {
        VsT[(cc2 * 8 + 2 * q) * LDT + lane] = (u16)(pv[it][q] & 0xffffu);
        VsT[(cc2 * 8 + 2 * q + 1) * LDT + lane] = (u16)(pv[it][q] >> 16);
      }
    }
    if (ci + 1 < 68) HG_LOAD(ci + 1)
    __syncthreads();
    {
      const int ch = tid & 127, half = tid >> 7;
      float tot0 = 0.f;
      for (int pp = 0; pp < 32; ++pp) tot0 += h2f(Ksm[pp * HLD + ch]);
      __syncthreads();
      float run = half ? 0.f : -tot0;
#pragma unroll
      for (int p8 = 0; p8 < 4; ++p8) {
        float kt[8];
#pragma unroll
        for (int e = 0; e < 8; ++e) {
          int pp = half * 32 + p8 * 8 + e;
          float lf = h2f(Ksm[pp * HLD + ch]);
          run += lf;
          float q = bf2f(Qs[pp * HLD + ch]);
          float er = __expf(run);
          Qs[pp * HLD + ch] = f2bf(q * er);
          kt[e] = (1.f - __expf(lf)) / er;
          Ksm[pp * HLD + ch] = f2bf(kt[e]);
        }
        *(u32x4*)(KsT + ch * LDT + half * 32 + p8 * 8) = pack8(kt);
      }
      if (half == 0) emid[ch] = __expf(tot0); else ecm[ch] = __expf(run);
    }
    __syncthreads();
#define HG_FENCE asm volatile("" ::: "memory")
    f32x16 oTb[2];
#pragma unroll
    for (int tb = 0; tb < 2; ++tb)
#pragma unroll
      for (int g = 0; g < 16; ++g) oTb[tb][g] = 0.f;
#pragma unroll
    for (int kb = 0; kb < 4; ++kb) {
#pragma unroll
      for (int g4 = 0; g4 < 4; ++g4) {
        const float4 e4 = *(const float4*)(emid + kb * 32 + 8 * g4 + 4 * h);
        S[kb][4 * g4] *= e4.x; S[kb][4 * g4 + 1] *= e4.y; S[kb][4 * g4 + 2] *= e4.z; S[kb][4 * g4 + 3] *= e4.w;
      }
#pragma unroll
      for (int s = 0; s < 2; ++s) {
        u32x4 o;
#pragma unroll
        for (int q = 0; q < 4; ++q) o[q] = pk2(S[kb][8 * s + 2 * q], S[kb][8 * s + 2 * q + 1]);
        const bf16x8 xa = __builtin_bit_cast(bf16x8, o);
#pragma unroll
        for (int tb = 0; tb < 2; ++tb) {
          const u16* qp = Qs + (tb * 32 + r) * HLD + kb * 32 + s * 16 + 4 * h;
          u32x2 lo = *(const u32x2*)qp, hi = *(const u32x2*)(qp + 8);
          u32x4 bq = {lo[0], lo[1], hi[0], hi[1]};
          oTb[tb] = MFMA32(xa, __builtin_bit_cast(bf16x8, bq), oTb[tb]);
        }
      }
      HG_FENCE;
    }
#pragma unroll
    for (int tb = 0; tb < 2; ++tb) {
#pragma unroll
      for (int sb = 0; sb <= tb; ++sb) {
        f32x16 P;
#pragma unroll
        for (int g = 0; g < 16; ++g) P[g] = 0.f;
#pragma unroll
        for (int ks = 0; ks < 8; ++ks) {
          bf16x8 a = *(const bf16x8*)(Ksm + (sb * 32 + r) * HLD + ks * 16 + h * 8);
          bf16x8 bb = *(const bf16x8*)(Qs + (tb * 32 + r) * HLD + ks * 16 + h * 8);
          P = MFMA32(a, bb, P);
          if ((ks & 3) == 3) HG_FENCE;
        }
        if (sb == tb) {
#pragma unroll
          for (int g = 0; g < 16; ++g) P[g] = (crow(g, h) <= r) ? P[g] : 0.f;
        }
#pragma unroll
        for (int s = 0; s < 2; ++s) {
          u32x4 o;
#pragma unroll
          for (int q = 0; q < 4; ++q) o[q] = pk2(P[8 * s + 2 * q], P[8 * s + 2 * q + 1]);
          const u16* vp = VsT + (w * 32 + r) * LDT + sb * 32 + s * 16 + 4 * h;
          u32x2 lo = *(const u32x2*)vp, hi = *(const u32x2*)(vp + 8);
          u32x4 av = {lo[0], lo[1], hi[0], hi[1]};
          oTb[tb] = MFMA32(__builtin_bit_cast(bf16x8, av), __builtin_bit_cast(bf16x8, o), oTb[tb]);
        }
        HG_FENCE;
      }
      {
        int pp = tb * 32 + r;
        size_t grow = (size_t)(rowc + (dir ? 63 - pp : pp));
        u16* op = OHd + grow * 512 + hd * 128 + w * 32;
#pragma unroll
        for (int g4 = 0; g4 < 4; ++g4) {
          u32x2 o;
          o[0] = pk2(oTb[tb][4 * g4], oTb[tb][4 * g4 + 1]);
          o[1] = pk2(oTb[tb][4 * g4 + 2], oTb[tb][4 * g4 + 3]);
          *(u32x2*)(op + 8 * g4 + 4 * h) = o;
        }
      }
      HG_FENCE;
    }
#pragma unroll
    for (int kb = 0; kb < 4; ++kb) {
#pragma unroll
      for (int ts = 0; ts < 4; ++ts) {
        bf16x8 a = *(const bf16x8*)(KsT + (kb * 32 + r) * LDT + ts * 16 + h * 8);
        bf16x8 bb = *(const bf16x8*)(VsT + (w * 32 + r) * LDT + ts * 16 + h * 8);
        S[kb] = MFMA32(a, bb, S[kb]);
      }
#pragma unroll
      for (int g4 = 0; g4 < 4; ++g4) {
        const float4 e4 = *(const float4*)(ecm + kb * 32 + 8 * g4 + 4 * h);
        S[kb][4 * g4] *= e4.x; S[kb][4 * g4 + 1] *= e4.y; S[kb][4 * g4 + 2] *= e4.z; S[kb][4 * g4 + 3] *= e4.w;
      }
      HG_FENCE;
    }
#undef HG_FENCE
    __syncthreads();
  }
#undef HG_LOAD
}

DI void hgrn_readout_row8(const Params& p, const Bufs& B, int grow, int lane) {
  const size_t o = (size_t)grow * 512 + lane * 8;
  const u32x4 a = *(const u32x4*)(B.OH_() + o), bq = *(const u32x4*)(B.OH_() + (size_t)M * 512 + o);
  const u32x4 gq = *(const u32x4*)(B.HG_() + o);
  float v[8], g[8], hn[8];
  float ss = 0.f;
#pragma unroll
  for (int q = 0; q < 4; ++q) {
    v[2 * q] = bflo(a[q]) + bflo(bq[q]); v[2 * q + 1] = bfhi(a[q]) + bfhi(bq[q]);
    g[2 * q] = bflo(gq[q]); g[2 * q + 1] = bfhi(gq[q]);
    ss += v[2 * q] * v[2 * q] + v[2 * q + 1] * v[2 * q + 1];
  }
  ss += __shfl_xor(ss, 1); ss += __shfl_xor(ss, 2); ss += __shfl_xor(ss, 4); ss += __shfl_xor(ss, 8);
  const float rstd = rsqrtf(ss * (1.f / 128.f) + EPS);
  ld8(hn, p.in[23] + (lane & 15) * 8);
#pragma unroll
  for (int e = 0; e < 8; ++e) v[e] = v[e] * rstd * hn[e] * siluf(g[e]);
  *(u32x4*)(B.MIX1_() + (size_t)grow * 1024 + 512 + lane * 8) = pack8(v);
}

DI void hgrn_readout_row(const Params& p, const Bufs& B, int grow, int hd, int lane) {
  const size_t o = (size_t)grow * 512 + hd * 128 + lane * 2;
  unsigned a = *(const unsigned*)(B.OH_() + o), bq = *(const unsigned*)(B.OH_() + (size_t)M * 512 + o);
  unsigned gq = *(const unsigned*)(B.HG_() + o);
  float v0 = bflo(a) + bflo(bq), v1 = bfhi(a) + bfhi(bq);
  float ss = wave_sum(v0 * v0 + v1 * v1);
  float rstd = rsqrtf(ss * (1.f / 128.f) + EPS);
  const float* hn = p.in[23];
  float g0 = bflo(gq), g1 = bfhi(gq);
  unsigned out = pk2(v0 * rstd * hn[lane * 2] * siluf(g0), v1 * rstd * hn[lane * 2 + 1] * siluf(g1));
  *(unsigned*)(B.MIX1_() + (size_t)grow * 1024 + 512 + hd * 128 + lane * 2) = out;
}


namespace pg8 {
#define PG8_LAS __attribute__((address_space(3)))
typedef unsigned short bf16_t;
typedef short bf16x8 __attribute__((ext_vector_type(8)));
typedef float f32x4 __attribute__((ext_vector_type(4)));
typedef unsigned u32x4 __attribute__((ext_vector_type(4)));
constexpr int BM = 256, BK = 64, HALF = 128, HTB = HALF * BK * 2  , STAGE_BYTES = 8 * HTB, NXCD = 8, WGM = 8;

__host__ __device__ __forceinline__ int lds_byte(int r, int c) { const int st = (r >> 4) * 2 + (c >> 5), rr = r & 15, cc = c & 31, ob = rr * 64 + cc * 2; return st * 1024 + (ob ^ (((ob >> 9) & 1) << 5)); }
__host__ __device__ __forceinline__ void stage_rc(int b, int& R, int& C) { const int st = b / 1024, sb = b % 1024, swz = sb ^ (((sb >> 9) & 1) << 5); R = (st >> 1) * 16 + swz / 64; C = (st & 1) * 32 + (swz % 64) / 2; }
__host__ __device__ __forceinline__ int perm32(int rho) { const int n = rho >> 4, i = rho & 15; return 8 * (i >> 2) + 4 * n + (i & 3); }

struct Unit { int pm, pn; };
struct Gemm { const bf16_t* A; const bf16_t* Bt; int M, N, K; };

struct StaticOrder {
    int nM, nN, nwg, G, c;
    __host__ __device__ void init(int M, int N, int G_, int c_) { nM = M / BM; nN = N / BM; nwg = nM * nN; G = G_; c = c_; }
    __host__ __device__ bool next(int i, Unit& u) const {
        const long L = (long)i * G + c; if (L >= nwg) return false;
        int wgid = (int)L; { const int q = nwg / NXCD, r = nwg % NXCD, xcd = wgid % NXCD, off = wgid / NXCD; wgid = (xcd < r ? xcd * (q + 1) : r * (q + 1) + (xcd - r) * q) + off; }
        const int nig = WGM * nN, gid = wgid / nig, fm = gid * WGM, gsz = (nM - fm) < WGM ? (nM - fm) : WGM;
        u.pm = fm + ((wgid % nig) % gsz); u.pn = (wgid % nig) / gsz; return true;
    }
    __device__ __forceinline__ void a_ready(const Unit&) const {}
    __device__ __forceinline__ void done(const Unit&) const {}
};
template <class Epi, class Sched, bool STAMP = false, int AMODE = 0>
__device__ __forceinline__ void gemm_phase(PG8_LAS unsigned char* lds, const Gemm g, const Sched& S, const Epi& E, unsigned long long* stamps) {
    const int tid = threadIdx.x, wid = __builtin_amdgcn_readfirstlane(tid >> 6), lane = tid & 63, wr = wid >> 2, wc = wid & 3, fr = lane & 15, fq = lane >> 4;
    const int K = g.K, nt = K / BK;
    int ts_lo = 0, ts_hi = 0, nts = 0; const unsigned long long rt_entry = STAMP ? (unsigned long long)wall_clock64() : 0ull;
#define PG8_STAMP() do { if (STAMP && wid == 0 && nts < 64) { const unsigned long long _c = (unsigned long long)clock64(); \
        ts_lo = (lane == nts) ? (int)(unsigned)_c : ts_lo; ts_hi = (lane == nts) ? (int)(unsigned)(_c >> 32) : ts_hi; ++nts; } } while (0)
    PG8_STAMP();
    unsigned voffA[2], voffB[2];
#pragma unroll
    for (int i = 0; i < 2; ++i) { int R, C; stage_rc(tid * 16 + i * 8192, R, C); const int Rb = Epi::PERM ? ((R & ~31) + perm32(R & 31)) : R;
        const int Ra = AMODE ? (((R >> 6) ? 126 : 0) + (R & 15) * 8 + ((R >> 4) & 3)) : R;
        voffA[i] = (unsigned)(Ra * K + C) * 2u; voffB[i] = (unsigned)(Rb * K + C) * 2u; }
    const size_t kstep = (size_t)(BK * 2);
    const size_t hstep = (size_t)HALF * K * 2;
    const size_t hstepA = AMODE ? (size_t)4 * K * 2 : hstep;
    const size_t tstep = 2 * hstep;
    const unsigned ldsw = (unsigned)wid * 1024u;
    const int aoff = lds_byte(wr * 64 + fr, fq * 8), boff = lds_byte(wc * 32 + fr, fq * 8);
#define PG8_SA(b, h) (((b) * 2 + (h)) * HTB)
#define PG8_SB(b, h) ((4 + (b) * 2 + (h)) * HTB)
#define PG8_STAGE(bufoff, gbase, voff) do { _Pragma("unroll") for (int _i = 0; _i < 2; ++_i) \
        __builtin_amdgcn_global_load_lds((const unsigned*)((const char*)(gbase) + (voff)[_i]), (PG8_LAS unsigned*)(lds + (bufoff) + ldsw + _i * 8192), 16, 0, 0); } while (0)
#define PG8_LDA(dst, b, h) do { _Pragma("unroll") for (int m = 0; m < 4; ++m) _Pragma("unroll") for (int k = 0; k < 2; ++k) dst[m][k] = *(const PG8_LAS bf16x8*)(lds + PG8_SA(b, h) + aoff + m * 2048 + k * 1024); } while (0)
#define PG8_LDB(dst, b, h) do { _Pragma("unroll") for (int n = 0; n < 2; ++n) _Pragma("unroll") for (int k = 0; k < 2; ++k) dst[n][k] = *(const PG8_LAS bf16x8*)(lds + PG8_SB(b, h) + boff + n * 2048 + k * 1024); } while (0)
#define PG8_MMA(ai, bj, At, Bt) do { __builtin_amdgcn_s_setprio(1); _Pragma("unroll") for (int m = 0; m < 4; ++m) _Pragma("unroll") for (int n = 0; n < 2; ++n) _Pragma("unroll") for (int k = 0; k < 2; ++k) \
        acc[ai][bj][m][n] = __builtin_amdgcn_mfma_f32_16x16x32_bf16(Bt[n][k], At[m][k], acc[ai][bj][m][n], 0, 0, 0); __builtin_amdgcn_s_setprio(0); } while (0)
#define PG8_WAIT_V(n) asm volatile("s_waitcnt vmcnt(" #n ")" ::: "memory")
#define PG8_WAIT_L(n) asm volatile("s_waitcnt lgkmcnt(" #n ")" ::: "memory")
#define PG8_BAR __builtin_amdgcn_s_barrier()
#define PG8_SCHED __builtin_amdgcn_sched_barrier(0)
    Unit cur, nxt; int ui = 0;
    if (!S.next(0, cur)) return;
    f32x4 acc[2][2][4][2];
#pragma unroll
    for (int a = 0; a < 2; ++a)
#pragma unroll
        for (int b = 0; b < 2; ++b)
#pragma unroll
            for (int m = 0; m < 4; ++m)
#pragma unroll
                for (int n = 0; n < 2; ++n) acc[a][b][m][n] = (f32x4){0.f, 0.f, 0.f, 0.f};
    bf16x8 At[4][2], B0[2][2], B1[2][2];
    const char* cA = AMODE ? (const char*)g.A + (long)S.abase(cur) * K * 2 : (const char*)g.A + (size_t)cur.pm * tstep; const char* cB = (const char*)g.Bt + (size_t)cur.pn * tstep;
    S.a_ready(cur);
    PG8_STAGE(PG8_SB(0, 0), cB, voffB); PG8_STAGE(PG8_SA(0, 0), cA, voffA); PG8_STAGE(PG8_SB(0, 1), cB + hstep, voffB); PG8_STAGE(PG8_SA(0, 1), cA + hstepA, voffA);
    if (wr == 1) PG8_BAR;
    PG8_WAIT_V(4); PG8_BAR;
    PG8_STAGE(PG8_SB(1, 0), cB + kstep, voffB); PG8_STAGE(PG8_SA(1, 0), cA + kstep, voffA); PG8_STAGE(PG8_SB(1, 1), cB + hstep + kstep, voffB);
    PG8_WAIT_V(6); PG8_BAR;
    PG8_STAMP();
    for (;;) {
        const bool has_next = S.next(ui + 1, nxt);
        const char* nA = has_next ? (AMODE ? (const char*)g.A + (long)S.abase(nxt) * K * 2 : (const char*)g.A + (size_t)nxt.pm * tstep) : cA; const char* nB = has_next ? (const char*)g.Bt + (size_t)nxt.pn * tstep : cB;
        for (int t = 0; t < nt; t += 2) {
            const bool last = (t == nt - 2);
            const char* a1 = cA + (size_t)(t + 1) * kstep;
            const char* a2 = last ? nA : cA + (size_t)(t + 2) * kstep; const char* b2 = last ? nB : cB + (size_t)(t + 2) * kstep;
            const char* a3 = a2 + kstep; const char* b3 = b2 + kstep;
            if (last && has_next) S.a_ready(nxt);
            PG8_LDB(B0, 0, 0); PG8_SCHED; PG8_LDA(At, 0, 0); PG8_STAGE(PG8_SA(1, 1), a1 + hstepA, voffA);
            PG8_WAIT_L(8); PG8_BAR; PG8_WAIT_L(0); PG8_MMA(0, 0, At, B0); PG8_BAR; PG8_SCHED;
            PG8_LDB(B1, 0, 1); PG8_STAGE(PG8_SB(0, 0), b2, voffB);
            PG8_BAR; PG8_WAIT_L(0); PG8_MMA(0, 1, At, B1); PG8_BAR;
            PG8_LDA(At, 0, 1); PG8_STAGE(PG8_SA(0, 0), a2, voffA);
            PG8_BAR; PG8_WAIT_L(0); PG8_MMA(1, 0, At, B0); PG8_BAR; PG8_SCHED;
            PG8_STAGE(PG8_SB(0, 1), b2 + hstep, voffB);
            PG8_WAIT_V(6); PG8_BAR; PG8_MMA(1, 1, At, B1); PG8_BAR;
            PG8_LDB(B0, 1, 0); PG8_SCHED; PG8_LDA(At, 1, 0); PG8_STAGE(PG8_SA(0, 1), a2 + hstepA, voffA);
            PG8_WAIT_L(8); PG8_BAR; PG8_WAIT_L(0); PG8_MMA(0, 0, At, B0); PG8_BAR; PG8_SCHED;
            PG8_LDB(B1, 1, 1); PG8_STAGE(PG8_SB(1, 0), b3, voffB);
            PG8_BAR; PG8_WAIT_L(0); PG8_MMA(0, 1, At, B1); PG8_BAR;
            PG8_LDA(At, 1, 1); PG8_STAGE(PG8_SA(1, 0), a3, voffA);
            PG8_BAR; PG8_WAIT_L(0); PG8_MMA(1, 0, At, B0); PG8_BAR; PG8_SCHED;
            PG8_STAGE(PG8_SB(1, 1), b3 + hstep, voffB);
            PG8_WAIT_V(6); PG8_BAR; PG8_MMA(1, 1, At, B1); PG8_BAR;
        }
        PG8_STAMP();
        if constexpr (!Epi::AFTER_DRAIN) { E(acc, cur, wr, wc, fr, fq); S.done(cur); }
        PG8_STAMP();
        if (!has_next) break;
#pragma unroll
        for (int a = 0; a < 2; ++a)
#pragma unroll
            for (int b = 0; b < 2; ++b)
#pragma unroll
                for (int m = 0; m < 4; ++m)
#pragma unroll
                    for (int n = 0; n < 2; ++n) acc[a][b][m][n] = (f32x4){0.f, 0.f, 0.f, 0.f};
        cur = nxt; cA = nA; cB = nB; ++ui;
    }
    PG8_WAIT_V(0);
    if (wr == 0) PG8_BAR;
    PG8_BAR;
    if constexpr (Epi::AFTER_DRAIN) { E.fused(acc, cur, wr, wc, fr, fq, lds, wid, lane); S.done(cur); }
    PG8_STAMP();
    if (STAMP && wid == 0) { stamps[lane] = lane < nts ? (((unsigned long long)(unsigned)ts_hi << 32) | (unsigned)ts_lo) : 0ull;
        if (lane == 62) stamps[62] = rt_entry; if (lane == 63) stamps[63] = (unsigned long long)wall_clock64(); }
#undef PG8_STAMP
#undef PG8_SA
#undef PG8_SB
#undef PG8_STAGE
#undef PG8_LDA
#undef PG8_LDB
#undef PG8_MMA
#undef PG8_WAIT_V
#undef PG8_WAIT_L
#undef PG8_BAR
#undef PG8_SCHED
}
}

struct POrder {
  pg8::StaticOrder so; int mode;
  DI void init(int nrow_tiles, int N, int mode_) { so.init(nrow_tiles * 256, N, gridDim.x, blockIdx.x); mode = mode_; }
  DI bool next(int i, pg8::Unit& u) const {
    if (!so.next(i, u)) return false;
    if (mode == 1) u.pm = (u.pm >> 4) * 17 + 1 + (u.pm & 15);
    return true;
  }
  DI int abase(const pg8::Unit&) const { return 0; }
  DI void a_ready(const pg8::Unit&) const {}
  DI void done(const pg8::Unit&) const {}
};
struct EpiStoreBf16 {
  static constexpr bool PERM = true, AFTER_DRAIN = false;
  u16* O;
  DI void operator()(const pg8::f32x4 (&acc)[2][2][4][2], const pg8::Unit& u, int wr, int wc, int fr, int fq) const {
    const int row0 = u.pm * 256 + wr * 64 + fr, col0 = u.pn * 256 + wc * 32 + 8 * fq;
#pragma unroll
    for (int ai = 0; ai < 2; ++ai)
#pragma unroll
      for (int m = 0; m < 4; ++m) {
        u16* rowp = O + (size_t)(row0 + ai * 128 + m * 16) * 1024 + col0;
#pragma unroll
        for (int bj = 0; bj < 2; ++bj) {
          const pg8::f32x4 v0 = acc[ai][bj][m][0], v1 = acc[ai][bj][m][1];
          u32x4 w;
          w[0] = pk2(v0[0], v0[1]); w[1] = pk2(v0[2], v0[3]); w[2] = pk2(v1[0], v1[1]); w[3] = pk2(v1[2], v1[3]);
          *(u32x4*)(rowp + bj * 128) = w;
        }
      }
  }
};

struct FOrder {
  pg8::StaticOrder so; int per_b, pos0;
  DI void init(int per_b_, int pos0_) { per_b = per_b_; pos0 = pos0_; so.init(NB * per_b_ * 256, 22 * 256, gridDim.x, blockIdx.x); }
  DI bool next(int i, pg8::Unit& u) const { return so.next(i, u); }
  DI int gb(const pg8::Unit& u) const { int b = u.pm / per_b, j = u.pm - b * per_b; return b * LT + pos0 + 252 * j; }
  DI int abase(const pg8::Unit& u) const { return gb(u) - 1; }
  DI void a_ready(const pg8::Unit&) const {}
  DI void done(const pg8::Unit&) const {}
};
struct EpiFFN1 {
  static constexpr bool PERM = true, AFTER_DRAIN = false;
  const float* cw; const float* cb; u16* G; int per_b, pos0;
  DI void operator()(const pg8::f32x4 (&acc)[2][2][4][2], const pg8::Unit& u, int wr, int wc, int fr, int fq) const {
    const int b = u.pm / per_b, j = u.pm - b * per_b;
    const int tok0 = b * LT + pos0 + 252 * j + (wr ? 126 : 0) - 1 + fr * 8;
    const int fc0 = u.pn * 128 + wc * 32 + 8 * fq;
#pragma unroll
    for (int hh = 0; hh < 2; ++hh) {
      const int fc = fc0 + 4 * hh;
      const float4 w0 = *(const float4*)(cw + fc), w1 = *(const float4*)(cw + DFF + fc), w2 = *(const float4*)(cw + 2 * DFF + fc),
                   bb = *(const float4*)(cb + fc);
      const float w0a[4] = {w0.x, w0.y, w0.z, w0.w}, w1a[4] = {w1.x, w1.y, w1.z, w1.w}, w2a[4] = {w2.x, w2.y, w2.z, w2.w},
                  bba[4] = {bb.x, bb.y, bb.z, bb.w};
      float pv[4], nx[4];
#pragma unroll
      for (int e = 0; e < 4; ++e) {
        pv[e] = __shfl_up(acc[1][0][3][hh][e], 1, 16);
        nx[e] = __shfl_down(acc[0][0][0][hh][e], 1, 16);
      }
#pragma unroll
      for (int i = 0; i < 8; ++i) {
        const int ai = i >> 2, m = i & 3;
        const int lam = fr * 8 + i, tok = tok0 + i, pos = tok - b * LT;
        const bool hp = !(pos == 0 || pos == CTX), hn = !(pos == CTX - 1 || pos == LT - 1);
        float v[4];
#pragma unroll
        for (int e = 0; e < 4; ++e) {
          const float a = acc[ai][0][m][hh][e], up = acc[ai][1][m][hh][e];
          const float ap = (i > 0) ? acc[(i - 1) >> 2][0][(i - 1) & 3][hh][e] : pv[e];
          const float an = (i < 7) ? acc[(i + 1) >> 2][0][(i + 1) & 3][hh][e] : nx[e];
          const float av = (hp ? ap : 0.f) * w0a[e] + a * w1a[e] + (hn ? an : 0.f) * w2a[e] + bba[e];
          v[e] = siluf(av) * up;
        }
        if (lam >= 1 && lam <= 126 && pos < LT) {
          u32x2 o; o[0] = pk2(v[0], v[1]); o[1] = pk2(v[2], v[3]);
          *(u32x2*)(G + (size_t)tok * DFF + fc) = o;
        }
      }
    }
  }
};

DI void rope8_reg(float* v, int d, int n, const float* ropec, const float* ropes) {
  const int axis = d >> 5, pa = axis ? (n & 63) : (n >> 6), f0 = d & 15;
  const bool first = (d & 16) == 0;
  float cs[8], sn[8];
  ld8(cs, ropec + pa * 16 + f0); ld8(sn, ropes + pa * 16 + f0);
#pragma unroll
  for (int e = 0; e < 8; ++e) {
    const float xp = __shfl_xor(v[e], 32);
    v[e] = first ? v[e] * cs[e] - xp * sn[e] : v[e] * cs[e] + xp * sn[e];
  }
}
struct EpiIn0 {
  static constexpr bool PERM = true, AFTER_DRAIN = false;
  Bufs B;
  DI void operator()(const pg8::f32x4 (&acc)[2][2][4][2], const pg8::Unit& u, int wr, int wc, int fr, int fq) const {
    const int seg = u.pn >> 1;
    const int b = u.pm / 17, pos00 = (u.pm - b * 17) * 256 + wr * 64 + fr;
    const bool lat = (u.pm - b * 17) != 0;
#pragma unroll
    for (int ai = 0; ai < 2; ++ai)
#pragma unroll
      for (int m = 0; m < 4; ++m) {
        int pos = pos00 + ai * 128 + m * 16;
        asm volatile("" : "+v"(pos));
        const size_t grow = (size_t)b * LT + pos;
#pragma unroll
        for (int bj = 0; bj < 2; ++bj) {
          const int c = u.pn * 256 + bj * 128 + wc * 32 + 8 * fq;
          float v[8];
#pragma unroll
          for (int e = 0; e < 8; ++e) v[e] = acc[ai][bj][m][e >> 2][e & 3];
          if (seg == 0) {
            *(u32x4*)(B.U_() + grow * 512 + c) = pack8(v);
          } else if (seg == 3) {
            const int hc = c - 1536, vh = hc >> 7, dv = hc & 127;
            u16* dst = B.VT0_() + ((size_t)(b * 4 + vh) * 128 + dv) * LT + pos;
#pragma unroll
            for (int e = 0; e < 8; ++e) dst[(size_t)e * LT] = f2bf(v[e]);
          } else {
            const int hc = c - 512 * seg, head = hc >> 6, d = hc & 63;
            if (lat) rope8_reg(v, d, pos - CTX, B.ropec_(), B.ropes_());
            if (seg == 1) {
#pragma unroll
              for (int e = 0; e < 8; ++e) v[e] *= QS_DIFF;
            }
            u16* dst = (seg == 1 ? B.Q0_() : B.K0_()) + ((size_t)(b * 8 + head) * LT + pos) * 64 + d;
            *(u32x4*)dst = pack8(v);
          }
        }
        asm volatile("" ::: "memory");
      }
  }
};

DI float quad_sum(float s) { s += __shfl_xor(s, 16); s += __shfl_xor(s, 32); return s; }

struct EpiIn1 {
  static constexpr bool PERM = true, AFTER_DRAIN = false;
  Bufs B;
  DI void operator()(const pg8::f32x4 (&acc)[2][2][4][2], const pg8::Unit& u, int wr, int wc, int fr, int fq) const {
    const int b = u.pm / 17, pos00 = (u.pm - b * 17) * 256 + wr * 64 + fr;
    const bool lat = (u.pm - b * 17) != 0;
#pragma unroll
    for (int bj = 0; bj < 2; ++bj) {
      const int c = u.pn * 256 + bj * 128 + wc * 32 + 8 * fq;
      const int cg = u.pn * 256 + bj * 128 + wc * 32;
      if (cg >= 3392) continue;
      float lb8[8];
      if (cg >= 1344 && cg < 2368) ld8(lb8, B.lb_() + (cg >= 1856 ? 512 + c - 1856 : c - 1344));
#pragma unroll
      for (int ai = 0; ai < 2; ++ai)
#pragma unroll
        for (int m = 0; m < 4; ++m) {
          int pos = pos00 + ai * 128 + m * 16;
        asm volatile("" : "+v"(pos));
          const size_t grow = (size_t)b * LT + pos;
          float v[8];
#pragma unroll
          for (int e = 0; e < 8; ++e) v[e] = acc[ai][bj][m][e >> 2][e & 3];
          if (cg < 768) {
            float ss = 0.f;
#pragma unroll
            for (int e = 0; e < 8; ++e) ss += v[e] * v[e];
            ss = quad_sum(ss);
            if (fq == 0) B.RS_()[grow * 24 + (cg >> 5)] = ss;
            if (cg < 512) *(u32x4*)(B.CQ_() + grow * 512 + c) = pack8(v);
            else *(u32x4*)(B.CKV_() + grow * 256 + (c - 512)) = pack8(v);
          } else if (cg < 832) {
            const int d = c - 768;
            if (lat) rope8_reg(v, d, pos - CTX, B.ropec_(), B.ropes_());
            const u32x4 o = pack8(v);
#pragma unroll
            for (int hh = 0; hh < 4; ++hh) *(u32x4*)(B.KF_() + ((size_t)(b * 4 + hh) * LT + pos) * 192 + 128 + d) = o;
          } else if (cg < 1344) {
#pragma unroll
            for (int e = 0; e < 8; ++e) v[e] = siluf(v[e]);
            *(u32x4*)(B.HQ_() + grow * 512 + (c - 832)) = pack8(v);
          } else if (cg < 2368) {
            const int dir = cg >= 1856, ch = c - (dir ? 1856 : 1344);
            u32x4 o;
            float lf[8];
#pragma unroll
            for (int e = 0; e < 8; ++e) {
              const float f = lb8[e] + (1.f - lb8[e]) / (1.f + __expf(-v[e]));
              lf[e] = logf(f);
            }
#pragma unroll
            for (int q = 0; q < 4; ++q) o[q] = (unsigned)f2h(lf[2 * q]) | ((unsigned)f2h(lf[2 * q + 1]) << 16);
            *(u32x4*)(B.LF_() + (size_t)dir * M * 512 + grow * 512 + ch) = o;
          } else if (cg < 2880) {
            *(u32x4*)(B.HI_() + grow * 512 + (c - 2368)) = pack8(v);
          } else {
            *(u32x4*)(B.HG_() + grow * 512 + (c - 2880)) = pack8(v);
          }
          asm volatile("" ::: "memory");
        }
    }
  }
};
struct EpiUQ {
  static constexpr bool PERM = true, AFTER_DRAIN = false;
  Bufs B;
  DI void operator()(const pg8::f32x4 (&acc)[2][2][4][2], const pg8::Unit& u, int wr, int wc, int fr, int fq) const {
    const int b = u.pm / 17, n00 = (u.pm - b * 17 - 1) * 256 + wr * 64 + fr;
#pragma unroll
    for (int ai = 0; ai < 2; ++ai)
#pragma unroll
      for (int m = 0; m < 4; ++m) {
        int n = n00 + ai * 128 + m * 16;
        asm volatile("" : "+v"(n));
        const size_t grow = (size_t)b * LT + CTX + n;
        const float4 r4 = *(const float4*)(B.RS_() + grow * 24 + 4 * fq);
        const float sc = rsqrtf(quad_sum(r4.x + r4.y + r4.z + r4.w) * (1.f / 512.f) + EPS) * QS_MLA;
#pragma unroll
        for (int bj = 0; bj < 2; ++bj) {
          const int c = u.pn * 256 + bj * 128 + wc * 32 + 8 * fq;
          const int cg = u.pn * 256 + bj * 128 + wc * 32, head = cg / 192, dd = c - head * 192;
          float v[8];
#pragma unroll
          for (int e = 0; e < 8; ++e) v[e] = acc[ai][bj][m][e >> 2][e & 3];
          if (cg - head * 192 >= 128) rope8_reg(v, dd - 128, n, B.ropec_(), B.ropes_());
#pragma unroll
          for (int e = 0; e < 8; ++e) v[e] *= sc;
          *(u32x4*)(B.QF_() + ((size_t)(b * 4 + head) * SEQ + n) * 192 + dd) = pack8(v);
        }
        asm volatile("" ::: "memory");
      }
  }
};
struct EpiUKV {
  static constexpr bool PERM = true, AFTER_DRAIN = false;
  Bufs B;
  DI void operator()(const pg8::f32x4 (&acc)[2][2][4][2], const pg8::Unit& u, int wr, int wc, int fr, int fq) const {
    const int b = u.pm / 17, pos00 = (u.pm - b * 17) * 256 + wr * 64 + fr, head = u.pn;
    const int dd = wc * 32 + 8 * fq;
    u16* const kf = B.KF_() + (size_t)(b * 4 + head) * LT * 192 + 0;
    u16* const vt = B.VT1_() + (size_t)(b * 4 + head) * 128 * LT;
    const float* const rs = B.RS_() + (size_t)b * LT * 24 + 16 + 2 * fq;
#pragma unroll
    for (int ai = 0; ai < 2; ++ai)
#pragma unroll
      for (int m = 0; m < 4; ++m) {
        int pos = pos00 + ai * 128 + m * 16;
        asm volatile("" : "+v"(pos));
        const float2 r2 = *(const float2*)(rs + pos * 24);
        const float sc = rsqrtf(quad_sum(r2.x + r2.y) * (1.f / 256.f) + EPS);
        {
          float v[8];
#pragma unroll
          for (int e = 0; e < 8; ++e) v[e] = acc[ai][0][m][e >> 2][e & 3] * sc;
          *(u32x4*)(kf + pos * 192 + dd) = pack8(v);
        }
        int vo = dd * LT + pos;
#pragma unroll
        for (int e = 0; e < 8; ++e) {
          vt[vo] = f2bf(acc[ai][1][m][e >> 2][e & 3] * sc);
          vo += LT;
          asm volatile("" : "+v"(vo));
        }
        asm volatile("" ::: "memory");
      }
  }
};
template <class Epi>
DI void run_gemm256(char* smem_wg, const u16* A, const u16* Bt, int K, int nrow_tiles, int N, int mode, const Epi& E) {
  asm volatile("" : "+s"(K));
  pg8::Gemm g; g.A = A; g.Bt = Bt; g.M = 0; g.N = N; g.K = K;
  POrder S; S.init(nrow_tiles, N, mode);
  pg8::gemm_phase<Epi, POrder, false>((PG8_LAS unsigned char*)smem_wg, g, S, E, nullptr);
}

constexpr int NPHASE = 18;


struct TileIter {
  int qg, step, ntn, nloc, total, xcd;
  DI TileIter(int nrt, int ntn_) {
    xcd = blockIdx.x & 7; qg = (blockIdx.x >> 3) * 2 + vblk(); step = (gridDim.x >> 3) * 2; ntn = ntn_;
    nloc = (nrt - xcd + 7) >> 3;
    total = ((nloc + 7) >> 3) * 8 * ntn;
  }
  DI bool next(int& rt, int& nt, int& live) {
    const int per = 8 * ntn, full = ntn >> 3, wrem = ntn & 7;
    live = 0; rt = 0; nt = 0;
    while (qg < total) {
      int grp = qg / per, q = qg - grp * per, r, c;
      qg += step;
      if (q < full * 64) { int ch = q >> 6, qq = q & 63; r = qq >> 3; c = ch * 8 + (qq & 7); }
      else { int qq = q - full * 64; r = qq / wrem; c = full * 8 + (qq - r * wrem); }
      int rl = grp * 8 + r;
      if (rl < nloc) { rt = rl * 8 + xcd; nt = c; live = 1; break; }
    }
    return __syncthreads_or(live) != 0;
  }
};

DI int lat_rowbase(int rt) { return (rt >> 5) * LT + CTX + (rt & 31) * 128; }

DI void run_phase(int ph, const Params& p, const Bufs& B, char* smem_wg) {
  const int VB = vblk();
  char* smem = smem_wg + VB * SMEM_HALF;
  const int bid = blockIdx.x * 2 + VB, nb = gridDim.x * 2, tid = otid(), lane = tid & 63, wid = tid >> 6;
  switch (ph) {
    case 0: {
      const int n = NW_P0 + 192 + 1;
      for (int it = bid; it < n; it += nb) {
        if (it < NW_P0) prep_weight_item(smem, p, B, it);
        else if (it < NW_P0 + 192) mod_gemv_item(smem, p, B, it - NW_P0);
        else tables_item(p, B);
      }
    } break;
    case 1: {
      for (int it = bid; it < M / 32; it += nb) {
        for (int rr = 0; rr < 8; ++rr) {
          int row = it * 32 + rr * 4 + wid;
          RowInfo ri = row_info(row);
          const float* x = (ri.lat ? p.in[0] : p.in[2]) + resid_off(ri);
          const float* md = B.mod_() + (size_t)(0 * 9 + ri.mi) * 6144;
          norm_mod_row(x, p.in[6] + 0, md, md + 1024, B.H_() + (size_t)row * 1024, lane);
        }
      }
    } break;
    case 2: {
      EpiIn0 E; E.B = B;
      run_gemm256(smem_wg, B.H_(), B.wt_ev_(), 1024, 136, 2048, 0, E);
    } break;
    case 3: {
      const int n_lat = 8 * 4 * 16, n_ctx = 8 * 4, n_pool = 272 * 4;
      for (int it = blockIdx.x; it < n_lat + n_ctx; it += gridDim.x) {
        const bool lt = it < n_lat;
        const int j = lt ? it : it - n_lat;
        const int b = lt ? (j >> 6) : (j >> 2), vh = lt ? ((j >> 4) & 3) : (j & 3);
        diff_attn_item8(smem_wg, p, B, b, vh, lt ? CTX + (j & 15) * 256 : 0, lt ? LT : CTX);
      }
      __syncthreads();
      for (int it = nb - 1 - bid; it < n_pool; it += nb) pool_tile(smem, p, B, it >> 2, it & 3);
    } break;
    case 4: {
      EpiStoreBf16 E; E.O = (u16*)B.Y0_();
      run_gemm256(smem_wg, B.MIX0_(), B.wt_out_(), 1024, 128, 1024, 1, E);
      {
        EpiArgs ea{}; ea.outf = B.Y0_();
        for (int it = bid; it < 128; it += nb) {
          const int rt = it >> 3, nt = it & 7;
          gemm_tile<EPI_F32, false>(smem, p, B, B.MIX0_(), 1024, (rt >> 1) * LT + (rt & 1) * 128, 0, M, B.wt_out_(), 1024, nt * 128, ea, 1);
        }
      }
    } break;
    case 5: case 8: {
      const bool first = (ph == 5);
      const u16* Yb = (const u16*)B.Y0_();
      for (int it = bid; it < M / 32; it += nb) {
        const RowInfo r0 = row_info(it * 32);
        const float* md0 = B.mod_() + (size_t)(0 * 9 + r0.mi) * 6144;
        const float* md1 = B.mod_() + (size_t)(1 * 9 + r0.mi) * 6144;
        RowParams P;
        if (first) load_row_params<true>(P, md0 + 2 * 1024, p.in[6] + 1 * 1024, p.in[6] + 2 * 1024, md0 + 3 * 1024, md0 + 4 * 1024, lane);
        else load_row_params<true>(P, md0 + 5 * 1024, p.in[6] + 3 * 1024, p.in[6] + 4 * 1024, md1, md1 + 1024, lane);
        for (int rr = 0; rr < 8; ++rr) {
          int row = it * 32 + rr * 4 + wid;
          RowInfo ri = row_info(row);
          size_t ro = resid_off(ri);
          float* xd = (ri.lat ? p.out : B.xc_()) + ro;
          const float* xs = first ? (ri.lat ? p.in[0] : p.in[2]) + ro : xd;
          resid_row_p<true>(Yb + (size_t)row * 1024, xs, xd, P, B.H_() + (size_t)row * 1024, lane);
        }
      }
    } break;
    case 6: {
      FOrder S; S.init(18, 0);
      EpiFFN1 E; E.cw = p.in[10]; E.cb = p.in[11]; E.G = B.G0_(); E.per_b = 18; E.pos0 = 0;
      pg8::Gemm g; g.A = B.H_(); g.Bt = B.wt_f1_(); g.M = 0; g.N = 22 * 256; g.K = 1024;
      pg8::gemm_phase<EpiFFN1, FOrder, false, 1>((PG8_LAS unsigned char*)smem_wg, g, S, E, nullptr);
    } break;
    case 7: {
      EpiStoreBf16 E; E.O = (u16*)B.Y0_();
      run_gemm256(smem_wg, B.G0_(), B.wt_f2_(), DFF, 128, 1024, 1, E);
      {
        EpiArgs ea{}; ea.outf = B.Y0_();
        for (int it = bid; it < 128; it += nb) {
          const int rt = it >> 3, nt = it & 7;
          gemm_tile<EPI_F32, false>(smem, p, B, B.G0_(), DFF, (rt >> 1) * LT + (rt & 1) * 128, 0, M, B.wt_f2_(), DFF, nt * 128, ea, 1);
        }
      }
    } break;
    case 9: {
      EpiIn1 E; E.B = B;
      run_gemm256(smem_wg, B.H_(), B.wt_od_(), 1024, 136, 3584, 0, E);
    } break;
    case 10: {
      {
        EpiUQ E; E.B = B;
        run_gemm256(smem_wg, B.CQ_(), B.wt_uq_(), 512, 128, 768, 1, E);
      }
      {
        EpiUKV E; E.B = B;
        run_gemm256(smem_wg, B.CKV_(), B.wt_ukv_(), 256, 136, 1024, 0, E);
      }
      for (int it = nb - 1 - bid; it < NW_FFN; it += nb) ffn_weight_item(smem, p, B, 1, it);
    } break;
    case 11: {
      const int n_h = 64, n_a = 8 * 4 * 32;
      unsigned* qctr = (unsigned*)(p.ws + OFF_LAM + 256) + 64;
      volatile int* sitem = (volatile int*)(smem_wg + SMEM_MAIN + 8);
      const int vb = VB;
      for (;;) {
        __syncthreads();
        if (threadIdx.x == 0) *sitem = (int)atomicAdd(qctr, 1u);
        __syncthreads();
        const int it = *sitem;
        if (it >= n_h) break;
        if (vb == 0) hgrn_item(smem, B, it >> 3, (it >> 1) & 3, it & 1);
        else for (int ci = 0; ci < 68 * 4; ++ci) __syncthreads();
      }
      for (;;) {
        __syncthreads();
        if (threadIdx.x == 0) *sitem = (int)atomicAdd(qctr + 1, 1u);
        __syncthreads();
        const int j = *sitem;
        if (j >= 448 + 128) break;
        const bool split = j >= 448;
        const int it = split ? 896 + (j - 448) : 2 * j + vb;
        mla_attn_item(smem_wg, smem, B, it >> 7, (it >> 5) & 3, it & 31, split, vb);
      }
    } break;
    case 12: {
      for (int it = bid; it < NB * SEQ / 4; it += nb) {
        const int rl = it * 4 + wid;
        hgrn_readout_row8(p, B, (rl >> 12) * LT + CTX + (rl & 4095), lane);
      }
    } break;
    case 13: {
      EpiStoreBf16 E; E.O = (u16*)B.Y1_();
      run_gemm256(smem_wg, B.MIX1_(), B.wt_out_() + 1024 * 1024, 1024, 128, 1024, 1, E);
    } break;
    case 14: case 17: {
      const bool first = (ph == 14);
      for (int it = bid; it < NB * SEQ / 32; it += nb) {
        const int bb = (it * 32) >> 12;
        const float* md1 = B.mod_() + (size_t)(1 * 9 + bb) * 6144;
        const float* ng = p.in[6] + 4 * 1024;
        RowParams P;
        if (first) load_row_params<true>(P, md1 + 2 * 1024, ng + 1 * 1024, ng + 2 * 1024, md1 + 3 * 1024, md1 + 4 * 1024, lane);
        else load_row_params<false>(P, md1 + 5 * 1024, ng + 3 * 1024, nullptr, nullptr, nullptr, lane);
        for (int rr = 0; rr < 8; ++rr) {
          int rl = it * 32 + rr * 4 + wid;
          int row = bb * LT + CTX + (rl & 4095);
          float* xd = p.out + (size_t)rl * 1024;
          if (first) resid_row_p<true>((const u16*)B.Y1_() + (size_t)row * 1024, xd, xd, P, B.H_() + (size_t)row * 1024, lane);
          else resid_row_p<false>((const u16*)B.Y1_() + (size_t)row * 1024, xd, xd, P, nullptr, lane);
        }
      }
    } break;
    case 15: {
      FOrder S; S.init(17, CTX);
      EpiFFN1 E; E.cw = p.in[10] + 3 * DFF; E.cb = p.in[11] + DFF; E.G = B.G1_(); E.per_b = 17; E.pos0 = CTX;
      pg8::Gemm g; g.A = B.H_(); g.Bt = B.wt_f1_(); g.M = 0; g.N = 22 * 256; g.K = 1024;
      pg8::gemm_phase<EpiFFN1, FOrder, false, 1>((PG8_LAS unsigned char*)smem_wg, g, S, E, nullptr);
    } break;
    case 16: {
      EpiStoreBf16 E; E.O = (u16*)B.Y1_();
      run_gemm256(smem_wg, B.G1_(), B.wt_f2_(), DFF, 128, 1024, 1, E);
    } break;
    default: break;
  }
}

#define XB_TMO      128
#define XB_XCNT(j)  (256  + 64 * (j))
#define XB_XSUB(j)  (1280 + 64 * (j))
#define XB_XGEN(j)  (2304 + 64 * (j))
#define XB_TOP      3328
#define XB_TOPGEN   3392
#define XCD_BAR_WORDS 3456
#define XB_SPIN_CAP (1u << 18)
#define LAS __attribute__((address_space(3)))
DI unsigned xb_ld(unsigned* p) { return __hip_atomic_load(p, __ATOMIC_RELAXED, __HIP_MEMORY_SCOPE_AGENT); }
DI unsigned xb_add(unsigned* p, unsigned v) { return __hip_atomic_fetch_add(p, v, __ATOMIC_RELAXED, __HIP_MEMORY_SCOPE_AGENT); }
DI unsigned xb_xcc_id() { return (unsigned)__builtin_amdgcn_s_getreg((3 << 11) | 20) & 0xFu; }
#define XB_SPIN(cond, bar) do { unsigned _sp = 0; while (cond) { __builtin_amdgcn_s_sleep(1); \
    if ((++_sp & 255u) == 0u) { if (xb_ld(&(bar)[XB_TMO])) break; if (_sp > XB_SPIN_CAP) { atomicAdd(&(bar)[XB_TMO], 1u); break; } } } } while (0)
struct XcdBarrier { unsigned* bar; unsigned x; volatile LAS unsigned* st; };
DI XcdBarrier xcd_barrier_post(unsigned* bar, volatile LAS unsigned* st) {
  XcdBarrier b; b.bar = bar; b.x = xb_xcc_id(); b.st = st;
  if (threadIdx.x == 0) (void)xb_add(&bar[XB_XCNT(b.x)], 1u);
  return b;
}
DI void xcd_barrier_complete(unsigned* bar, unsigned x, unsigned& nloc, unsigned& nx) {
  const unsigned G = gridDim.x * gridDim.y * gridDim.z;
  unsigned sum, cnt, mine, sp = 0u;
  for (;;) {
    sum = 0u; cnt = 0u; mine = 0u;
#pragma unroll
    for (unsigned j = 0; j < 16; ++j) { const unsigned c = xb_ld(&bar[XB_XCNT(j)]); sum += c; cnt += (c > 0u) ? 1u : 0u; mine = (j == x) ? c : mine; }
    if (sum == G) break;
    __builtin_amdgcn_s_sleep(1);
    if ((++sp & 255u) == 0u) { if (xb_ld(&bar[XB_TMO])) break; if (sp > XB_SPIN_CAP) { atomicAdd(&bar[XB_TMO], 1u); break; } }
  }
  nloc = mine > 0u ? mine : 1u; nx = cnt > 0u ? cnt : 1u;
}
DI void xcd_barrier(const XcdBarrier& b) {
  asm volatile("s_waitcnt vmcnt(0)" ::: "memory");
  __syncthreads();
  if (threadIdx.x == 0) {
    unsigned* bar = b.bar;
    __builtin_amdgcn_s_waitcnt(0);
    unsigned nloc = b.st[0], nx = b.st[1];
    if (nloc == 0u) { xcd_barrier_complete(bar, b.x, nloc, nx); b.st[0] = nloc; b.st[1] = nx; }
    const unsigned old = xb_add(&bar[XB_XSUB(b.x)], 1u);
    const unsigned gen = old / nloc;
    if (old + 1u == (gen + 1u) * nloc) {
      __builtin_amdgcn_fence(__ATOMIC_RELEASE, "agent");
      asm volatile("s_waitcnt vmcnt(0)" ::: "memory");
      const unsigned og = xb_add(&bar[XB_TOP], 1u);
      const unsigned tg = og / nx;
      if (og + 1u == (tg + 1u) * nx) xb_add(&bar[XB_TOPGEN], 1u);
      else XB_SPIN(xb_ld(&bar[XB_TOPGEN]) == tg, bar);
      __builtin_amdgcn_fence(__ATOMIC_ACQUIRE, "agent");
      xb_add(&bar[XB_XGEN(b.x)], 1u);
      asm volatile("s_waitcnt vmcnt(0)" ::: "memory");
    } else {
      XB_SPIN(xb_ld(&bar[XB_XGEN(b.x)]) == gen, bar);
      __builtin_amdgcn_fence(__ATOMIC_ACQUIRE, "agent");
      asm volatile("s_waitcnt vmcnt(0)" ::: "memory");
    }
  }
  __syncthreads();
}
#define RUNPH(k)                                                                       \
  if (p.ph_lo <= (k) && (k) < p.ph_hi) {                                               \
    run_phase((k), p, B, smem);                                                        \
    if ((k) + 1 < p.ph_hi) {                                                           \
      if ((k) == 0) cg::this_grid().sync();                                            \
      else xcd_barrier(xb);                                                            \
    }                                                                                  \
  }
__global__ void __launch_bounds__(NTHR, 2) fwd_megakernel(Params p) {
  extern __shared__ __attribute__((aligned(16))) char smem[];
  const Bufs B = make_bufs(p.ws);
  volatile LAS unsigned* xst = (volatile LAS unsigned*)(smem + SMEM_MAIN);
  if (threadIdx.x == 0) { xst[0] = 0u; xst[1] = 0u; xst[2] = 0u; xst[3] = 0u; }
  __syncthreads();
  const XcdBarrier xb = xcd_barrier_post((unsigned*)(p.ws + OFF_LAM + 256), xst);
  RUNPH(0) RUNPH(1) RUNPH(2) RUNPH(3) RUNPH(4) RUNPH(5) RUNPH(6) RUNPH(7) RUNPH(8)
  RUNPH(9) RUNPH(10) RUNPH(11) RUNPH(12) RUNPH(13) RUNPH(14) RUNPH(15) RUNPH(16) RUNPH(17)
}

constexpr bool ONE_LAUNCH = true;

extern "C" void kernel_launch(void* const* d_in, const int* in_sizes, int n_in, void* d_out, int out_size, void* d_ws,
                              size_t ws_size, hipStream_t stream) {
  static int grid_blocks = 0;
  if (!grid_blocks) {
    int dev = 0, cus = 0, per_cu = 0;
    hipGetDevice(&dev);
    hipDeviceGetAttribute(&cus, hipDeviceAttributeMultiprocessorCount, dev);
    hipFuncSetAttribute((const void*)fwd_megakernel, hipFuncAttributeMaxDynamicSharedMemorySize, SMEM_BYTES);
    hipOccupancyMaxActiveBlocksPerMultiprocessor(&per_cu, fwd_megakernel, NTHR, SMEM_BYTES);
    if (per_cu < 1) per_cu = 1;
    if (per_cu > 1) per_cu = 1;
    grid_blocks = cus * per_cu;
  }
  if (ws_size < WS_NEEDED) {
    fprintf(stderr, "workspace too small: %zu < %zu\n", ws_size, (size_t)WS_NEEDED);
    return;
  }
  Params p{};
  for (int i = 0; i < 25; ++i) p.in[i] = (const float*)d_in[i];
  p.out = (float*)d_out;
  p.ws = (char*)d_ws;
  hipMemsetAsync((char*)d_ws + OFF_LAM + 256, 0, XCD_BAR_WORDS * 4, stream);
  if (ONE_LAUNCH) {
    p.ph_lo = 0; p.ph_hi = NPHASE;

    void* args[] = {&p};
    hipError_t e = hipLaunchCooperativeKernel((const void*)fwd_megakernel, dim3(grid_blocks), dim3(NTHR), args,
                                              SMEM_BYTES, stream);
    if (e != hipSuccess) fprintf(stderr, "cooperative launch failed: %s (grid %d)\n", hipGetErrorString(e), grid_blocks);
  } else {
    for (int ph = 0; ph < NPHASE; ++ph) {
      p.ph_lo = ph; p.ph_hi = ph + 1;
      hipLaunchKernelGGL(fwd_megakernel, dim3(grid_blocks), dim3(NTHR), SMEM_BYTES, stream, p);
    }
  }
}
```
